# Optimizing an MI355X kernel written in HIP

```python
import jax, jax.numpy as jnp
from jax import lax
import numpy as np

D_MODEL = 2048
BATCH = 8
SEQ = 2048
DEPTH = 1

GRID_W = 64
CTX_LEN = 256
N_HEADS = 16
HEAD_DIM = D_MODEL // N_HEADS
ATTN_WIDTH = N_HEADS * HEAD_DIM
F_GROUPS = 4
F_GROUP_DIM = D_MODEL // 8
F_WIDTH = F_GROUPS * F_GROUP_DIM
MAX_WIN_R = 8
WIN_C = 16
ROT_PER_AXIS = HEAD_DIM // 2
ROPE_BASE = 10000.0
EPS = 1e-6

OFF_ZF = F_WIDTH
OFF_Q = 2 * F_WIDTH
OFF_K = OFF_Q + ATTN_WIDTH
OFF_V = OFF_K + ATTN_WIDTH
OFF_ZA = OFF_V + ATTN_WIDTH
OFF_GF = OFF_ZA + ATTN_WIDTH
OFF_GA = OFF_GF + D_MODEL
IN_WIDTH = OFF_GA + D_MODEL
SPLIT_POINTS = (OFF_ZF, OFF_Q, OFF_K, OFF_V, OFF_ZA, OFF_GF, OFF_GA)

kernel_name = "hybrid_fourier_natten_dit_block"


def _rms(x):
    xf = x.astype(jnp.float32)
    return (xf * lax.rsqrt(jnp.mean(xf * xf, axis=-1, keepdims=True) + EPS)).astype(x.dtype)


def _qk_norm(x, gain):
    return _rms(x) * gain.astype(x.dtype)


def _heads(t):
    B, N, _ = t.shape
    return t.reshape(B, N, N_HEADS, HEAD_DIM).transpose(0, 2, 1, 3)


def _merge_heads(t):
    B, H, N, Dh = t.shape
    return t.transpose(0, 2, 1, 3).reshape(B, N, H * Dh)


def _axial_rope(n_tok):
    t = jnp.arange(n_tok)
    pos = jnp.stack([t // GRID_W, t % GRID_W], axis=-1).astype(jnp.float32)
    n_freq = ROT_PER_AXIS // 2
    inv_freq = ROPE_BASE ** (-jnp.arange(n_freq, dtype=jnp.float32) / n_freq)
    ang = pos[..., None] * inv_freq
    return jnp.cos(ang), jnp.sin(ang)


def _apply_rope(x, cos, sin):
    B, H, N, Dh = x.shape
    xr = x.reshape(B, H, N, 2, 2, ROT_PER_AXIS // 2)
    x0, x1 = xr[..., 0, :], xr[..., 1, :]
    cos = cos.astype(x.dtype)
    sin = sin.astype(x.dtype)
    out = jnp.stack([x0 * cos - x1 * sin, x1 * cos + x0 * sin], axis=-2)
    return out.reshape(B, H, N, Dh)


def _fourier_mix(u):
    B, N, _ = u.shape
    ug = u.reshape(B, N, F_GROUPS, F_GROUP_DIM).astype(jnp.float32)
    y = jnp.fft.fft2(ug, axes=(1, 3), norm="ortho").real
    return y.reshape(B, N, F_WIDTH).astype(u.dtype)


def _merge_branches(u_f, z_f, o, z_a, g_f, g_a, w_f_out, w_a_out, w_out):
    y_f = (_fourier_mix(u_f) * jax.nn.silu(z_f)) @ w_f_out
    y_a = (o * jax.nn.silu(z_a)) @ w_a_out
    y = jax.nn.sigmoid(g_f) * y_f + jax.nn.sigmoid(g_a) * y_a
    return y @ w_out


def _neighbourhood_attention(q, k, v, k_ctx, v_ctx, rpb):
    B, H, S, Dh = q.shape
    rows = S // GRID_W
    win_r = min(MAX_WIN_R, rows)
    scale = HEAD_DIM ** -0.5
    qg = q.reshape(B, H, rows, GRID_W, Dh)
    kg = k.reshape(B, H, rows, GRID_W, Dh)
    vg = v.reshape(B, H, rows, GRID_W, Dh)
    cols = jnp.arange(GRID_W)
    col_start = jnp.clip(cols - WIN_C // 2, 0, GRID_W - WIN_C)
    col_idx = col_start[:, None] + jnp.arange(WIN_C)[None, :]
    dc_idx = col_idx - cols[:, None] + (WIN_C - 1)

    def one_row(r):
        r_start = jnp.clip(r - win_r // 2, 0, rows - win_r)
        q_r = lax.dynamic_index_in_dim(qg, r, axis=2, keepdims=False)
        k_band = lax.dynamic_slice_in_dim(kg, r_start, win_r, axis=2)
        v_band = lax.dynamic_slice_in_dim(vg, r_start, win_r, axis=2)
        k_nb = k_band[:, :, :, col_idx, :]
        v_nb = v_band[:, :, :, col_idx, :]
        dr_idx = r_start + jnp.arange(win_r) - r + (MAX_WIN_R - 1)
        bias = rpb[:, dr_idx[:, None, None], dc_idx[None, :, :]]
        bias = bias.transpose(0, 2, 1, 3).reshape(H, GRID_W, win_r * WIN_C).astype(jnp.float32)
        s_loc = jnp.einsum('bhqd,bhiqjd->bhqij', q_r, k_nb).reshape(B, H, GRID_W, win_r * WIN_C)
        s_ctx = jnp.einsum('bhqd,bhld->bhql', q_r, k_ctx)
        logits = jnp.concatenate([s_loc.astype(jnp.float32) * scale + bias,
                                  s_ctx.astype(jnp.float32) * scale], axis=-1)
        p = jax.nn.softmax(logits, axis=-1).astype(v.dtype)
        n_loc = win_r * WIN_C
        p_loc = p[..., :n_loc].reshape(B, H, GRID_W, win_r, WIN_C)
        p_ctx = p[..., n_loc:]
        return (jnp.einsum('bhqij,bhiqjd->bhqd', p_loc, v_nb)
                + jnp.einsum('bhql,bhld->bhqd', p_ctx, v_ctx))

    out = lax.map(one_row, jnp.arange(rows))
    return out.transpose(1, 2, 0, 3, 4).reshape(B, H, S, Dh)


def _latent_mixer(h, k_ctx, v_ctx, w_in, q_gain, k_gain, rpb, w_f_out, w_a_out, w_out):
    S = h.shape[1]
    u_f, z_f, q, k, v, z_a, g_f, g_a = jnp.split(h @ w_in, SPLIT_POINTS, axis=-1)
    cos, sin = _axial_rope(S)
    q = _apply_rope(_qk_norm(_heads(q), q_gain), cos, sin)
    k = _apply_rope(_qk_norm(_heads(k), k_gain), cos, sin)
    o = _merge_heads(_neighbourhood_attention(q, k, _heads(v), k_ctx, v_ctx, rpb))
    return _merge_branches(u_f, z_f, o, z_a, g_f, g_a, w_f_out, w_a_out, w_out)


def _context_kv(h_ctx, w_in, k_gain):
    k, v = jnp.split(h_ctx @ w_in[:, OFF_K:OFF_ZA], [ATTN_WIDTH], axis=-1)
    return _qk_norm(_heads(k), k_gain), _heads(v)


def _context_mixer(h_ctx, w_in, q_gain, k_gain, w_f_out, w_a_out, w_out):
    u_f, z_f, q, k, v, z_a, g_f, g_a = jnp.split(h_ctx @ w_in, SPLIT_POINTS, axis=-1)
    q = _qk_norm(_heads(q), q_gain)
    k = _qk_norm(_heads(k), k_gain)
    v = _heads(v)
    logits = jnp.einsum('bhqd,bhkd->bhqk', q, k).astype(jnp.float32) * (HEAD_DIM ** -0.5)
    p = jax.nn.softmax(logits, axis=-1).astype(v.dtype)
    o = _merge_heads(jnp.einsum('bhqk,bhkd->bhqd', p, v))
    return _merge_branches(u_f, z_f, o, z_a, g_f, g_a, w_f_out, w_a_out, w_out), k, v


def setup_inputs(seed: int = 0) -> dict:
    key = jax.random.key(seed)
    ks = jax.random.split(key, 14)
    f32 = jnp.float32
    nrm = lambda k, shape, s: jax.random.normal(k, shape, f32) * s
    return {
        "x": nrm(ks[0], (BATCH, SEQ, D_MODEL), 1.0),
        "c": nrm(ks[1], (BATCH, D_MODEL), 1.0),
        "ctx": nrm(ks[2], (BATCH, CTX_LEN, D_MODEL), 1.0),
        "c_ctx": nrm(ks[3], (D_MODEL,), 1.0),
        "w_mod": nrm(ks[4], (DEPTH, D_MODEL, 3 * D_MODEL), D_MODEL ** -0.5),
        "b_mod": nrm(ks[5], (DEPTH, 3 * D_MODEL), 0.02),
        "w_in": nrm(ks[6], (DEPTH, D_MODEL, IN_WIDTH), D_MODEL ** -0.5),
        "q_gain": 1.0 + nrm(ks[7], (DEPTH, HEAD_DIM), 0.02),
        "k_gain": 1.0 + nrm(ks[8], (DEPTH, HEAD_DIM), 0.02),
        "rpb": nrm(ks[9], (DEPTH, N_HEADS, 2 * MAX_WIN_R - 1, 2 * WIN_C - 1), 0.1),
        "w_f_out": nrm(ks[10], (DEPTH, F_WIDTH, D_MODEL), F_WIDTH ** -0.5),
        "w_a_out": nrm(ks[11], (DEPTH, ATTN_WIDTH, D_MODEL), ATTN_WIDTH ** -0.5),
        "w_out": nrm(ks[12], (DEPTH, D_MODEL, D_MODEL), D_MODEL ** -0.5),
    }


def reference(x, c, ctx, c_ctx, w_mod, b_mod, w_in, q_gain, k_gain, rpb, w_f_out, w_a_out, w_out):
    silu_c = jax.nn.silu(c)
    silu_cc = jax.nn.silu(c_ctx)
    for l in range(DEPTH):
        mod_x = silu_c @ w_mod[l] + b_mod[l]
        mod_c = silu_cc @ w_mod[l] + b_mod[l]
        shift_x, scale_x, gate_x = jnp.split(mod_x[:, None, :], 3, axis=-1)
        shift_c, scale_c, gate_c = jnp.split(mod_c, 3, axis=-1)
        h_ctx = _rms(ctx) * (1.0 + scale_c) + shift_c
        h_x = _rms(x) * (1.0 + scale_x) + shift_x
        if l < DEPTH - 1:
            y_ctx, k_ctx, v_ctx = _context_mixer(h_ctx, w_in[l], q_gain[l], k_gain[l],
                                                 w_f_out[l], w_a_out[l], w_out[l])
            ctx_next = ctx + gate_c * y_ctx
        else:
            k_ctx, v_ctx = _context_kv(h_ctx, w_in[l], k_gain[l])
            ctx_next = ctx
        y_x = _latent_mixer(h_x, k_ctx, v_ctx, w_in[l], q_gain[l], k_gain[l], rpb[l],
                            w_f_out[l], w_a_out[l], w_out[l])
        x = x + gate_x * y_x
        ctx = ctx_next
    return x
```

```cpp
#include <hip/hip_runtime.h>
#include <stdint.h>
#include <string.h>

typedef unsigned short bf16_t;
typedef short bf16x8 __attribute__((ext_vector_type(8)));
typedef float f32x4 __attribute__((ext_vector_type(4)));
typedef unsigned u32x4 __attribute__((ext_vector_type(4)));
typedef unsigned u32x2 __attribute__((ext_vector_type(2)));

constexpr int D = 2048, NB = 8, S = 2048, L = 256, NH = 16, HD = 128, FW = 1024, INW = 14336;
constexpr int OFF_ZF = 1024, OFF_Q = 2048, OFF_K = 4096, OFF_V = 6144, OFF_ZA = 8192, OFF_GF = 10240, OFF_GA = 12288;
constexpr size_t MiB = 1u << 20;
constexpr size_t WS_WIN = 0, WS_WF = 56 * MiB, WS_WA = 60 * MiB, WS_WO = 68 * MiB, WS_H = 76 * MiB, WS_HC = 140 * MiB,
                 WS_MOD = 148 * MiB, WS_MODP = 149 * MiB, WS_ROPE = 152 * MiB, WS_DFTA = 154 * MiB, WS_CS = 170 * MiB,
                 WS_RAW = 172 * MiB, WS_RAWC = 228 * MiB, WS_PQT = 230 * MiB, WS_MF = 238 * MiB, WS_OA = 242 * MiB,
                 WS_Y = 250 * MiB, WS_YB = 266 * MiB, WS_END = 274 * MiB;

__device__ __forceinline__ unsigned f2bf(float f) { unsigned u = __float_as_uint(f); return (u + 0x7fffu + ((u >> 16) & 1u)) >> 16; }
__device__ __forceinline__ float bf2f(unsigned h) { return __uint_as_float(h << 16); }
__device__ __forceinline__ float silu_f(float z) { return z / (1.0f + expf(-z)); }
__device__ __forceinline__ float sigm_f(float z) { return 1.0f / (1.0f + expf(-z)); }
__device__ __forceinline__ float wave_sum(float v) {
#pragma unroll
    for (int o = 1; o < 64; o <<= 1) v += __shfl_xor(v, o);
    return v;
}
__device__ __forceinline__ float wave_max(float v) {
#pragma unroll
    for (int o = 1; o < 64; o <<= 1) v = fmaxf(v, __shfl_xor(v, o));
    return v;
}

__global__ void k_tables(float2* rope, bf16_t* CS, bf16_t* DFTA) {
    const size_t gid = (size_t)blockIdx.x * blockDim.x + threadIdx.x;
    if (gid < 64 * 32) {
        const int pos = (int)(gid >> 5), j = (int)(gid & 31);
        const double inv = pow(10000.0, -(double)j / 32.0);
        const float invf = (float)inv;
        const float ang = (float)pos * invf;
        rope[gid] = make_float2((float)cos((double)ang), (float)sin((double)ang));
    }
    if (gid < 2 * 256 * 256) {
        const int part = (int)(gid >> 16), cp = (int)((gid >> 8) & 255), c = (int)(gid & 255);
        const int m = (cp * c) & 255;
        const double a = 2.0 * 3.14159265358979323846 * (double)m / 256.0;
        const double v = (part == 0 ? cos(a) : sin(a)) / 16.0;
        CS[gid] = (bf16_t)f2bf((float)v);
    }
    if (gid < (size_t)2048 * 4096) {
        const int k1 = (int)(gid >> 12), kk = (int)(gid & 4095), part = kk >> 11, n = kk & 2047;
        const int m = (k1 * n) & 2047;
        const double a = 2.0 * 3.14159265358979323846 * (double)m / 2048.0;
        const double v = (part == 0 ? cos(a) : -sin(a)) / 45.254833995939045;
        DFTA[gid] = (bf16_t)f2bf((float)v);
    }
}

__global__ __launch_bounds__(256) void k_mod(const float* c, const float* cctx, const float* wmod, float* part) {
    __shared__ float s[9][256];
    const int j = blockIdx.x * 256 + threadIdx.x, ky = blockIdx.y, k0 = ky * 256;
    for (int b = 0; b < 9; ++b) { const float v = (b < 8) ? c[b * D + k0 + threadIdx.x] : cctx[k0 + threadIdx.x]; s[b][threadIdx.x] = silu_f(v); }
    __syncthreads();
    float acc[9];
#pragma unroll
    for (int b = 0; b < 9; ++b) acc[b] = 0.f;
    for (int k = 0; k < 256; ++k) {
        const float w = wmod[(size_t)(k0 + k) * (3 * D) + j];
#pragma unroll
        for (int b = 0; b < 9; ++b) acc[b] += s[b][k] * w;
    }
#pragma unroll
    for (int b = 0; b < 9; ++b) part[((size_t)ky * 9 + b) * (3 * D) + j] = acc[b];
}
__global__ void k_modfin(const float* part, const float* bmod, float* mod) {
    const int i = blockIdx.x * blockDim.x + threadIdx.x;
    if (i >= 9 * 3 * D) return;
    float a = bmod[i % (3 * D)];
    for (int ky = 0; ky < 8; ++ky) a += part[(size_t)ky * 9 * 3 * D + i];
    mod[i] = a;
}

__global__ __launch_bounds__(256) void k_hnorm(const float* x, const float* ctx, const float* mod, bf16_t* H, bf16_t* Hc) {
    const int wid = threadIdx.x >> 6, lane = threadIdx.x & 63;
    const int row = blockIdx.x * 4 + wid;
    const float* src; bf16_t* dst; int mb;
    if (row < NB * S) { src = x + (size_t)row * D; dst = H + (size_t)row * D; mb = row / S; }
    else { const int r2 = row - NB * S; src = ctx + (size_t)r2 * D; dst = Hc + (size_t)r2 * D; mb = 8; }
    const float* shift = mod + (size_t)mb * 3 * D; const float* scale = shift + D;
    f32x4 v[8]; float ss = 0.f;
#pragma unroll
    for (int j = 0; j < 8; ++j) { v[j] = *(const f32x4*)(src + (j * 64 + lane) * 4); ss += v[j][0] * v[j][0] + v[j][1] * v[j][1] + v[j][2] * v[j][2] + v[j][3] * v[j][3]; }
    ss = wave_sum(ss);
    const float rstd = 1.0f / sqrtf(ss * (1.0f / D) + 1e-6f);
#pragma unroll
    for (int j = 0; j < 8; ++j) {
        const int k = (j * 64 + lane) * 4;
        const f32x4 sc = *(const f32x4*)(scale + k), sh = *(const f32x4*)(shift + k);
        u32x2 o;
        o[0] = f2bf(v[j][0] * rstd * (1.f + sc[0]) + sh[0]) | (f2bf(v[j][1] * rstd * (1.f + sc[1]) + sh[1]) << 16);
        o[1] = f2bf(v[j][2] * rstd * (1.f + sc[2]) + sh[2]) | (f2bf(v[j][3] * rstd * (1.f + sc[3]) + sh[3]) << 16);
        *(u32x2*)(dst + k) = o;
    }
}

__global__ __launch_bounds__(256) void k_wconv(const float* W, int K, int N, bf16_t* WT) {
    __shared__ float t[64][65];
    const int n0 = blockIdx.x * 64, k0 = blockIdx.y * 64, tx = threadIdx.x & 63, ty = threadIdx.x >> 6;
    for (int r = ty; r < 64; r += 4) t[r][tx] = W[(size_t)(k0 + r) * N + n0 + tx];
    __syncthreads();
    for (int r = ty; r < 64; r += 4) WT[(size_t)(n0 + r) * K + k0 + tx] = (bf16_t)f2bf(t[tx][r]);
}

struct GemmP {
    const bf16_t* A; const bf16_t* Bt; int lda, ldb, M, N, K;
    int zdiv; long sA0, sA1, sB0, sB1, sC0, sC1;
    void* C; int ldc; const void* aux0; const void* aux1; int ldaux;
};
template <int MODE> __global__ __launch_bounds__(256) void k_gemm(GemmP p) {
    __shared__ __attribute__((aligned(16))) bf16_t sA[128][40];
    __shared__ __attribute__((aligned(16))) bf16_t sB[128][40];
    const int tid = threadIdx.x, wid = tid >> 6, lane = tid & 63, fr = lane & 15, fq = lane >> 4, wm = wid >> 1, wn = wid & 1;
    const int z0 = blockIdx.z % p.zdiv, z1 = blockIdx.z / p.zdiv;
    const bf16_t* A = p.A + z0 * p.sA0 + z1 * p.sA1; const bf16_t* Bt = p.Bt + z0 * p.sB0 + z1 * p.sB1;
    const long coff = z0 * p.sC0 + z1 * p.sC1;
    const int m0 = blockIdx.y * 128, n0 = blockIdx.x * 128;
    f32x4 acc[4][4];
#pragma unroll
    for (int i = 0; i < 4; ++i)
#pragma unroll
        for (int j = 0; j < 4; ++j) acc[i][j] = (f32x4){0.f, 0.f, 0.f, 0.f};
    for (int k0 = 0; k0 < p.K; k0 += 32) {
#pragma unroll
        for (int i = 0; i < 2; ++i) {
            const int c = tid + i * 256, row = c >> 2, kc = c & 3;
            *(u32x4*)&sA[row][kc * 8] = *(const u32x4*)(A + (size_t)(m0 + row) * p.lda + k0 + kc * 8);
            *(u32x4*)&sB[row][kc * 8] = *(const u32x4*)(Bt + (size_t)(n0 + row) * p.ldb + k0 + kc * 8);
        }
        __syncthreads();
        bf16x8 af[4], bfr[4];
#pragma unroll
        for (int i = 0; i < 4; ++i) { af[i] = *(const bf16x8*)&sA[wm * 64 + i * 16 + fr][fq * 8]; bfr[i] = *(const bf16x8*)&sB[wn * 64 + i * 16 + fr][fq * 8]; }
#pragma unroll
        for (int i = 0; i < 4; ++i)
#pragma unroll
            for (int j = 0; j < 4; ++j) acc[i][j] = __builtin_amdgcn_mfma_f32_16x16x32_bf16(bfr[j], af[i], acc[i][j], 0, 0, 0);
        __syncthreads();
    }
#pragma unroll
    for (int i = 0; i < 4; ++i)
#pragma unroll
        for (int j = 0; j < 4; ++j) {
            const int row = m0 + wm * 64 + i * 16 + fr, col = n0 + wn * 64 + j * 16 + fq * 4;
            const f32x4 v = acc[i][j];
            const size_t ci = (size_t)coff + (size_t)row * p.ldc + col;
            if (MODE == 0) {
                u32x2 o; o[0] = f2bf(v[0]) | (f2bf(v[1]) << 16); o[1] = f2bf(v[2]) | (f2bf(v[3]) << 16);
                *(u32x2*)((bf16_t*)p.C + ci) = o;
            } else if (MODE == 1) {
                const u32x2 z = *(const u32x2*)((const bf16_t*)p.aux0 + (size_t)row * p.ldaux + col);
                const float z0f = bf2f(z[0] & 0xffff), z1f = bf2f(z[0] >> 16), z2f = bf2f(z[1] & 0xffff), z3f = bf2f(z[1] >> 16);
                u32x2 o; o[0] = f2bf(v[0] * silu_f(z0f)) | (f2bf(v[1] * silu_f(z1f)) << 16); o[1] = f2bf(v[2] * silu_f(z2f)) | (f2bf(v[3] * silu_f(z3f)) << 16);
                *(u32x2*)((bf16_t*)p.C + ci) = o;
            } else if (MODE == 2) {
                const u32x2 z = *(const u32x2*)((const bf16_t*)p.aux0 + (size_t)row * p.ldaux + col);
                f32x4 o; o[0] = v[0] * sigm_f(bf2f(z[0] & 0xffff)); o[1] = v[1] * sigm_f(bf2f(z[0] >> 16)); o[2] = v[2] * sigm_f(bf2f(z[1] & 0xffff)); o[3] = v[3] * sigm_f(bf2f(z[1] >> 16));
                *(f32x4*)((float*)p.C + ci) = o;
            } else if (MODE == 3) {
                const u32x2 z = *(const u32x2*)((const bf16_t*)p.aux0 + (size_t)row * p.ldaux + col);
                const f32x4 y = *(const f32x4*)((const float*)p.aux1 + (size_t)row * p.ldc + col);
                const float o0 = y[0] + v[0] * sigm_f(bf2f(z[0] & 0xffff)), o1 = y[1] + v[1] * sigm_f(bf2f(z[0] >> 16)), o2 = y[2] + v[2] * sigm_f(bf2f(z[1] & 0xffff)), o3 = y[3] + v[3] * sigm_f(bf2f(z[1] >> 16));
                u32x2 o; o[0] = f2bf(o0) | (f2bf(o1) << 16); o[1] = f2bf(o2) | (f2bf(o3) << 16);
                *(u32x2*)((bf16_t*)p.C + ci) = o;
            } else {
                const f32x4 xv = *(const f32x4*)((const float*)p.aux0 + (size_t)row * p.ldc + col);
                const f32x4 g = *(const f32x4*)((const float*)p.aux1 + col);
                f32x4 o; o[0] = xv[0] + g[0] * v[0]; o[1] = xv[1] + g[1] * v[1]; o[2] = xv[2] + g[2] * v[2]; o[3] = xv[3] + g[3] * v[3];
                *(f32x4*)((float*)p.C + ci) = o;
            }
        }
}

__global__ __launch_bounds__(256) void k_qknorm(bf16_t* RAW, bf16_t* RAWc, const float* qg, const float* kg, const float2* rope) {
    const int wid = threadIdx.x >> 6, lane = threadIdx.x & 63;
    const int gw = blockIdx.x * 4 + wid;
    bf16_t* p; const float* gain; bool do_rope; int t = 0;
    if (gw < S * 32) { t = gw >> 5; const int wh = gw & 31, which = wh >> 4, h = wh & 15; p = RAW + (size_t)t * INW + (which ? OFF_K : OFF_Q) + h * HD; gain = which ? kg : qg; do_rope = true; }
    else { const int g2 = gw - S * 32; const int tr = g2 >> 4, h = g2 & 15; p = RAWc + (size_t)tr * 4096 + h * HD; gain = kg; do_rope = false; }
    const int a = lane >> 5, j = lane & 31, d0 = a * 64 + j, d1 = d0 + 32;
    float x0 = bf2f(p[d0]), x1 = bf2f(p[d1]);
    const float ss = wave_sum(x0 * x0 + x1 * x1);
    const float rstd = 1.0f / sqrtf(ss * (1.0f / HD) + 1e-6f);
    x0 = x0 * rstd * gain[d0]; x1 = x1 * rstd * gain[d1];
    if (do_rope) {
        const int pos = a == 0 ? (t >> 6) : (t & 63);
        const float2 cs = rope[pos * 32 + j];
        const float y0 = x0 * cs.x - x1 * cs.y, y1 = x1 * cs.x + x0 * cs.y;
        x0 = y0; x1 = y1;
    }
    p[d0] = (bf16_t)f2bf(x0); p[d1] = (bf16_t)f2bf(x1);
}

__global__ __launch_bounds__(256) void k_attn(const bf16_t* RAW, const bf16_t* RAWc, const float* rpb, bf16_t* OA) {
    __shared__ __attribute__((aligned(16))) float sq[4][128];
    __shared__ float sp[4][384];
    const int wid = threadIdx.x >> 6, lane = threadIdx.x & 63;
    const int gw = blockIdx.x * 4 + wid, h = gw >> 11, t = gw & 2047;
    const int r = t >> 6, c = t & 63;
    const int rs = min(max(r - 4, 0), 24), cs = min(max(c - 8, 0), 48);
    const bf16_t* qrow = RAW + (size_t)t * INW + OFF_Q + h * HD;
    sq[wid][lane * 2] = bf2f(qrow[lane * 2]); sq[wid][lane * 2 + 1] = bf2f(qrow[lane * 2 + 1]);
    __syncthreads();
    float lg[6]; float mx = -1e30f;
#pragma unroll
    for (int i = 0; i < 6; ++i) {
        const int tk = lane + 64 * i;
        const bf16_t* krow; float bias = 0.f;
        if (tk < 128) { const int kr = rs + (tk >> 4), kc = cs + (tk & 15); krow = RAW + (size_t)(kr * 64 + kc) * INW + OFF_K + h * HD; bias = rpb[(h * 15 + (kr - r + 7)) * 31 + (kc - c + 15)]; }
        else krow = RAWc + (size_t)(tk - 128) * 4096 + h * HD;
        float dot = 0.f;
#pragma unroll
        for (int dd = 0; dd < 16; ++dd) {
            const u32x4 kv = *(const u32x4*)(krow + dd * 8);
            const f32x4 q0 = *(const f32x4*)&sq[wid][dd * 8], q1 = *(const f32x4*)&sq[wid][dd * 8 + 4];
            dot += q0[0] * bf2f(kv[0] & 0xffff) + q0[1] * bf2f(kv[0] >> 16) + q0[2] * bf2f(kv[1] & 0xffff) + q0[3] * bf2f(kv[1] >> 16)
                 + q1[0] * bf2f(kv[2] & 0xffff) + q1[1] * bf2f(kv[2] >> 16) + q1[2] * bf2f(kv[3] & 0xffff) + q1[3] * bf2f(kv[3] >> 16);
        }
        lg[i] = dot * 0.08838834764831845f + bias;
        mx = fmaxf(mx, lg[i]);
    }
    mx = wave_max(mx);
    float sum = 0.f;
#pragma unroll
    for (int i = 0; i < 6; ++i) { lg[i] = expf(lg[i] - mx); sum += lg[i]; }
    sum = wave_sum(sum);
    const float inv = 1.0f / sum;
#pragma unroll
    for (int i = 0; i < 6; ++i) sp[wid][lane + 64 * i] = lg[i] * inv;
    __syncthreads();
    float o0 = 0.f, o1 = 0.f; const int d = lane * 2;
    for (int tk = 0; tk < 384; ++tk) {
        const bf16_t* vrow;
        if (tk < 128) { const int kr = rs + (tk >> 4), kc = cs + (tk & 15); vrow = RAW + (size_t)(kr * 64 + kc) * INW + OFF_V + h * HD; }
        else vrow = RAWc + (size_t)(tk - 128) * 4096 + 2048 + h * HD;
        const unsigned vv = *(const unsigned*)(vrow + d);
        const float pw = sp[wid][tk];
        o0 += pw * bf2f(vv & 0xffff); o1 += pw * bf2f(vv >> 16);
    }
    const unsigned zz = *(const unsigned*)(RAW + (size_t)t * INW + OFF_ZA + h * HD + d);
    const unsigned ov = f2bf(o0 * silu_f(bf2f(zz & 0xffff))) | (f2bf(o1 * silu_f(bf2f(zz >> 16))) << 16);
    *(unsigned*)(OA + (size_t)t * D + h * HD + d) = ov;
}

template <int MODE> static void run_gemm(hipStream_t st, const bf16_t* A, int lda, const bf16_t* Bt, int ldb, int M, int N, int K, void* C, int ldc,
                                         const void* aux0 = nullptr, const void* aux1 = nullptr, int ldaux = 0, int nz = 1, int zdiv = 1,
                                         long sA0 = 0, long sA1 = 0, long sB0 = 0, long sB1 = 0, long sC0 = 0, long sC1 = 0) {
    GemmP p; memset(&p, 0, sizeof(p)); p.A = A; p.Bt = Bt; p.lda = lda; p.ldb = ldb; p.M = M; p.N = N; p.K = K; p.zdiv = zdiv; p.sA0 = sA0; p.sA1 = sA1; p.sB0 = sB0; p.sB1 = sB1; p.sC0 = sC0; p.sC1 = sC1;
    p.C = C; p.ldc = ldc; p.aux0 = aux0; p.aux1 = aux1; p.ldaux = ldaux;
    hipLaunchKernelGGL(k_gemm<MODE>, dim3(N / 128, M / 128, nz), dim3(256), 0, st, p);
}

extern "C" void kernel_launch(void* const* d_in, const int* in_sizes, int n_in, void* d_out, int out_size, void* d_ws, size_t ws_size, hipStream_t stream) {
    const float* x = (const float*)d_in[0]; const float* c = (const float*)d_in[1]; const float* ctx = (const float*)d_in[2]; const float* cctx = (const float*)d_in[3];
    const float* wmod = (const float*)d_in[4]; const float* bmod = (const float*)d_in[5]; const float* win = (const float*)d_in[6];
    const float* qg = (const float*)d_in[7]; const float* kg = (const float*)d_in[8]; const float* rpb = (const float*)d_in[9];
    const float* wf = (const float*)d_in[10]; const float* wa = (const float*)d_in[11]; const float* wo = (const float*)d_in[12];
    float* out = (float*)d_out; unsigned char* ws = (unsigned char*)d_ws;
    if (ws_size < WS_END) return;
    bf16_t* Win_t = (bf16_t*)(ws + WS_WIN); bf16_t* Wf_t = (bf16_t*)(ws + WS_WF); bf16_t* Wa_t = (bf16_t*)(ws + WS_WA); bf16_t* Wo_t = (bf16_t*)(ws + WS_WO);
    bf16_t* H = (bf16_t*)(ws + WS_H); bf16_t* Hc = (bf16_t*)(ws + WS_HC); float* mod = (float*)(ws + WS_MOD); float* modp = (float*)(ws + WS_MODP);
    float2* rope = (float2*)(ws + WS_ROPE); bf16_t* DFTA = (bf16_t*)(ws + WS_DFTA); bf16_t* CS = (bf16_t*)(ws + WS_CS);
    bf16_t* RAW = (bf16_t*)(ws + WS_RAW); bf16_t* RAWc = (bf16_t*)(ws + WS_RAWC); bf16_t* PQt = (bf16_t*)(ws + WS_PQT); bf16_t* MF = (bf16_t*)(ws + WS_MF);
    bf16_t* OA = (bf16_t*)(ws + WS_OA); float* Y = (float*)(ws + WS_Y); bf16_t* Yb = (bf16_t*)(ws + WS_YB);

    hipLaunchKernelGGL(k_tables, dim3((2048 * 4096) / 256), dim3(256), 0, stream, rope, CS, DFTA);
    hipLaunchKernelGGL(k_mod, dim3(24, 8), dim3(256), 0, stream, c, cctx, wmod, modp);
    hipLaunchKernelGGL(k_modfin, dim3((9 * 3 * D + 255) / 256), dim3(256), 0, stream, modp, bmod, mod);
    hipLaunchKernelGGL(k_hnorm, dim3((NB * S + NB * L) / 4), dim3(256), 0, stream, x, ctx, mod, H, Hc);
    hipLaunchKernelGGL(k_wconv, dim3(INW / 64, D / 64), dim3(256), 0, stream, win, D, INW, Win_t);
    hipLaunchKernelGGL(k_wconv, dim3(D / 64, FW / 64), dim3(256), 0, stream, wf, FW, D, Wf_t);
    hipLaunchKernelGGL(k_wconv, dim3(D / 64, D / 64), dim3(256), 0, stream, wa, D, D, Wa_t);
    hipLaunchKernelGGL(k_wconv, dim3(D / 64, D / 64), dim3(256), 0, stream, wo, D, D, Wo_t);
    for (int b = 0; b < NB; ++b) {
        run_gemm<0>(stream, H + (size_t)b * S * D, D, Win_t, D, S, INW, D, RAW, INW);
        run_gemm<0>(stream, Hc + (size_t)b * L * D, D, Win_t + (size_t)OFF_K * D, D, L, 4096, D, RAWc, 4096);
        hipLaunchKernelGGL(k_qknorm, dim3((S * 32 + L * 16) / 4), dim3(256), 0, stream, RAW, RAWc, qg, kg, rope);
        hipLaunchKernelGGL(k_attn, dim3(NH * S / 4), dim3(256), 0, stream, RAW, RAWc, rpb, OA);
        run_gemm<0>(stream, CS, 256, RAW, INW, 256, S, 256, PQt, 4096, nullptr, nullptr, 0, 8, 2, 65536, 0, 0, 256, 2048, (long)256 * 4096);
        run_gemm<1>(stream, DFTA, 4096, PQt, 4096, S, FW, 4096, MF, FW, RAW + OFF_ZF, nullptr, INW);
        run_gemm<2>(stream, MF, FW, Wf_t, FW, S, D, FW, Y, D, RAW + OFF_GF, nullptr, INW);
        run_gemm<3>(stream, OA, D, Wa_t, D, S, D, D, Yb, D, RAW + OFF_GA, Y, INW);
        run_gemm<4>(stream, Yb, D, Wo_t, D, S, D, D, out + (size_t)b * S * D, D, x + (size_t)b * S * D, mod + (size_t)b * 3 * D + 2 * D, 0);
    }
}
```

```cpp
#include <hip/hip_runtime.h>
#include <stdint.h>
#include <string.h>
#include <stdio.h>

typedef unsigned short bf16_t;
typedef short bf16x8 __attribute__((ext_vector_type(8)));
typedef float f32x4 __attribute__((ext_vector_type(4)));
typedef unsigned u32x4 __attribute__((ext_vector_type(4)));
typedef unsigned u32x2 __attribute__((ext_vector_type(2)));

constexpr int D = 2048, NB = 8, S = 2048, L = 256, NH = 16, HD = 128, FW = 1024, INW = 14336;
constexpr int OFF_ZF = 1024, OFF_Q = 2048, OFF_K = 4096, OFF_V = 6144, OFF_ZA = 8192, OFF_GF = 10240, OFF_GA = 12288;
constexpr size_t MiB = 1u << 20;
constexpr float QSCALE = 0.08838834764831845f * 1.4426950408889634f;
constexpr size_t WS_UZ = 0, WS_Q = 64 * MiB, WS_K = 128 * MiB, WS_V = 192 * MiB, WS_SZA = 256 * MiB, WS_SGF = 320 * MiB, WS_SGA = 384 * MiB,
                 WS_KC = 448 * MiB, WS_VC = 456 * MiB, WS_WFA = 464 * MiB, WS_WO = 476 * MiB, WS_DFTA = 484 * MiB,
                 WS_CTL = 500 * MiB, WS_MOD = 501 * MiB, WS_ROPE = 502 * MiB, WS_CS = 503 * MiB, WS_MODP = 504 * MiB, WS_END = 512 * MiB;
constexpr size_t DO_H = 0, DO_HC = 64 * MiB, DO_WIN = 72 * MiB, DO_PQT = 0;

__device__ __forceinline__ unsigned f2bf(float f) { unsigned u = __float_as_uint(f); return (u + 0x7fffu + ((u >> 16) & 1u)) >> 16; }
__device__ __forceinline__ float bf2f(unsigned h) { return __uint_as_float(h << 16); }
__device__ __forceinline__ float silu_f(float z) { return z / (1.0f + expf(-z)); }
__device__ __forceinline__ float sigm_f(float z) { return 1.0f / (1.0f + expf(-z)); }
__device__ __forceinline__ float wave_sum(float v) {
#pragma unroll
    for (int o = 1; o < 64; o <<= 1) v += __shfl_xor(v, o);
    return v;
}
__device__ __forceinline__ float wave_max(float v) {
#pragma unroll
    for (int o = 1; o < 64; o <<= 1) v = fmaxf(v, __shfl_xor(v, o));
    return v;
}

#define LAS __attribute__((address_space(3)))
#define GAS __attribute__((address_space(1)))
typedef GAS unsigned gu32;
#define RLX_AGENT __ATOMIC_RELAXED, __HIP_MEMORY_SCOPE_AGENT
#define LDS_WAIT() asm volatile("s_waitcnt lgkmcnt(0)" ::: "memory")
#define VM_WAIT() asm volatile("s_waitcnt vmcnt(0)" ::: "memory")
constexpr int NWAVES = 8;
constexpr int RING_BYTES = 131072, LDSCTL_OFF = RING_BYTES, MISC_OFF = LDSCTL_OFF + 320, XCH_OFF = LDSCTL_OFF + 1024, LDS_BYTES = 147456;
constexpr int CW_BAR = 4096;

#define XB_TMO      128
#define XB_XCNT(j)  (256  + 64 * (j))
#define XB_XSUB(j)  (1280 + 64 * (j))
#define XB_XGEN(j)  (2304 + 64 * (j))
#define XB_TOP      3328
#define XB_TOPGEN   3392
#define XCD_BAR_WORDS 3456
#define XB_SPIN_CAP (1u << 18)
__device__ __forceinline__ unsigned xb_ld(unsigned* p)              { return __hip_atomic_load(p, __ATOMIC_RELAXED, __HIP_MEMORY_SCOPE_AGENT); }
__device__ __forceinline__ unsigned xb_add(unsigned* p, unsigned v) { return __hip_atomic_fetch_add(p, v, __ATOMIC_RELAXED, __HIP_MEMORY_SCOPE_AGENT); }
__device__ __forceinline__ unsigned xb_xcc_id() { return (unsigned)__builtin_amdgcn_s_getreg((3 << 11) | 20) & 0xFu; }
#define XB_SPIN(cond, bar) do { unsigned _sp = 0; while (cond) { __builtin_amdgcn_s_sleep(1); \
    if ((++_sp & 255u) == 0u) { if (xb_ld(&(bar)[XB_TMO])) break; if (_sp > XB_SPIN_CAP) { atomicAdd(&(bar)[XB_TMO], 1u); break; } } } } while (0)
struct XcdBarrier { unsigned* bar; unsigned x; volatile LAS unsigned* st; };
__device__ __forceinline__ XcdBarrier xcd_barrier_post(unsigned* bar, volatile LAS unsigned* st) {
    XcdBarrier b; b.bar = bar; b.x = xb_xcc_id(); b.st = st;
    if (threadIdx.x == 0) (void)xb_add(&bar[XB_XCNT(b.x)], 1u);
    return b;
}
__device__ __forceinline__ void xcd_barrier_complete(unsigned* bar, unsigned x, unsigned& nloc, unsigned& nx) {
    const unsigned G = gridDim.x * gridDim.y * gridDim.z;
    unsigned sum, cnt, mine, sp = 0u;
    for (;;) {
        sum = 0u; cnt = 0u; mine = 0u;
#pragma unroll
        for (unsigned j = 0; j < 16; ++j) { const unsigned c = xb_ld(&bar[XB_XCNT(j)]); sum += c; cnt += (c > 0u) ? 1u : 0u; mine = (j == x) ? c : mine; }
        if (sum == G) break;
        __builtin_amdgcn_s_sleep(1);
        if ((++sp & 255u) == 0u) { if (xb_ld(&bar[XB_TMO])) break; if (sp > XB_SPIN_CAP) { atomicAdd(&bar[XB_TMO], 1u); break; } }
    }
    nloc = mine > 0u ? mine : 1u; nx = cnt > 0u ? cnt : 1u;
}
__device__ __forceinline__ void xcd_barrier(const XcdBarrier& b) {
    asm volatile("s_waitcnt vmcnt(0)" ::: "memory");
    __syncthreads();
    if (threadIdx.x == 0) {
        unsigned* bar = b.bar;
        __builtin_amdgcn_s_waitcnt(0);
        unsigned nloc = b.st[0], nx = b.st[1];
        if (nloc == 0u) { xcd_barrier_complete(bar, b.x, nloc, nx); b.st[0] = nloc; b.st[1] = nx; }
        const unsigned old = xb_add(&bar[XB_XSUB(b.x)], 1u);
        const unsigned gen = old / nloc;
        if (old + 1u == (gen + 1u) * nloc) {
            __builtin_amdgcn_fence(__ATOMIC_RELEASE, "agent");
            asm volatile("s_waitcnt vmcnt(0)" ::: "memory");
            const unsigned og = xb_add(&bar[XB_TOP], 1u);
            const unsigned tg = og / nx;
            if (og + 1u == (tg + 1u) * nx) xb_add(&bar[XB_TOPGEN], 1u);
            else XB_SPIN(xb_ld(&bar[XB_TOPGEN]) == tg, bar);
            __builtin_amdgcn_fence(__ATOMIC_ACQUIRE, "agent");
            xb_add(&bar[XB_XGEN(b.x)], 1u);
            asm volatile("s_waitcnt vmcnt(0)" ::: "memory");
        } else {
            XB_SPIN(xb_ld(&bar[XB_XGEN(b.x)]) == gen, bar);
            __builtin_amdgcn_fence(__ATOMIC_ACQUIRE, "agent");
            asm volatile("s_waitcnt vmcnt(0)" ::: "memory");
        }
    }
    __syncthreads();
}

namespace pg8 {
constexpr int BM = 256, BK = 64, HALF = 128, HTB = HALF * BK * 2, STAGE_BYTES = 8 * HTB;
__host__ __device__ __forceinline__ int lds_byte(int r, int c) { const int st = (r >> 4) * 2 + (c >> 5), rr = r & 15, cc = c & 31, ob = rr * 64 + cc * 2; return st * 1024 + (ob ^ (((ob >> 9) & 1) << 5)); }
__host__ __device__ __forceinline__ void stage_rc(int b, int& R, int& C) { const int st = b / 1024, sb = b % 1024, swz = sb ^ (((sb >> 9) & 1) << 5); R = (st >> 1) * 16 + swz / 64; C = (st & 1) * 32 + (swz % 64) / 2; }
__host__ __device__ __forceinline__ int perm32(int rho) { const int n = rho >> 4, i = rho & 15; return 8 * (i >> 2) + 4 * n + (i & 3); }
struct Unit { int pm, pn, x0, x1, nt, keep; long aoff, boff; };
struct Gemm { const bf16_t* A; const bf16_t* Bt; int lda, ldb; };
__device__ __forceinline__ unsigned cvt_pk_bf16(float lo, float hi) { unsigned r; asm volatile("v_cvt_pk_bf16_f32 %0, %1, %2" : "=v"(r) : "v"(lo), "v"(hi)); return r; }

template <class Epi, class Sched>
__device__ __forceinline__ void gemm_phase(LAS unsigned char* lds, const Gemm g, const Sched& S, const Epi& E) {
    const int tid = threadIdx.x, wid = __builtin_amdgcn_readfirstlane(tid >> 6), lane = tid & 63, wr = wid >> 2, wc = wid & 3, fr = lane & 15, fq = lane >> 4;
    unsigned voffA[2], voffB[2];
#pragma unroll
    for (int i = 0; i < 2; ++i) { int R, C; stage_rc(tid * 16 + i * 8192, R, C); const int Rb = 64 * (R >> 5) + perm32(R & 31);
        voffA[i] = (unsigned)(R * g.lda + C) * 2u; voffB[i] = (unsigned)(Rb * g.ldb + C) * 2u; }
    const size_t kstep = (size_t)(BK * 2);
    const size_t hstepA = (size_t)HALF * g.lda * 2, hstepB = (size_t)32 * g.ldb * 2;
    const unsigned ldsw = (unsigned)wid * 1024u;
    const int aoff = lds_byte(wr * 64 + fr, fq * 8), boff = lds_byte(wc * 32 + fr, fq * 8);
#define PG8_SA(b, h) (((b) * 2 + (h)) * HTB)
#define PG8_SB(b, h) ((4 + (b) * 2 + (h)) * HTB)
#define PG8_STAGE(bufoff, gbase, voff) do { _Pragma("unroll") for (int _i = 0; _i < 2; ++_i) \
        __builtin_amdgcn_global_load_lds((const unsigned*)((const char*)(gbase) + (voff)[_i]), (LAS unsigned*)(lds + (bufoff) + ldsw + _i * 8192), 16, 0, 0); } while (0)
#define PG8_LDA(dst, b, h) do { _Pragma("unroll") for (int m = 0; m < 4; ++m) _Pragma("unroll") for (int k = 0; k < 2; ++k) dst[m][k] = *(const LAS bf16x8*)(lds + PG8_SA(b, h) + aoff + m * 2048 + k * 1024); } while (0)
#define PG8_LDB(dst, b, h) do { _Pragma("unroll") for (int n = 0; n < 2; ++n) _Pragma("unroll") for (int k = 0; k < 2; ++k) dst[n][k] = *(const LAS bf16x8*)(lds + PG8_SB(b, h) + boff + n * 2048 + k * 1024); } while (0)
#define PG8_MMA(ai, bj, At, Bt) do { __builtin_amdgcn_s_setprio(1); _Pragma("unroll") for (int m = 0; m < 4; ++m) _Pragma("unroll") for (int n = 0; n < 2; ++n) _Pragma("unroll") for (int k = 0; k < 2; ++k) \
        acc[ai][bj][m][n] = __builtin_amdgcn_mfma_f32_16x16x32_bf16(Bt[n][k], At[m][k], acc[ai][bj][m][n], 0, 0, 0); __builtin_amdgcn_s_setprio(0); } while (0)
#define PG8_WAIT_V(n) asm volatile("s_waitcnt vmcnt(" #n ")" ::: "memory")
#define PG8_WAIT_L(n) asm volatile("s_waitcnt lgkmcnt(" #n ")" ::: "memory")
#define PG8_BAR __builtin_amdgcn_s_barrier()
#define PG8_SCHED __builtin_amdgcn_sched_barrier(0)
    Unit cur, nxt; int ui = 0;
    if (!S.next(0, cur)) return;
    f32x4 acc[2][2][4][2];
#pragma unroll
    for (int a = 0; a < 2; ++a)
#pragma unroll
        for (int b = 0; b < 2; ++b)
#pragma unroll
            for (int m = 0; m < 4; ++m)
#pragma unroll
                for (int n = 0; n < 2; ++n) acc[a][b][m][n] = (f32x4){0.f, 0.f, 0.f, 0.f};
    bf16x8 At[4][2], B0[2][2], B1[2][2];
    const char* cA = (const char*)g.A + cur.aoff; const char* cB = (const char*)g.Bt + cur.boff;
    PG8_STAGE(PG8_SB(0, 0), cB, voffB); PG8_STAGE(PG8_SB(0, 1), cB + hstepB, voffB); PG8_STAGE(PG8_SA(0, 0), cA, voffA); PG8_STAGE(PG8_SA(0, 1), cA + hstepA, voffA);
    if (wr == 1) PG8_BAR;
    PG8_WAIT_V(2); PG8_BAR;
    PG8_STAGE(PG8_SB(1, 0), cB + kstep, voffB); PG8_STAGE(PG8_SA(1, 0), cA + kstep, voffA); PG8_STAGE(PG8_SB(1, 1), cB + hstepB + kstep, voffB);
    PG8_WAIT_V(6); PG8_BAR;
    for (;;) {
        const bool has_next = S.next(ui + 1, nxt);
        const char* nA = has_next ? (const char*)g.A + nxt.aoff : cA; const char* nB = has_next ? (const char*)g.Bt + nxt.boff : cB;
        int nt = cur.nt; asm volatile("" : "+s"(nt));
        for (int t = 0; t < nt; t += 2) {
            const bool last = (t == nt - 2);
            const char* a1 = cA + (size_t)(t + 1) * kstep;
            const char* a2 = last ? nA : cA + (size_t)(t + 2) * kstep; const char* b2 = last ? nB : cB + (size_t)(t + 2) * kstep;
            const char* a3 = a2 + kstep; const char* b3 = b2 + kstep;
            PG8_LDB(B0, 0, 0); PG8_LDB(B1, 0, 1); PG8_SCHED; PG8_LDA(At, 0, 0); PG8_STAGE(PG8_SA(1, 1), a1 + hstepA, voffA);
            PG8_WAIT_V(8); PG8_WAIT_L(0); PG8_BAR; PG8_MMA(0, 0, At, B0); PG8_MMA(0, 1, At, B1); PG8_BAR; PG8_SCHED;
            PG8_LDA(At, 0, 1); PG8_STAGE(PG8_SB(0, 0), b2, voffB); PG8_STAGE(PG8_SB(0, 1), b2 + hstepB, voffB); PG8_STAGE(PG8_SA(0, 0), a2, voffA);
            PG8_WAIT_V(8); PG8_WAIT_L(0); PG8_BAR; PG8_MMA(1, 0, At, B0); PG8_MMA(1, 1, At, B1); PG8_BAR; PG8_SCHED;
            PG8_LDB(B0, 1, 0); PG8_LDB(B1, 1, 1); PG8_SCHED; PG8_LDA(At, 1, 0); PG8_STAGE(PG8_SA(0, 1), a2 + hstepA, voffA);
            PG8_WAIT_V(8); PG8_WAIT_L(0); PG8_BAR; PG8_MMA(0, 0, At, B0); PG8_MMA(0, 1, At, B1); PG8_BAR; PG8_SCHED;
            PG8_LDA(At, 1, 1); PG8_STAGE(PG8_SB(1, 0), b3, voffB); PG8_STAGE(PG8_SB(1, 1), b3 + hstepB, voffB); PG8_STAGE(PG8_SA(1, 0), a3, voffA);
            PG8_WAIT_V(8); PG8_WAIT_L(0); PG8_BAR; PG8_MMA(1, 0, At, B0); PG8_MMA(1, 1, At, B1); PG8_BAR; PG8_SCHED;
        }
        if (wr == 0) PG8_BAR;
        E(acc, cur, wr, wc, fr, fq, lds, wid, lane);
        if (!has_next) break;
        if (!cur.keep) {
#pragma unroll
        for (int a = 0; a < 2; ++a)
#pragma unroll
            for (int b = 0; b < 2; ++b)
#pragma unroll
                for (int m = 0; m < 4; ++m)
#pragma unroll
                    for (int n = 0; n < 2; ++n) acc[a][b][m][n] = (f32x4){0.f, 0.f, 0.f, 0.f};
        }
        cur = nxt; cA = nA; cB = nB; ++ui;
        if (wr == 1) PG8_BAR;
    }
    PG8_WAIT_V(0);
    PG8_BAR;
#undef PG8_SA
#undef PG8_SB
#undef PG8_STAGE
#undef PG8_LDA
#undef PG8_LDB
#undef PG8_MMA
#undef PG8_WAIT_V
#undef PG8_WAIT_L
#undef PG8_BAR
#undef PG8_SCHED
}
}

__device__ __forceinline__ float fast_sigm(float z) { return __builtin_amdgcn_rcpf(1.0f + __builtin_amdgcn_exp2f(-1.4426950408889634f * z)); }
__device__ __forceinline__ float fast_silu(float z) { return z * fast_sigm(z); }

struct SchedInproj {
    int G, c;
    __device__ __forceinline__ bool next(int i, pg8::Unit& u) const {
        const long L = (long)i * G + c; if (L >= 3712) return false;
        if (L < 3584) { const int xcd = (int)(L & 7), off = (int)(L >> 3); u.pm = 8 * xcd + (off & 7); u.pn = off >> 3; }
        else { const int q = (int)L - 3584; u.pm = 64 + (q & 7); u.pn = 16 + (q >> 3); }
        u.x0 = 0; u.x1 = 0; u.nt = D / 64; u.keep = 0; u.aoff = (long)u.pm * 256 * D * 2; u.boff = (long)u.pn * 256 * D * 2; return true;
    }
};
struct EpiInproj {
    unsigned char* ws; const float* qg; const float* kg; const float2* rope;
    __device__ __forceinline__ void operator()(f32x4 (&acc)[2][2][4][2], const pg8::Unit& u, int wr, int wc, int fr, int fq, LAS unsigned char* lds, int wid, int lane) const {
        const bool isctx = u.pm >= 64;
        const int blk = u.pn >> 3;
        const int act = (blk == 0) ? ((u.pn >= 4) ? 1 : 0) : (blk == 1 || blk == 2) ? 3 : (blk == 3) ? 0 : (blk == 4) ? 1 : 2;
        bf16_t* dst; int row0;
        if (!isctx) { dst = (bf16_t*)(ws + (size_t)blk * 64 * MiB); row0 = u.pm * 256; }
        else { dst = (bf16_t*)(ws + (blk == 2 ? WS_KC : WS_VC)); row0 = (u.pm - 64) * 256; }
        const int colb = (u.pn & 7) * 256 + wc * 64 + 8 * fq;
        if (act != 3) {
#pragma unroll
            for (int ai = 0; ai < 2; ++ai)
#pragma unroll
                for (int m = 0; m < 4; ++m) {
                    bf16_t* rowp = dst + (size_t)(row0 + ai * 128 + wr * 64 + m * 16 + fr) * D + colb;
#pragma unroll
                    for (int bj = 0; bj < 2; ++bj) {
                        f32x4 v0 = acc[ai][bj][m][0], v1 = acc[ai][bj][m][1];
                        if (act == 1) { v0[0] = fast_silu(v0[0]); v0[1] = fast_silu(v0[1]); v0[2] = fast_silu(v0[2]); v0[3] = fast_silu(v0[3]); v1[0] = fast_silu(v1[0]); v1[1] = fast_silu(v1[1]); v1[2] = fast_silu(v1[2]); v1[3] = fast_silu(v1[3]); }
                        else if (act == 2) { v0[0] = fast_sigm(v0[0]); v0[1] = fast_sigm(v0[1]); v0[2] = fast_sigm(v0[2]); v0[3] = fast_sigm(v0[3]); v1[0] = fast_sigm(v1[0]); v1[1] = fast_sigm(v1[1]); v1[2] = fast_sigm(v1[2]); v1[3] = fast_sigm(v1[3]); }
                        u32x4 w; w[0] = pg8::cvt_pk_bf16(v0[0], v0[1]); w[1] = pg8::cvt_pk_bf16(v0[2], v0[3]); w[2] = pg8::cvt_pk_bf16(v1[0], v1[1]); w[3] = pg8::cvt_pk_bf16(v1[2], v1[3]);
                        *(u32x4*)(rowp + bj * 32) = w;
                    }
                }
            return;
        }
        LAS float* X = (LAS float*)(lds + XCH_OFF);
#pragma unroll
        for (int ai = 0; ai < 2; ++ai)
#pragma unroll
            for (int m = 0; m < 4; ++m) {
                float ss = 0.f;
#pragma unroll
                for (int bj = 0; bj < 2; ++bj)
#pragma unroll
                    for (int n = 0; n < 2; ++n) { const f32x4 v = acc[ai][bj][m][n]; ss += (v[0] * v[0] + v[1] * v[1]) + (v[2] * v[2] + v[3] * v[3]); }
                ss += __shfl_xor(ss, 16); ss += __shfl_xor(ss, 32);
                if (fq == 0) X[wid * 128 + ai * 64 + m * 16 + fr] = ss;
            }
        asm volatile("s_waitcnt lgkmcnt(0)" ::: "memory"); __builtin_amdgcn_s_barrier(); asm volatile("" ::: "memory");
        const int ax = wc & 1;
        const float* gain = (blk == 1 ? qg : kg) + ax * 64 + 8 * fq;
        const f32x4 g00 = *(const f32x4*)(gain), g01 = *(const f32x4*)(gain + 4), g10 = *(const f32x4*)(gain + 32), g11 = *(const f32x4*)(gain + 36);
        const float post = (blk == 1) ? QSCALE : 1.0f;
#pragma unroll
        for (int ai = 0; ai < 2; ++ai)
#pragma unroll
            for (int m = 0; m < 4; ++m) {
                const int ridx = ai * 64 + m * 16 + fr;
                const float tot = X[wid * 128 + ridx] + X[(wid ^ 1) * 128 + ridx];
                const float rs = post / sqrtf(tot * (1.0f / HD) + 1e-6f);
                f32x4 x0a = acc[ai][0][m][0] * g00 * rs, x0b = acc[ai][0][m][1] * g01 * rs, x1a = acc[ai][1][m][0] * g10 * rs, x1b = acc[ai][1][m][1] * g11 * rs;
                if (!isctx) {
                    const int t = (row0 + ai * 128 + wr * 64 + m * 16 + fr) & (S - 1);
                    const int pos = ax ? (t & 63) : (t >> 6);
                    const f32x4* rp = (const f32x4*)(rope + pos * 32 + 8 * fq);
                    const f32x4 c0 = rp[0], c1 = rp[1], c2 = rp[2], c3 = rp[3];
                    f32x4 y0a, y0b, y1a, y1b;
                    y0a[0] = x0a[0] * c0[0] - x1a[0] * c0[1]; y1a[0] = x1a[0] * c0[0] + x0a[0] * c0[1];
                    y0a[1] = x0a[1] * c0[2] - x1a[1] * c0[3]; y1a[1] = x1a[1] * c0[2] + x0a[1] * c0[3];
                    y0a[2] = x0a[2] * c1[0] - x1a[2] * c1[1]; y1a[2] = x1a[2] * c1[0] + x0a[2] * c1[1];
                    y0a[3] = x0a[3] * c1[2] - x1a[3] * c1[3]; y1a[3] = x1a[3] * c1[2] + x0a[3] * c1[3];
                    y0b[0] = x0b[0] * c2[0] - x1b[0] * c2[1]; y1b[0] = x1b[0] * c2[0] + x0b[0] * c2[1];
                    y0b[1] = x0b[1] * c2[2] - x1b[1] * c2[3]; y1b[1] = x1b[1] * c2[2] + x0b[1] * c2[3];
                    y0b[2] = x0b[2] * c3[0] - x1b[2] * c3[1]; y1b[2] = x1b[2] * c3[0] + x0b[2] * c3[1];
                    y0b[3] = x0b[3] * c3[2] - x1b[3] * c3[3]; y1b[3] = x1b[3] * c3[2] + x0b[3] * c3[3];
                    x0a = y0a; x0b = y0b; x1a = y1a; x1b = y1b;
                }
                bf16_t* rowp = dst + (size_t)(row0 + ai * 128 + wr * 64 + m * 16 + fr) * D + colb;
                u32x4 w0, w1;
                w0[0] = pg8::cvt_pk_bf16(x0a[0], x0a[1]); w0[1] = pg8::cvt_pk_bf16(x0a[2], x0a[3]); w0[2] = pg8::cvt_pk_bf16(x0b[0], x0b[1]); w0[3] = pg8::cvt_pk_bf16(x0b[2], x0b[3]);
                w1[0] = pg8::cvt_pk_bf16(x1a[0], x1a[1]); w1[1] = pg8::cvt_pk_bf16(x1a[2], x1a[3]); w1[2] = pg8::cvt_pk_bf16(x1b[0], x1b[1]); w1[3] = pg8::cvt_pk_bf16(x1b[2], x1b[3]);
                *(u32x4*)(rowp) = w0; *(u32x4*)(rowp + 32) = w1;
            }
    }
};

struct SchedChan {
    int G, c;
    __device__ __forceinline__ bool next(int i, pg8::Unit& u) const {
        const long L = (long)i * G + c; if (L >= 512) return false;
        const int part = (int)(L & 1), g = (int)((L >> 1) & 3), pnt = (int)(L >> 3);
        u.pm = part; u.pn = pnt; u.x0 = g; u.x1 = 0; u.nt = 4; u.keep = 0; u.aoff = (long)part * 256 * 256 * 2; u.boff = ((long)pnt * 256 * D + g * 256) * 2; return true;
    }
};
struct EpiChan {
    bf16_t* PQt;
    __device__ __forceinline__ void operator()(f32x4 (&acc)[2][2][4][2], const pg8::Unit& u, int wr, int wc, int fr, int fq, LAS unsigned char*, int, int) const {
        const int b = u.pn >> 3, n0 = (u.pn & 7) * 256, part = u.pm, g = u.x0;
        bf16_t* base = PQt + ((size_t)(b * 1024 + g * 256) * 4096 + part * 2048 + n0 + wc * 64 + 8 * fq);
#pragma unroll
        for (int ai = 0; ai < 2; ++ai)
#pragma unroll
            for (int m = 0; m < 4; ++m) {
                bf16_t* rowp = base + (size_t)(ai * 128 + wr * 64 + m * 16 + fr) * 4096;
#pragma unroll
                for (int bj = 0; bj < 2; ++bj) { const f32x4 v0 = acc[ai][bj][m][0], v1 = acc[ai][bj][m][1];
                    u32x4 w; w[0] = pg8::cvt_pk_bf16(v0[0], v0[1]); w[1] = pg8::cvt_pk_bf16(v0[2], v0[3]); w[2] = pg8::cvt_pk_bf16(v1[0], v1[1]); w[3] = pg8::cvt_pk_bf16(v1[2], v1[3]);
                    *(u32x4*)(rowp + bj * 32) = w; }
            }
    }
};
struct SchedPos {
    int G, c;
    __device__ __forceinline__ bool next(int i, pg8::Unit& u) const {
        const long L = (long)i * G + c; if (L >= 256) return false;
        const int b = (int)(L >> 5), pm = (int)((L & 31) >> 2), pn = (int)(L & 3);
        u.pm = pm; u.pn = pn; u.x0 = b; u.x1 = 0; u.nt = 64; u.keep = 0; u.aoff = (long)pm * 256 * 4096 * 2; u.boff = ((long)b * 1024 + pn * 256) * 4096 * 2; return true;
    }
};
__device__ __forceinline__ float bflo(unsigned w) { return __uint_as_float(w << 16); }
__device__ __forceinline__ float bfhi(unsigned w) { return __uint_as_float(w & 0xffff0000u); }
struct EpiPos {
    bf16_t* UZ;
    __device__ __forceinline__ void operator()(f32x4 (&acc)[2][2][4][2], const pg8::Unit& u, int wr, int wc, int fr, int fq, LAS unsigned char*, int, int) const {
        bf16_t* base = UZ + ((size_t)(u.x0 * S + u.pm * 256) * D + OFF_ZF + u.pn * 256 + wc * 64 + 8 * fq);
#pragma unroll
        for (int ai = 0; ai < 2; ++ai)
#pragma unroll
            for (int m = 0; m < 4; ++m) {
                bf16_t* rowp = base + (size_t)(ai * 128 + wr * 64 + m * 16 + fr) * D;
#pragma unroll
                for (int bj = 0; bj < 2; ++bj) { const f32x4 v0 = acc[ai][bj][m][0], v1 = acc[ai][bj][m][1];
                    const u32x4 z = *(const u32x4*)(rowp + bj * 32);
                    u32x4 w; w[0] = pg8::cvt_pk_bf16(v0[0] * bflo(z[0]), v0[1] * bfhi(z[0])); w[1] = pg8::cvt_pk_bf16(v0[2] * bflo(z[1]), v0[3] * bfhi(z[1]));
                    w[2] = pg8::cvt_pk_bf16(v1[0] * bflo(z[2]), v1[1] * bfhi(z[2])); w[3] = pg8::cvt_pk_bf16(v1[2] * bflo(z[3]), v1[3] * bfhi(z[3]));
                    *(u32x4*)(rowp + bj * 32) = w; }
            }
    }
};
struct SchedRows {
    int G, c;
    __device__ __forceinline__ bool next(int i, pg8::Unit& u) const {
        const long L = (long)i * G + c; if (L >= 512) return false;
        const int xcd = (int)(L & 7), off = (int)(L >> 3);
        u.pm = 8 * xcd + (off & 7); u.pn = off >> 3; u.x0 = 0; u.x1 = 0; u.nt = D / 64; u.keep = 0; u.aoff = (long)u.pm * 256 * D * 2; u.boff = (long)u.pn * 256 * D * 2; return true;
    }
};
struct SchedY {
    int G, c; long a2off;
    __device__ __forceinline__ bool next(int i, pg8::Unit& u) const {
        const int seg = i & 1; const long L = (long)(i >> 1) * G + c; if (L >= 512) return false;
        const int xcd = (int)(L & 7), off = (int)(L >> 3);
        u.pm = 8 * xcd + (off & 7); u.pn = off >> 3; u.x0 = seg; u.x1 = 0; u.nt = seg ? 32 : 16; u.keep = seg ? 0 : 1;
        u.aoff = (long)u.pm * 256 * D * 2 + (seg ? a2off : 0); u.boff = (long)u.pn * 256 * 3072 * 2 + (seg ? 1024 * 2 : 0); return true;
    }
};
struct EpiY {
    bf16_t* SGF; const bf16_t* SGA;
    __device__ __forceinline__ void mid(f32x4 (&acc)[2][2][4][2], const pg8::Unit& u, int wr, int wc, int fr, int fq) const {
        const size_t base = (size_t)(u.pm * 256 + wr * 64 + fr) * D + u.pn * 256 + wc * 64 + 8 * fq;
#pragma unroll
        for (int ai = 0; ai < 2; ++ai)
#pragma unroll
            for (int m = 0; m < 4; ++m)
#pragma unroll
                for (int bj = 0; bj < 2; ++bj) {
                    const size_t o = base + (size_t)(ai * 128 + m * 16) * D + bj * 32;
                    const u32x4 gf = *(const u32x4*)(SGF + o), ga = *(const u32x4*)(SGA + o);
                    f32x4& v0 = acc[ai][bj][m][0]; f32x4& v1 = acc[ai][bj][m][1];
                    v0[0] *= bflo(gf[0]) * __builtin_amdgcn_rcpf(bflo(ga[0])); v0[1] *= bfhi(gf[0]) * __builtin_amdgcn_rcpf(bfhi(ga[0]));
                    v0[2] *= bflo(gf[1]) * __builtin_amdgcn_rcpf(bflo(ga[1])); v0[3] *= bfhi(gf[1]) * __builtin_amdgcn_rcpf(bfhi(ga[1]));
                    v1[0] *= bflo(gf[2]) * __builtin_amdgcn_rcpf(bflo(ga[2])); v1[1] *= bfhi(gf[2]) * __builtin_amdgcn_rcpf(bfhi(ga[2]));
                    v1[2] *= bflo(gf[3]) * __builtin_amdgcn_rcpf(bflo(ga[3])); v1[3] *= bfhi(gf[3]) * __builtin_amdgcn_rcpf(bfhi(ga[3]));
                    if (bj == 1) asm volatile("" ::: "memory");
                }
    }
    __device__ __forceinline__ void operator()(f32x4 (&acc)[2][2][4][2], const pg8::Unit& u, int wr, int wc, int fr, int fq, LAS unsigned char*, int, int) const {
        if (u.x0 == 0) { mid(acc, u, wr, wc, fr, fq); return; }
        const size_t base = (size_t)(u.pm * 256 + wr * 64 + fr) * D + u.pn * 256 + wc * 64 + 8 * fq;
#pragma unroll
        for (int ai = 0; ai < 2; ++ai)
#pragma unroll
            for (int m = 0; m < 4; ++m)
#pragma unroll
                for (int bj = 0; bj < 2; ++bj) {
                    const size_t o = base + (size_t)(ai * 128 + m * 16) * D + bj * 32;
                    const u32x4 ga = *(const u32x4*)(SGA + o);
                    const f32x4 v0 = acc[ai][bj][m][0], v1 = acc[ai][bj][m][1];
                    u32x4 w; w[0] = pg8::cvt_pk_bf16(v0[0] * bflo(ga[0]), v0[1] * bfhi(ga[0])); w[1] = pg8::cvt_pk_bf16(v0[2] * bflo(ga[1]), v0[3] * bfhi(ga[1]));
                    w[2] = pg8::cvt_pk_bf16(v1[0] * bflo(ga[2]), v1[1] * bfhi(ga[2])); w[3] = pg8::cvt_pk_bf16(v1[2] * bflo(ga[3]), v1[3] * bfhi(ga[3]));
                    *(u32x4*)(SGF + o) = w;
                }
    }
};
struct EpiOut {
    const float* x; const float* mod; float* out;
    __device__ __forceinline__ void operator()(f32x4 (&acc)[2][2][4][2], const pg8::Unit& u, int wr, int wc, int fr, int fq, LAS unsigned char*, int, int) const {
        const int col = u.pn * 256 + wc * 64 + 8 * fq;
        const float* gate = mod + (size_t)(u.pm >> 3) * 3 * D + 2 * D + col;
        f32x4 gt[2][2];
#pragma unroll
        for (int bj = 0; bj < 2; ++bj) { gt[bj][0] = *(const f32x4*)(gate + bj * 32); gt[bj][1] = *(const f32x4*)(gate + bj * 32 + 4); }
#pragma unroll
        for (int ai = 0; ai < 2; ++ai)
#pragma unroll
            for (int m = 0; m < 4; ++m) {
                const size_t o = (size_t)(u.pm * 256 + ai * 128 + wr * 64 + m * 16 + fr) * D + col;
#pragma unroll
                for (int bj = 0; bj < 2; ++bj)
#pragma unroll
                    for (int n = 0; n < 2; ++n) { const f32x4 xv = *(const f32x4*)(x + o + bj * 32 + n * 4); *(f32x4*)(out + o + bj * 32 + n * 4) = xv + gt[bj][n] * acc[ai][bj][m][n]; }
            }
    }
};

namespace natt {
typedef short v4i16_t __attribute__((ext_vector_type(4)));
__device__ __forceinline__ v4i16_t vtr(const LAS unsigned char* p) { return __builtin_amdgcn_ds_read_tr16_b64_v4i16((LAS v4i16_t*)p); }
struct Tensors { bf16_t* Q; const bf16_t* K; const bf16_t* V; const bf16_t* KC; const bf16_t* VC; const bf16_t* SZA; const float* rpb; const float* shift; };

__device__ __forceinline__ void pair(const LAS unsigned char* Kb, const LAS unsigned char* Vb, int keybase, const bf16x8 (&qf)[4], f32x4 (&o)[8], float& lsum,
                                     int fr, int fq, bool local, const int (&dcv)[2][4], const LAS float* Trow, float shift) {
    f32x4 sx = (f32x4){0.f, 0.f, 0.f, 0.f}, sy = (f32x4){0.f, 0.f, 0.f, 0.f};
    const int krow = keybase + fr;
#pragma unroll
    for (int ks = 0; ks < 4; ++ks) {
        const int pos = ((4 * ks + fq) ^ (krow & 15)) * 16;
        const bf16x8 kx = *(const LAS bf16x8*)(Kb + krow * 256 + pos), ky = *(const LAS bf16x8*)(Kb + (krow + 16) * 256 + pos);
        sx = __builtin_amdgcn_mfma_f32_16x16x32_bf16(kx, qf[ks], sx, 0, 0, 0);
        sy = __builtin_amdgcn_mfma_f32_16x16x32_bf16(ky, qf[ks], sy, 0, 0, 0);
    }
    float px[4], py[4];
#pragma unroll
    for (int j = 0; j < 4; ++j) {
        if (local) {
            const int ix = dcv[0][j], iy = dcv[1][j];
            const float bx = Trow[ix < 0 ? 0 : ix], by = Trow[iy < 0 ? 0 : iy];
            px[j] = ix < 0 ? 0.f : __builtin_amdgcn_exp2f(sx[j] + bx - shift);
            py[j] = iy < 0 ? 0.f : __builtin_amdgcn_exp2f(sy[j] + by - shift);
        } else { px[j] = __builtin_amdgcn_exp2f(sx[j] - shift); py[j] = __builtin_amdgcn_exp2f(sy[j] - shift); }
    }
    lsum += ((px[0] + px[1]) + (px[2] + px[3])) + ((py[0] + py[1]) + (py[2] + py[3]));
    u32x4 pw; pw[0] = pg8::cvt_pk_bf16(px[0], px[1]); pw[1] = pg8::cvt_pk_bf16(px[2], px[3]); pw[2] = pg8::cvt_pk_bf16(py[0], py[1]); pw[3] = pg8::cvt_pk_bf16(py[2], py[3]);
    const bf16x8 pb = __builtin_bit_cast(bf16x8, pw);
    const int vrow = keybase + 4 * fq + (fr >> 2), sw = (vrow & 7) << 1;
    const LAS unsigned char* vp = Vb + vrow * 256 + (fr & 1) * 8;
    const int ch = (fr & 3) >> 1;
#pragma unroll
    for (int db = 0; db < 8; ++db) {
        const int pos = ((2 * db + ch) ^ sw) * 16;
        const v4i16_t vx = vtr(vp + pos), vy = vtr(vp + 16 * 256 + pos);
        const bf16x8 vf = (bf16x8){vx[0], vx[1], vx[2], vx[3], vy[0], vy[1], vy[2], vy[3]};
        o[db] = __builtin_amdgcn_mfma_f32_16x16x32_bf16(vf, pb, o[db], 0, 0, 0);
    }
}

__device__ __forceinline__ void attn_phase(LAS unsigned char* lds, const Tensors& T, int vcu) {
    const int tid = threadIdx.x, lane = tid & 63, wid = __builtin_amdgcn_readfirstlane(tid >> 6), fr = lane & 15, fq = lane >> 4;
    const int bh = vcu >> 1, b = bh >> 4, h = bh & 15;
    LAS float* Tb = (LAS float*)(lds + XCH_OFF);
    for (int i = tid; i < 465; i += NWAVES * 64) Tb[i] = T.rpb[h * 465 + i] * 1.4426950408889634f;
    const float shift = T.shift[0];
    const int s = wid & 3, wq = wid >> 2;
    const int cw = (s == 0) ? 0 : (s == 1) ? 8 : (s == 2) ? 24 : 32;
    const int c = 16 * s + fr, cst = min(max(c - 8, 0), 48);
    int dcv[2][4];
#pragma unroll
    for (int blk = 0; blk < 2; ++blk)
#pragma unroll
        for (int j = 0; j < 4; ++j) { const int kc = cw + 16 * blk + 4 * fq + j; dcv[blk][j] = (kc >= cst && kc < cst + 16) ? (kc - c + 15) : -1; }
    const bool isV = wid >= 4;
    const int drow = 16 * (wid & 3) + (lane >> 4), dp = lane & 15;
    for (int ui = 0; ui < 8; ++ui) {
        const int rp = (vcu & 1) * 8 + ui, r0 = 2 * rp, qrow = r0 + wq;
        const int rs0 = min(max(r0 - 4, 0), 24), rs1 = min(max(r0 - 3, 0), 24), rsq = wq ? rs1 : rs0;
        const int ntile = 4 + (rs1 + 8 - rs0);
        const size_t qtok = (size_t)b * S + qrow * 64 + 16 * s + fr;
        bf16_t* qp = T.Q + qtok * D + h * HD;
        bf16x8 qf[4];
#pragma unroll
        for (int ks = 0; ks < 4; ++ks) qf[ks] = *(const bf16x8*)(qp + 32 * ks + 8 * fq);
        f32x4 o[8];
#pragma unroll
        for (int db = 0; db < 8; ++db) o[db] = (f32x4){0.f, 0.f, 0.f, 0.f};
        float lsum = 0.f;
#define NATT_ISSUE(j) do { const int j_ = (j); const bf16_t* src_; \
            if (j_ < 4) src_ = (isV ? T.VC : T.KC) + ((size_t)b * L + 64 * j_) * D + h * HD; \
            else src_ = (isV ? T.V : T.K) + ((size_t)b * S + (rs0 + j_ - 4) * 64) * D + h * HD; \
            LAS unsigned char* dst_ = lds + (j_ & 1) * 32768 + (isV ? 16384 : 0) + (wid & 3) * 4096; \
            _Pragma("unroll") for (int e_ = 0; e_ < 4; ++e_) { const int row_ = drow + 4 * e_; const int c_ = isV ? (dp ^ ((row_ & 7) << 1)) : (dp ^ (row_ & 15)); \
                __builtin_amdgcn_global_load_lds((const unsigned*)(src_ + (size_t)row_ * D + c_ * 8), (LAS unsigned*)(dst_ + e_ * 1024), 16, 0, 0); } } while (0)
        NATT_ISSUE(0);
        for (int j = 0; j < ntile; ++j) {
            asm volatile("s_waitcnt vmcnt(0) lgkmcnt(0)" ::: "memory"); __builtin_amdgcn_s_barrier(); asm volatile("" ::: "memory");
            if (j + 1 < ntile) NATT_ISSUE(j + 1);
            const LAS unsigned char* Kb = lds + (j & 1) * 32768; const LAS unsigned char* Vb = Kb + 16384;
            if (j < 4) {
                pair(Kb, Vb, 0, qf, o, lsum, fr, fq, false, dcv, Tb, shift);
                pair(Kb, Vb, 32, qf, o, lsum, fr, fq, false, dcv, Tb, shift);
            } else {
                const int kr = rs0 + j - 4;
                if (kr >= rsq && kr < rsq + 8) pair(Kb, Vb, cw, qf, o, lsum, fr, fq, true, dcv, Tb + (kr - qrow + 7) * 31, shift);
            }
        }
#undef NATT_ISSUE
        asm volatile("s_waitcnt lgkmcnt(0)" ::: "memory"); __builtin_amdgcn_s_barrier(); asm volatile("" ::: "memory");
        lsum += __shfl_xor(lsum, 16); lsum += __shfl_xor(lsum, 32);
        const float inv = 1.0f / lsum;
        const bf16_t* zp = T.SZA + qtok * D + h * HD + 4 * fq;
#pragma unroll
        for (int db = 0; db < 8; ++db) {
            const u32x2 z = *(const u32x2*)(zp + 16 * db);
            u32x2 w; w[0] = pg8::cvt_pk_bf16(o[db][0] * inv * bflo(z[0]), o[db][1] * inv * bfhi(z[0])); w[1] = pg8::cvt_pk_bf16(o[db][2] * inv * bflo(z[1]), o[db][3] * inv * bfhi(z[1]));
            *(u32x2*)(qp + 16 * db + 4 * fq) = w;
        }
    }
}
}

struct MArgs { const float* in[13]; float* out; unsigned char* ws; int ph_lo, ph_hi, li, pad; };
struct Frame {
    LAS unsigned char* lds; volatile LAS unsigned* MISC; unsigned* ctl; int tid, lane, wave, vcu, G;
};
__device__ __forceinline__ unsigned pk2(float lo, float hi) { return f2bf(lo) | (f2bf(hi) << 16); }

__device__ __forceinline__ void p0_transpose_item(const float* W, int K, int N, bf16_t* WT, int ldo, int koff, LAS float* scr, int item, int lane) {
    const int nblk = N / 32, kb = item / nblk, nb = item % nblk, k0 = 64 * kb, n0 = 32 * nb;
#pragma unroll 8
    for (int i = 0; i < 32; ++i) { const int kk = 2 * i + (lane >> 5); scr[kk * 33 + (lane & 31)] = W[(size_t)(k0 + kk) * N + n0 + (lane & 31)]; }
    LDS_WAIT(); asm volatile("" ::: "memory");
    const int c = lane & 7;
#pragma unroll
    for (int j = 0; j < 4; ++j) { const int n = (lane >> 3) + 8 * j; const LAS float* s = scr + (8 * c) * 33 + n;
        u32x4 o; o[0] = pk2(s[0 * 33], s[1 * 33]); o[1] = pk2(s[2 * 33], s[3 * 33]); o[2] = pk2(s[4 * 33], s[5 * 33]); o[3] = pk2(s[6 * 33], s[7 * 33]);
        *(u32x4*)(WT + (size_t)(n0 + n) * ldo + koff + k0 + 8 * c) = o; }
    LDS_WAIT(); asm volatile("" ::: "memory");
}
__device__ __forceinline__ void p0_mod_item(const float* c, const float* cctx, const float* wmod, const float* bmod, float* mod, LAS float* scr, int item, int lane) {
    const int j0 = item * 16, kq = lane >> 4, jj = lane & 15;
    float acc[9];
#pragma unroll
    for (int b = 0; b < 9; ++b) acc[b] = 0.f;
    for (int k0 = 0; k0 < D; k0 += 256) {
#pragma unroll 4
        for (int i = 0; i < 36; ++i) { const int idx = i * 64 + lane, b = idx >> 8, kk = idx & 255; const float v = (b < 8) ? c[b * D + k0 + kk] : cctx[k0 + kk]; scr[idx] = silu_f(v); }
        LDS_WAIT(); asm volatile("" ::: "memory");
#pragma unroll 8
        for (int i = 0; i < 64; ++i) { const int k = 4 * i + kq; const float w = wmod[(size_t)(k0 + k) * (3 * D) + j0 + jj];
#pragma unroll
            for (int b = 0; b < 9; ++b) acc[b] += scr[b * 256 + k] * w; }
        LDS_WAIT(); asm volatile("" ::: "memory");
    }
#pragma unroll
    for (int b = 0; b < 9; ++b) { float a = acc[b]; a += __shfl_xor(a, 16); a += __shfl_xor(a, 32); if (kq == 0) mod[b * 3 * D + j0 + jj] = a + bmod[j0 + jj]; }
}
__device__ __forceinline__ void p0_table_item(float2* rope, bf16_t* CS, bf16_t* DFTA, const float* qg, const float* kg, const float* rpbp, float* shiftp, int item, int lane) {
    if (item == 0) {
        for (int i = 0; i < 32; ++i) { const int gid = i * 64 + lane, pos = gid >> 5, j = gid & 31;
            const float invf = exp2f(-(float)j * 0.41524101186092029f); const float ang = (float)pos * invf; float sn, cs; sincosf(ang, &sn, &cs);
            rope[gid] = make_float2(cs, sn); }
        float mq = fmaxf(fabsf(qg[lane]), fabsf(qg[lane + 64])), mk = fmaxf(fabsf(kg[lane]), fabsf(kg[lane + 64])), mb = 0.f;
        for (int i = lane; i < NH * 465; i += 64) mb = fmaxf(mb, rpbp[i]);
        mq = wave_max(mq); mk = wave_max(mk); mb = wave_max(mb);
        if (lane == 0) shiftp[0] = (11.313708498984761f * mq * mk + mb) * 1.4426950408889634f;
    } else if (item <= 32) {
        const int base = (item - 1) * 4096;
#pragma unroll
        for (int i = 0; i < 8; ++i) { const int e0 = base + (i * 64 + lane) * 8; unsigned w[4];
#pragma unroll
            for (int q = 0; q < 4; ++q) { float v[2];
#pragma unroll
                for (int z = 0; z < 2; ++z) { const int e = e0 + 2 * q + z, part = e >> 16, cp = (e >> 8) & 255, cc = e & 255, mm = (cp * cc) & 255;
                    v[z] = (part == 0 ? cospif((float)mm * (1.0f / 128.0f)) : sinpif((float)mm * (1.0f / 128.0f))) * 0.0625f; }
                w[q] = pk2(v[0], v[1]); }
            *(u32x4*)(CS + e0) = (u32x4){w[0], w[1], w[2], w[3]}; }
    } else {
        const int k1 = item - 33;
#pragma unroll
        for (int i = 0; i < 8; ++i) { const int kk0 = (i * 64 + lane) * 8; unsigned w[4];
#pragma unroll
            for (int q = 0; q < 4; ++q) { float v[2];
#pragma unroll
                for (int z = 0; z < 2; ++z) { const int kk = kk0 + 2 * q + z, part = kk >> 11, n = kk & 2047, mm = (k1 * n) & 2047;
                    v[z] = (part == 0 ? cospif((float)mm * (1.0f / 1024.0f)) : -sinpif((float)mm * (1.0f / 1024.0f))) * 0.022097086912079608f; }
                w[q] = pk2(v[0], v[1]); }
            *(u32x4*)(DFTA + (size_t)k1 * 4096 + kk0) = (u32x4){w[0], w[1], w[2], w[3]}; }
    }
}
__device__ __forceinline__ void p1_hnorm_row(const float* src, const float* shift, const float* scale, bf16_t* dst, int lane) {
    f32x4 v[8]; float ss = 0.f;
#pragma unroll
    for (int j = 0; j < 8; ++j) { v[j] = *(const f32x4*)(src + (j * 64 + lane) * 4); ss += (v[j][0] * v[j][0] + v[j][1] * v[j][1]) + (v[j][2] * v[j][2] + v[j][3] * v[j][3]); }
    ss = wave_sum(ss);
    const float rstd = 1.0f / sqrtf(ss * (1.0f / D) + 1e-6f);
#pragma unroll
    for (int j = 0; j < 8; ++j) {
        const int k = (j * 64 + lane) * 4;
        const f32x4 sc = *(const f32x4*)(scale + k), sh = *(const f32x4*)(shift + k);
        u32x2 o;
        o[0] = pk2(v[j][0] * rstd * (1.f + sc[0]) + sh[0], v[j][1] * rstd * (1.f + sc[1]) + sh[1]);
        o[1] = pk2(v[j][2] * rstd * (1.f + sc[2]) + sh[2], v[j][3] * rstd * (1.f + sc[3]) + sh[3]);
        *(u32x2*)(dst + k) = o;
    }
}

__global__ void __launch_bounds__(NWAVES * 64, 2) mega_fwd(MArgs args) {
    extern __shared__ __attribute__((aligned(16))) unsigned char lds_raw[];
    Frame F;
    F.lds = (LAS unsigned char*)lds_raw;
    F.MISC = (volatile LAS unsigned*)(F.lds + MISC_OFF);
    F.tid = threadIdx.x; F.lane = F.tid & 63; F.wave = __builtin_amdgcn_readfirstlane(F.tid >> 6);
    F.G = gridDim.x; { const int bx = blockIdx.x; F.vcu = (F.G % 8 == 0) ? (bx % 8) * (F.G / 8) + bx / 8 : bx; }
    unsigned char* ws = args.ws; unsigned char* dob = (unsigned char*)args.out;
    F.ctl = (unsigned*)(ws + WS_CTL);
    const float* x = args.in[0]; const float* c = args.in[1]; const float* ctx = args.in[2]; const float* cctx = args.in[3];
    const float* wmod = args.in[4]; const float* bmod = args.in[5]; const float* win = args.in[6];
    const float* qg = args.in[7]; const float* kg = args.in[8]; const float* rpb = args.in[9];
    float* shiftp = (float*)(ws + WS_ROPE + 65536);
    const float* wf = args.in[10]; const float* wa = args.in[11]; const float* wo = args.in[12];
    bf16_t* Wfa_t = (bf16_t*)(ws + WS_WFA); bf16_t* Wo_t = (bf16_t*)(ws + WS_WO); bf16_t* DFTA = (bf16_t*)(ws + WS_DFTA); bf16_t* CS = (bf16_t*)(ws + WS_CS);
    float* mod = (float*)(ws + WS_MOD); float2* rope = (float2*)(ws + WS_ROPE);
    bf16_t* H = (bf16_t*)(dob + DO_H); bf16_t* Win_t = (bf16_t*)(dob + DO_WIN);
    for (int u = F.tid; u < (LDS_BYTES - LDSCTL_OFF) / 4; u += NWAVES * 64) ((LAS unsigned*)(F.lds + LDSCTL_OFF))[u] = 0u;
    __syncthreads();
    XcdBarrier bar = xcd_barrier_post(F.ctl + CW_BAR + args.li * XCD_BAR_WORDS, F.MISC + 8);
    const int lo = args.ph_lo, hi = args.ph_hi;
#define IN(k) (lo <= (k) && (k) < hi)
#define BOTH(k) (IN(k) && IN((k) + 1))

    if (IN(0)) {
        LAS float* scr = (LAS float*)(F.lds + F.wave * 16384);
        const int gw = F.wave * F.G + F.vcu, NGW = F.G * NWAVES;
        constexpr int I_MOD = 384, I_TAB = 33 + 2048, I_WO = 32 * 64, I_WF = 16 * 64, I_WA = 32 * 64, I_WIN = 32 * (INW / 32);
        constexpr int NITEMS = I_MOD + I_TAB + I_WO + I_WF + I_WA + I_WIN;
        for (int it = gw; it < NITEMS; it += NGW) {
            int r = it;
            if (r < I_MOD) { p0_mod_item(c, cctx, wmod, bmod, mod, scr, r, F.lane); continue; } r -= I_MOD;
            if (r < I_TAB) { p0_table_item(rope, CS, DFTA, qg, kg, rpb, shiftp, r, F.lane); continue; } r -= I_TAB;
            if (r < I_WO) { p0_transpose_item(wo, D, D, Wo_t, D, 0, scr, r, F.lane); continue; } r -= I_WO;
            if (r < I_WF) { p0_transpose_item(wf, FW, D, Wfa_t, 3072, 0, scr, r, F.lane); continue; } r -= I_WF;
            if (r < I_WA) { p0_transpose_item(wa, D, D, Wfa_t, 3072, 1024, scr, r, F.lane); continue; } r -= I_WA;
            p0_transpose_item(win, D, INW, Win_t, D, 0, scr, r, F.lane);
        }
        if (BOTH(0)) xcd_barrier(bar);
    }
    if (IN(1)) {
        const int gw = F.vcu * NWAVES + F.wave, NGW = F.G * NWAVES;
        for (int row = gw; row < NB * S + NB * L; row += NGW) {
            const float* src; int mb;
            if (row < NB * S) { src = x + (size_t)row * D; mb = row / S; } else { src = ctx + (size_t)(row - NB * S) * D; mb = 8; }
            p1_hnorm_row(src, mod + (size_t)mb * 3 * D, mod + (size_t)mb * 3 * D + D, H + (size_t)row * D, F.lane);
        }
        if (BOTH(1)) xcd_barrier(bar);
    }
    if (IN(2)) {
        pg8::Gemm g{H, Win_t, D, D};
        SchedInproj Sc{F.G, (int)blockIdx.x};
        EpiInproj E{ws, qg, kg, rope};
        pg8::gemm_phase<EpiInproj, SchedInproj>(F.lds, g, Sc, E);
        if (BOTH(2)) xcd_barrier(bar);
    }
    if (IN(3)) {
        pg8::Gemm g{CS, (const bf16_t*)(ws + WS_UZ), 256, D};
        SchedChan Sc{F.G, (int)blockIdx.x};
        EpiChan E{(bf16_t*)(dob + DO_PQT)};
        pg8::gemm_phase<EpiChan, SchedChan>(F.lds, g, Sc, E);
        natt::Tensors AT{(bf16_t*)(ws + WS_Q), (const bf16_t*)(ws + WS_K), (const bf16_t*)(ws + WS_V), (const bf16_t*)(ws + WS_KC), (const bf16_t*)(ws + WS_VC), (const bf16_t*)(ws + WS_SZA), rpb, shiftp};
        natt::attn_phase(F.lds, AT, F.vcu);
        if (BOTH(3)) xcd_barrier(bar);
    }
    if (IN(4)) {
        pg8::Gemm g{DFTA, (const bf16_t*)(dob + DO_PQT), 4096, 4096};
        SchedPos Sc{F.G, F.vcu};
        EpiPos E{(bf16_t*)(ws + WS_UZ)};
        pg8::gemm_phase<EpiPos, SchedPos>(F.lds, g, Sc, E);
        if (BOTH(4)) xcd_barrier(bar);
    }
    if (IN(5)) {
        pg8::Gemm g{(const bf16_t*)(ws + WS_UZ) + OFF_ZF, Wfa_t, D, 3072};
        SchedY Sc{F.G, (int)blockIdx.x, (long)(WS_Q - WS_UZ) - (long)OFF_ZF * 2};
        EpiY E{(bf16_t*)(ws + WS_SGF), (const bf16_t*)(ws + WS_SGA)};
        pg8::gemm_phase<EpiY, SchedY>(F.lds, g, Sc, E);
        if (BOTH(5)) xcd_barrier(bar);
    }
    if (IN(6)) {
        pg8::Gemm g{(const bf16_t*)(ws + WS_SGF), Wo_t, D, D};
        SchedRows Sc{F.G, (int)blockIdx.x};
        EpiOut E{x, mod, args.out};
        pg8::gemm_phase<EpiOut, SchedRows>(F.lds, g, Sc, E);
    }
#undef IN
#undef BOTH
}

extern "C" void kernel_launch(void* const* d_in, const int* in_sizes, int n_in, void* d_out, int out_size, void* d_ws, size_t ws_size, hipStream_t stream) {
    unsigned char* ws = (unsigned char*)d_ws;
    if (ws_size < WS_END || n_in != 13) return;
    static int grid = 0;
    if (grid == 0) {
        int dev = 0, cus = 0, per_cu = 0;
        if (hipGetDevice(&dev) != hipSuccess || hipDeviceGetAttribute(&cus, hipDeviceAttributeMultiprocessorCount, dev) != hipSuccess) { grid = -1; return; }
        if (hipFuncSetAttribute((const void*)mega_fwd, hipFuncAttributeMaxDynamicSharedMemorySize, LDS_BYTES) != hipSuccess) { grid = -1; return; }
        if (hipOccupancyMaxActiveBlocksPerMultiprocessor(&per_cu, (const void*)mega_fwd, NWAVES * 64, LDS_BYTES) != hipSuccess || per_cu < 1) { fprintf(stderr, "occupancy query: %d\n", per_cu); grid = -1; return; }
        (void)hipGetLastError();
        grid = cus;
    }
    if (grid != 256) return;
    (void)hipMemsetAsync(ws + WS_CTL, 0, 1 * MiB, stream);
    MArgs a; memset(&a, 0, sizeof(a));
    for (int i = 0; i < 13; ++i) a.in[i] = (const float*)d_in[i];
    a.out = (float*)d_out; a.ws = ws; a.ph_lo = 0; a.ph_hi = 7; a.li = 0;
    hipLaunchKernelGGL(mega_fwd, dim3(grid), dim3(NWAVES * 64), LDS_BYTES, stream, a);
}
```

```cpp
#include <hip/hip_runtime.h>
#include <stdint.h>
#include <string.h>
#include <stdio.h>

typedef unsigned short bf16_t;
typedef short bf16x8 __attribute__((ext_vector_type(8)));
typedef float f32x4 __attribute__((ext_vector_type(4)));
typedef unsigned u32x4 __attribute__((ext_vector_type(4)));
typedef unsigned u32x2 __attribute__((ext_vector_type(2)));

constexpr int D = 2048, NB = 8, S = 2048, L = 256, NH = 16, HD = 128, FW = 1024, INW = 14336;
constexpr int OFF_ZF = 1024, OFF_Q = 2048, OFF_K = 4096, OFF_V = 6144, OFF_ZA = 8192, OFF_GF = 10240, OFF_GA = 12288;
constexpr size_t MiB = 1u << 20;
constexpr float QSCALE = 0.08838834764831845f * 1.4426950408889634f;
constexpr size_t WS_UZ = 0, WS_Q = 64 * MiB, WS_K = 128 * MiB, WS_V = 192 * MiB, WS_SZA = 256 * MiB, WS_SGF = 320 * MiB, WS_SGA = 384 * MiB,
                 WS_KC = 448 * MiB, WS_VC = 456 * MiB, WS_WFA = 464 * MiB, WS_WO = 476 * MiB, WS_DFTA = 484 * MiB,
                 WS_CTL = 500 * MiB, WS_MOD = 501 * MiB, WS_ROPE = 502 * MiB, WS_CS = 503 * MiB, WS_MODP = 504 * MiB, WS_END = 512 * MiB;
constexpr size_t DO_H = 0, DO_HC = 64 * MiB, DO_WIN = 72 * MiB, DO_PQT = 0;

__device__ __forceinline__ unsigned f2bf(float f) { unsigned u = __float_as_uint(f); return (u + 0x7fffu + ((u >> 16) & 1u)) >> 16; }
__device__ __forceinline__ float bf2f(unsigned h) { return __uint_as_float(h << 16); }
__device__ __forceinline__ float silu_f(float z) { return z / (1.0f + expf(-z)); }
__device__ __forceinline__ float sigm_f(float z) { return 1.0f / (1.0f + expf(-z)); }
__device__ __forceinline__ float wave_sum(float v) {
#pragma unroll
    for (int o = 1; o < 64; o <<= 1) v += __shfl_xor(v, o);
    return v;
}
__device__ __forceinline__ float wave_max(float v) {
#pragma unroll
    for (int o = 1; o < 64; o <<= 1) v = fmaxf(v, __shfl_xor(v, o));
    return v;
}

#define LAS __attribute__((address_space(3)))
#define GAS __attribute__((address_space(1)))
typedef GAS unsigned gu32;
#define RLX_AGENT __ATOMIC_RELAXED, __HIP_MEMORY_SCOPE_AGENT
#define LDS_WAIT() asm volatile("s_waitcnt lgkmcnt(0)" ::: "memory")
#define VM_WAIT() asm volatile("s_waitcnt vmcnt(0)" ::: "memory")
constexpr int NWAVES = 8;
constexpr int RING_BYTES = 131072, LDSCTL_OFF = RING_BYTES, MISC_OFF = LDSCTL_OFF + 320, XCH_OFF = LDSCTL_OFF + 1024, LDS_BYTES = 147456;
constexpr int CW_BAR = 4096;

#define XB_TMO      128
#define XB_XCNT(j)  (256  + 64 * (j))
#define XB_XSUB(j)  (1280 + 64 * (j))
#define XB_XGEN(j)  (2304 + 64 * (j))
#define XB_TOP      3328
#define XB_TOPGEN   3392
#define XCD_BAR_WORDS 3456
#define XB_SPIN_CAP (1u << 18)
__device__ __forceinline__ unsigned xb_ld(unsigned* p)              { return __hip_atomic_load(p, __ATOMIC_RELAXED, __HIP_MEMORY_SCOPE_AGENT); }
__device__ __forceinline__ unsigned xb_add(unsigned* p, unsigned v) { return __hip_atomic_fetch_add(p, v, __ATOMIC_RELAXED, __HIP_MEMORY_SCOPE_AGENT); }
__device__ __forceinline__ unsigned xb_xcc_id() { return (unsigned)__builtin_amdgcn_s_getreg((3 << 11) | 20) & 0xFu; }
#define XB_SPIN(cond, bar) do { unsigned _sp = 0; while (cond) { __builtin_amdgcn_s_sleep(1); \
    if ((++_sp & 255u) == 0u) { if (xb_ld(&(bar)[XB_TMO])) break; if (_sp > XB_SPIN_CAP) { atomicAdd(&(bar)[XB_TMO], 1u); break; } } } } while (0)
struct XcdBarrier { unsigned* bar; unsigned x; volatile LAS unsigned* st; };
__device__ __forceinline__ XcdBarrier xcd_barrier_post(unsigned* bar, volatile LAS unsigned* st) {
    XcdBarrier b; b.bar = bar; b.x = xb_xcc_id(); b.st = st;
    if (threadIdx.x == 0) (void)xb_add(&bar[XB_XCNT(b.x)], 1u);
    return b;
}
__device__ __forceinline__ void xcd_barrier_complete(unsigned* bar, unsigned x, unsigned& nloc, unsigned& nx) {
    const unsigned G = gridDim.x * gridDim.y * gridDim.z;
    unsigned sum, cnt, mine, sp = 0u;
    for (;;) {
        sum = 0u; cnt = 0u; mine = 0u;
#pragma unroll
        for (unsigned j = 0; j < 16; ++j) { const unsigned c = xb_ld(&bar[XB_XCNT(j)]); sum += c; cnt += (c > 0u) ? 1u : 0u; mine = (j == x) ? c : mine; }
        if (sum == G) break;
        __builtin_amdgcn_s_sleep(1);
        if ((++sp & 255u) == 0u) { if (xb_ld(&bar[XB_TMO])) break; if (sp > XB_SPIN_CAP) { atomicAdd(&bar[XB_TMO], 1u); break; } }
    }
    nloc = mine > 0u ? mine : 1u; nx = cnt > 0u ? cnt : 1u;
}
__device__ __forceinline__ void xcd_barrier(const XcdBarrier& b) {
    asm volatile("s_waitcnt vmcnt(0)" ::: "memory");
    __syncthreads();
    if (threadIdx.x == 0) {
        unsigned* bar = b.bar;
        __builtin_amdgcn_s_waitcnt(0);
        unsigned nloc = b.st[0], nx = b.st[1];
        if (nloc == 0u) { xcd_barrier_complete(bar, b.x, nloc, nx); b.st[0] = nloc; b.st[1] = nx; }
        const unsigned old = xb_add(&bar[XB_XSUB(b.x)], 1u);
        const unsigned gen = old / nloc;
        if (old + 1u == (gen + 1u) * nloc) {
            __builtin_amdgcn_fence(__ATOMIC_RELEASE, "agent");
            asm volatile("s_waitcnt vmcnt(0)" ::: "memory");
            const unsigned og = xb_add(&bar[XB_TOP], 1u);
            const unsigned tg = og / nx;
            if (og + 1u == (tg + 1u) * nx) xb_add(&bar[XB_TOPGEN], 1u);
            else XB_SPIN(xb_ld(&bar[XB_TOPGEN]) == tg, bar);
            __builtin_amdgcn_fence(__ATOMIC_ACQUIRE, "agent");
            xb_add(&bar[XB_XGEN(b.x)], 1u);
            asm volatile("s_waitcnt vmcnt(0)" ::: "memory");
        } else {
            XB_SPIN(xb_ld(&bar[XB_XGEN(b.x)]) == gen, bar);
            __builtin_amdgcn_fence(__ATOMIC_ACQUIRE, "agent");
            asm volatile("s_waitcnt vmcnt(0)" ::: "memory");
        }
    }
    __syncthreads();
}

namespace pg8 {
constexpr int BM = 256, BK = 64, HALF = 128, HTB = HALF * BK * 2, STAGE_BYTES = 8 * HTB;
__host__ __device__ __forceinline__ int lds_byte(int r, int c) { const int st = (r >> 4) * 2 + (c >> 5), rr = r & 15, cc = c & 31, ob = rr * 64 + cc * 2; return st * 1024 + (ob ^ (((ob >> 9) & 1) << 5)); }
__host__ __device__ __forceinline__ void stage_rc(int b, int& R, int& C) { const int st = b / 1024, sb = b % 1024, swz = sb ^ (((sb >> 9) & 1) << 5); R = (st >> 1) * 16 + swz / 64; C = (st & 1) * 32 + (swz % 64) / 2; }
__host__ __device__ __forceinline__ int perm32(int rho) { const int n = rho >> 4, i = rho & 15; return 8 * (i >> 2) + 4 * n + (i & 3); }
struct Unit { int pm, pn, x0, x1, nt, keep; long aoff, boff; };
struct Gemm { const bf16_t* A; const bf16_t* Bt; int lda, ldb; };
__device__ __forceinline__ unsigned cvt_pk_bf16(float lo, float hi) { unsigned r; asm volatile("v_cvt_pk_bf16_f32 %0, %1, %2" : "=v"(r) : "v"(lo), "v"(hi)); return r; }

template <class Epi, class Sched>
__device__ __forceinline__ void gemm_phase(LAS unsigned char* lds, const Gemm g, const Sched& S, const Epi& E) {
    int tid = threadIdx.x; asm volatile("" : "+v"(tid));
    const int wid = __builtin_amdgcn_readfirstlane(tid >> 6), lane = tid & 63, wr = wid >> 2, wc = wid & 3, fr = lane & 15, fq = lane >> 4;
    unsigned voffA[2], voffB[2];
#pragma unroll
    for (int i = 0; i < 2; ++i) { int R, C; stage_rc(tid * 16 + i * 8192, R, C); const int Rb = 64 * (R >> 5) + perm32(R & 31);
        voffA[i] = (unsigned)(R * g.lda + C) * 2u; voffB[i] = (unsigned)(Rb * g.ldb + C) * 2u; }
    const size_t kstep = (size_t)(BK * 2);
    const size_t hstepA = (size_t)HALF * g.lda * 2, hstepB = (size_t)32 * g.ldb * 2;
    const unsigned ldsw = (unsigned)wid * 1024u;
    const int aoff = lds_byte(wr * 64 + fr, fq * 8), boff = lds_byte(wc * 32 + fr, fq * 8);
#define PG8_SA(b, h) (((b) * 2 + (h)) * HTB)
#define PG8_SB(b, h) ((4 + (b) * 2 + (h)) * HTB)
#define PG8_STAGE(bufoff, gbase, voff) do { _Pragma("unroll") for (int _i = 0; _i < 2; ++_i) \
        __builtin_amdgcn_global_load_lds((const unsigned*)((const char*)(gbase) + (voff)[_i]), (LAS unsigned*)(lds + (bufoff) + ldsw + _i * 8192), 16, 0, 0); } while (0)
#define PG8_LDA(dst, b, h) do { _Pragma("unroll") for (int m = 0; m < 4; ++m) _Pragma("unroll") for (int k = 0; k < 2; ++k) dst[m][k] = *(const LAS bf16x8*)(lds + PG8_SA(b, h) + aoff + m * 2048 + k * 1024); } while (0)
#define PG8_LDB(dst, b, h) do { _Pragma("unroll") for (int n = 0; n < 2; ++n) _Pragma("unroll") for (int k = 0; k < 2; ++k) dst[n][k] = *(const LAS bf16x8*)(lds + PG8_SB(b, h) + boff + n * 2048 + k * 1024); } while (0)
#define PG8_MMA(ai, bj, At, Bt) do { __builtin_amdgcn_s_setprio(1); _Pragma("unroll") for (int m = 0; m < 4; ++m) _Pragma("unroll") for (int n = 0; n < 2; ++n) _Pragma("unroll") for (int k = 0; k < 2; ++k) \
        acc[ai][bj][m][n] = __builtin_amdgcn_mfma_f32_16x16x32_bf16(Bt[n][k], At[m][k], acc[ai][bj][m][n], 0, 0, 0); __builtin_amdgcn_s_setprio(0); } while (0)
#define PG8_WAIT_V(n) asm volatile("s_waitcnt vmcnt(" #n ")" ::: "memory")
#define PG8_WAIT_L(n) asm volatile("s_waitcnt lgkmcnt(" #n ")" ::: "memory")
#define PG8_BAR __builtin_amdgcn_s_barrier()
#define PG8_SCHED __builtin_amdgcn_sched_barrier(0)
    Unit cur, nxt; int ui = 0;
    if (!S.next(0, cur)) return;
    f32x4 acc[2][2][4][2];
#pragma unroll
    for (int a = 0; a < 2; ++a)
#pragma unroll
        for (int b = 0; b < 2; ++b)
#pragma unroll
            for (int m = 0; m < 4; ++m)
#pragma unroll
                for (int n = 0; n < 2; ++n) acc[a][b][m][n] = (f32x4){0.f, 0.f, 0.f, 0.f};
    bf16x8 At[4][2], B0[2][2], B1[2][2];
    const char* cA = (const char*)g.A + cur.aoff; const char* cB = (const char*)g.Bt + cur.boff;
    PG8_STAGE(PG8_SB(0, 0), cB, voffB); PG8_STAGE(PG8_SB(0, 1), cB + hstepB, voffB); PG8_STAGE(PG8_SA(0, 0), cA, voffA); PG8_STAGE(PG8_SA(0, 1), cA + hstepA, voffA);
    if (wr == 1) PG8_BAR;
    PG8_WAIT_V(2); PG8_BAR;
    PG8_STAGE(PG8_SB(1, 0), cB + kstep, voffB); PG8_STAGE(PG8_SA(1, 0), cA + kstep, voffA); PG8_STAGE(PG8_SB(1, 1), cB + hstepB + kstep, voffB);
    PG8_WAIT_V(6); PG8_BAR;
    for (;;) {
        const bool has_next = S.next(ui + 1, nxt);
        const char* nA = has_next ? (const char*)g.A + nxt.aoff : cA; const char* nB = has_next ? (const char*)g.Bt + nxt.boff : cB;
        int nt = cur.nt; asm volatile("" : "+s"(nt));
        for (int t = 0; t < nt; t += 2) {
            const bool last = (t == nt - 2);
            const char* a1 = cA + (size_t)(t + 1) * kstep;
            const char* a2 = last ? nA : cA + (size_t)(t + 2) * kstep; const char* b2 = last ? nB : cB + (size_t)(t + 2) * kstep;
            const char* a3 = a2 + kstep; const char* b3 = b2 + kstep;
            PG8_LDB(B0, 0, 0); PG8_LDB(B1, 0, 1); PG8_SCHED; PG8_LDA(At, 0, 0); PG8_STAGE(PG8_SA(1, 1), a1 + hstepA, voffA);
            PG8_WAIT_V(8); PG8_WAIT_L(0); PG8_BAR; PG8_MMA(0, 0, At, B0); PG8_MMA(0, 1, At, B1); PG8_BAR; PG8_SCHED;
            PG8_LDA(At, 0, 1); PG8_STAGE(PG8_SB(0, 0), b2, voffB); PG8_STAGE(PG8_SB(0, 1), b2 + hstepB, voffB); PG8_STAGE(PG8_SA(0, 0), a2, voffA);
            PG8_WAIT_V(8); PG8_WAIT_L(0); PG8_BAR; PG8_MMA(1, 0, At, B0); PG8_MMA(1, 1, At, B1); PG8_BAR; PG8_SCHED;
            PG8_LDB(B0, 1, 0); PG8_LDB(B1, 1, 1); PG8_SCHED; PG8_LDA(At, 1, 0); PG8_STAGE(PG8_SA(0, 1), a2 + hstepA, voffA);
            PG8_WAIT_V(8); PG8_WAIT_L(0); PG8_BAR; PG8_MMA(0, 0, At, B0); PG8_MMA(0, 1, At, B1); PG8_BAR; PG8_SCHED;
            PG8_LDA(At, 1, 1); PG8_STAGE(PG8_SB(1, 0), b3, voffB); PG8_STAGE(PG8_SB(1, 1), b3 + hstepB, voffB); PG8_STAGE(PG8_SA(1, 0), a3, voffA);
            PG8_WAIT_V(8); PG8_WAIT_L(0); PG8_BAR; PG8_MMA(1, 0, At, B0); PG8_MMA(1, 1, At, B1); PG8_BAR; PG8_SCHED;
        }
        if (wr == 0) PG8_BAR;
        E(acc, cur, wr, wc, fr, fq, lds, wid, lane);
        if (!has_next) break;
        if (!cur.keep) {
#pragma unroll
        for (int a = 0; a < 2; ++a)
#pragma unroll
            for (int b = 0; b < 2; ++b)
#pragma unroll
                for (int m = 0; m < 4; ++m)
#pragma unroll
                    for (int n = 0; n < 2; ++n) acc[a][b][m][n] = (f32x4){0.f, 0.f, 0.f, 0.f};
        }
        cur = nxt; cA = nA; cB = nB; ++ui;
        if (wr == 1) PG8_BAR;
    }
    PG8_WAIT_V(0);
    PG8_BAR;
#undef PG8_SA
#undef PG8_SB
#undef PG8_STAGE
#undef PG8_LDA
#undef PG8_LDB
#undef PG8_MMA
#undef PG8_WAIT_V
#undef PG8_WAIT_L
#undef PG8_BAR
#undef PG8_SCHED
}
}

__device__ __forceinline__ float fast_sigm(float z) { return __builtin_amdgcn_rcpf(1.0f + __builtin_amdgcn_exp2f(-1.4426950408889634f * z)); }
__device__ __forceinline__ float fast_silu(float z) { return z * fast_sigm(z); }

struct SchedInproj {
    int G, c;
    __device__ __forceinline__ bool next(int i, pg8::Unit& u) const {
        const long L = (long)i * G + c; if (L >= 3712) return false;
        if (L < 3584) { const int xcd = (int)(L & 7), off = (int)(L >> 3); u.pm = 8 * xcd + (off & 7); u.pn = off >> 3; }
        else { const int q = (int)L - 3584; u.pm = 64 + (q & 7); u.pn = 16 + (q >> 3); }
        u.x0 = 0; u.x1 = 0; u.nt = D / 64; u.keep = 0; u.aoff = (long)u.pm * 256 * D * 2; u.boff = (long)u.pn * 256 * D * 2; return true;
    }
};
struct EpiInproj {
    unsigned char* ws; const float* qg; const float* kg; const float2* rope;
    __device__ __forceinline__ void operator()(f32x4 (&acc)[2][2][4][2], const pg8::Unit& u, int wr, int wc, int fr, int fq, LAS unsigned char* lds, int wid, int lane) const {
        const bool isctx = u.pm >= 64;
        const int blk = u.pn >> 3;
        const int act = (blk == 0) ? ((u.pn >= 4) ? 1 : 0) : (blk == 1 || blk == 2) ? 3 : (blk == 3) ? 0 : (blk == 4) ? 1 : 2;
        bf16_t* dst; int row0;
        if (!isctx) { dst = (bf16_t*)(ws + (size_t)blk * 64 * MiB); row0 = u.pm * 256; }
        else { dst = (bf16_t*)(ws + (blk == 2 ? WS_KC : WS_VC)); row0 = (u.pm - 64) * 256; }
        const int colb = (u.pn & 7) * 256 + wc * 64 + 8 * fq;
        if (act != 3) {
#pragma unroll
            for (int ai = 0; ai < 2; ++ai)
#pragma unroll
                for (int m = 0; m < 4; ++m) {
                    bf16_t* rowp = dst + (size_t)(row0 + ai * 128 + wr * 64 + m * 16 + fr) * D + colb;
#pragma unroll
                    for (int bj = 0; bj < 2; ++bj) {
                        f32x4 v0 = acc[ai][bj][m][0], v1 = acc[ai][bj][m][1];
                        if (act == 1) { v0[0] = fast_silu(v0[0]); v0[1] = fast_silu(v0[1]); v0[2] = fast_silu(v0[2]); v0[3] = fast_silu(v0[3]); v1[0] = fast_silu(v1[0]); v1[1] = fast_silu(v1[1]); v1[2] = fast_silu(v1[2]); v1[3] = fast_silu(v1[3]); }
                        else if (act == 2) { v0[0] = fast_sigm(v0[0]); v0[1] = fast_sigm(v0[1]); v0[2] = fast_sigm(v0[2]); v0[3] = fast_sigm(v0[3]); v1[0] = fast_sigm(v1[0]); v1[1] = fast_sigm(v1[1]); v1[2] = fast_sigm(v1[2]); v1[3] = fast_sigm(v1[3]); }
                        u32x4 w; w[0] = pg8::cvt_pk_bf16(v0[0], v0[1]); w[1] = pg8::cvt_pk_bf16(v0[2], v0[3]); w[2] = pg8::cvt_pk_bf16(v1[0], v1[1]); w[3] = pg8::cvt_pk_bf16(v1[2], v1[3]);
                        *(u32x4*)(rowp + bj * 32) = w;
                    }
                }
            return;
        }
        LAS float* X = (LAS float*)(lds + XCH_OFF);
#pragma unroll
        for (int ai = 0; ai < 2; ++ai)
#pragma unroll
            for (int m = 0; m < 4; ++m) {
                float ss = 0.f;
#pragma unroll
                for (int bj = 0; bj < 2; ++bj)
#pragma unroll
                    for (int n = 0; n < 2; ++n) { const f32x4 v = acc[ai][bj][m][n]; ss += (v[0] * v[0] + v[1] * v[1]) + (v[2] * v[2] + v[3] * v[3]); }
                ss += __shfl_xor(ss, 16); ss += __shfl_xor(ss, 32);
                if (fq == 0) X[wid * 128 + ai * 64 + m * 16 + fr] = ss;
            }
        asm volatile("s_waitcnt lgkmcnt(0)" ::: "memory"); __builtin_amdgcn_s_barrier(); asm volatile("" ::: "memory");
        const int ax = wc & 1;
        const float* gain = (blk == 1 ? qg : kg) + ax * 64 + 8 * fq;
        const f32x4 g00 = *(const f32x4*)(gain), g01 = *(const f32x4*)(gain + 4), g10 = *(const f32x4*)(gain + 32), g11 = *(const f32x4*)(gain + 36);
        const float post = (blk == 1) ? QSCALE : 1.0f;
#pragma unroll
        for (int ai = 0; ai < 2; ++ai)
#pragma unroll
            for (int m = 0; m < 4; ++m) {
                const int ridx = ai * 64 + m * 16 + fr;
                const float tot = X[wid * 128 + ridx] + X[(wid ^ 1) * 128 + ridx];
                const float rs = post / sqrtf(tot * (1.0f / HD) + 1e-6f);
                f32x4 x0a = acc[ai][0][m][0] * g00 * rs, x0b = acc[ai][0][m][1] * g01 * rs, x1a = acc[ai][1][m][0] * g10 * rs, x1b = acc[ai][1][m][1] * g11 * rs;
                if (!isctx) {
                    const int t = (row0 + ai * 128 + wr * 64 + m * 16 + fr) & (S - 1);
                    const int pos = ax ? (t & 63) : (t >> 6);
                    const f32x4* rp = (const f32x4*)(rope + pos * 32 + 8 * fq);
                    const f32x4 c0 = rp[0], c1 = rp[1], c2 = rp[2], c3 = rp[3];
                    f32x4 y0a, y0b, y1a, y1b;
                    y0a[0] = x0a[0] * c0[0] - x1a[0] * c0[1]; y1a[0] = x1a[0] * c0[0] + x0a[0] * c0[1];
                    y0a[1] = x0a[1] * c0[2] - x1a[1] * c0[3]; y1a[1] = x1a[1] * c0[2] + x0a[1] * c0[3];
                    y0a[2] = x0a[2] * c1[0] - x1a[2] * c1[1]; y1a[2] = x1a[2] * c1[0] + x0a[2] * c1[1];
                    y0a[3] = x0a[3] * c1[2] - x1a[3] * c1[3]; y1a[3] = x1a[3] * c1[2] + x0a[3] * c1[3];
                    y0b[0] = x0b[0] * c2[0] - x1b[0] * c2[1]; y1b[0] = x1b[0] * c2[0] + x0b[0] * c2[1];
                    y0b[1] = x0b[1] * c2[2] - x1b[1] * c2[3]; y1b[1] = x1b[1] * c2[2] + x0b[1] * c2[3];
                    y0b[2] = x0b[2] * c3[0] - x1b[2] * c3[1]; y1b[2] = x1b[2] * c3[0] + x0b[2] * c3[1];
                    y0b[3] = x0b[3] * c3[2] - x1b[3] * c3[3]; y1b[3] = x1b[3] * c3[2] + x0b[3] * c3[3];
                    x0a = y0a; x0b = y0b; x1a = y1a; x1b = y1b;
                }
                bf16_t* rowp = dst + (size_t)(row0 + ai * 128 + wr * 64 + m * 16 + fr) * D + colb;
                u32x4 w0, w1;
                w0[0] = pg8::cvt_pk_bf16(x0a[0], x0a[1]); w0[1] = pg8::cvt_pk_bf16(x0a[2], x0a[3]); w0[2] = pg8::cvt_pk_bf16(x0b[0], x0b[1]); w0[3] = pg8::cvt_pk_bf16(x0b[2], x0b[3]);
                w1[0] = pg8::cvt_pk_bf16(x1a[0], x1a[1]); w1[1] = pg8::cvt_pk_bf16(x1a[2], x1a[3]); w1[2] = pg8::cvt_pk_bf16(x1b[0], x1b[1]); w1[3] = pg8::cvt_pk_bf16(x1b[2], x1b[3]);
                *(u32x4*)(rowp) = w0; *(u32x4*)(rowp + 32) = w1;
            }
    }
};

struct SchedChan {
    int G, c;
    __device__ __forceinline__ bool next(int i, pg8::Unit& u) const {
        const long L = (long)i * G + c; if (L >= 512) return false;
        const int part = (int)(L & 1), g = (int)((L >> 1) & 3), pnt = (int)(L >> 3);
        u.pm = part; u.pn = pnt; u.x0 = g; u.x1 = 0; u.nt = 4; u.keep = 0; u.aoff = (long)part * 256 * 256 * 2; u.boff = ((long)pnt * 256 * D + g * 256) * 2; return true;
    }
};
struct EpiChan {
    bf16_t* PQt;
    __device__ __forceinline__ void operator()(f32x4 (&acc)[2][2][4][2], const pg8::Unit& u, int wr, int wc, int fr, int fq, LAS unsigned char*, int, int) const {
        const int b = u.pn >> 3, n0 = (u.pn & 7) * 256, part = u.pm, g = u.x0;
        bf16_t* base = PQt + ((size_t)(b * 1024 + g * 256) * 4096 + part * 2048 + n0 + wc * 64 + 8 * fq);
#pragma unroll
        for (int ai = 0; ai < 2; ++ai)
#pragma unroll
            for (int m = 0; m < 4; ++m) {
                bf16_t* rowp = base + (size_t)(ai * 128 + wr * 64 + m * 16 + fr) * 4096;
#pragma unroll
                for (int bj = 0; bj < 2; ++bj) { const f32x4 v0 = acc[ai][bj][m][0], v1 = acc[ai][bj][m][1];
                    u32x4 w; w[0] = pg8::cvt_pk_bf16(v0[0], v0[1]); w[1] = pg8::cvt_pk_bf16(v0[2], v0[3]); w[2] = pg8::cvt_pk_bf16(v1[0], v1[1]); w[3] = pg8::cvt_pk_bf16(v1[2], v1[3]);
                    *(u32x4*)(rowp + bj * 32) = w; }
            }
    }
};
struct SchedPos {
    int G, c;
    __device__ __forceinline__ bool next(int i, pg8::Unit& u) const {
        const long L = (long)i * G + c; if (L >= 256) return false;
        const int b = (int)(L >> 5), pm = (int)((L & 31) >> 2), pn = (int)(L & 3);
        u.pm = pm; u.pn = pn; u.x0 = b; u.x1 = 0; u.nt = 64; u.keep = 0; u.aoff = (long)pm * 256 * 4096 * 2; u.boff = ((long)b * 1024 + pn * 256) * 4096 * 2; return true;
    }
};
__device__ __forceinline__ float bflo(unsigned w) { return __uint_as_float(w << 16); }
__device__ __forceinline__ float bfhi(unsigned w) { return __uint_as_float(w & 0xffff0000u); }
struct EpiPos {
    bf16_t* UZ;
    __device__ __forceinline__ void operator()(f32x4 (&acc)[2][2][4][2], const pg8::Unit& u, int wr, int wc, int fr, int fq, LAS unsigned char*, int, int) const {
        bf16_t* base = UZ + ((size_t)(u.x0 * S + u.pm * 256) * D + OFF_ZF + u.pn * 256 + wc * 64 + 8 * fq);
#pragma unroll
        for (int ai = 0; ai < 2; ++ai)
#pragma unroll
            for (int m = 0; m < 4; ++m) {
                bf16_t* rowp = base + (size_t)(ai * 128 + wr * 64 + m * 16 + fr) * D;
#pragma unroll
                for (int bj = 0; bj < 2; ++bj) { const f32x4 v0 = acc[ai][bj][m][0], v1 = acc[ai][bj][m][1];
                    const u32x4 z = *(const u32x4*)(rowp + bj * 32);
                    u32x4 w; w[0] = pg8::cvt_pk_bf16(v0[0] * bflo(z[0]), v0[1] * bfhi(z[0])); w[1] = pg8::cvt_pk_bf16(v0[2] * bflo(z[1]), v0[3] * bfhi(z[1]));
                    w[2] = pg8::cvt_pk_bf16(v1[0] * bflo(z[2]), v1[1] * bfhi(z[2])); w[3] = pg8::cvt_pk_bf16(v1[2] * bflo(z[3]), v1[3] * bfhi(z[3]));
                    *(u32x4*)(rowp + bj * 32) = w; }
            }
    }
};
struct SchedRows {
    int G, c;
    __device__ __forceinline__ bool next(int i, pg8::Unit& u) const {
        const long L = (long)i * G + c; if (L >= 512) return false;
        const int xcd = (int)(L & 7), off = (int)(L >> 3);
        u.pm = 8 * xcd + (off & 7); u.pn = off >> 3; u.x0 = 0; u.x1 = 0; u.nt = D / 64; u.keep = 0; u.aoff = (long)u.pm * 256 * D * 2; u.boff = (long)u.pn * 256 * D * 2; return true;
    }
};
struct SchedY {
    int G, c; long a2off;
    __device__ __forceinline__ bool next(int i, pg8::Unit& u) const {
        const int seg = i & 1; const long L = (long)(i >> 1) * G + c; if (L >= 512) return false;
        const int xcd = (int)(L & 7), off = (int)(L >> 3);
        u.pm = 8 * xcd + (off & 7); u.pn = off >> 3; u.x0 = seg; u.x1 = 0; u.nt = seg ? 32 : 16; u.keep = seg ? 0 : 1;
        u.aoff = (long)u.pm * 256 * D * 2 + (seg ? a2off : 0); u.boff = (long)u.pn * 256 * 3072 * 2 + (seg ? 1024 * 2 : 0); return true;
    }
};
struct EpiY {
    bf16_t* SGF; const bf16_t* SGA;
    __device__ __forceinline__ void mid(f32x4 (&acc)[2][2][4][2], const pg8::Unit& u, int wr, int wc, int fr, int fq) const {
        const size_t base = (size_t)(u.pm * 256 + wr * 64 + fr) * D + u.pn * 256 + wc * 64 + 8 * fq;
#pragma unroll
        for (int ai = 0; ai < 2; ++ai)
#pragma unroll
            for (int m = 0; m < 4; ++m)
#pragma unroll
                for (int bj = 0; bj < 2; ++bj) {
                    const size_t o = base + (size_t)(ai * 128 + m * 16) * D + bj * 32;
                    const u32x4 gf = *(const u32x4*)(SGF + o), ga = *(const u32x4*)(SGA + o);
                    f32x4& v0 = acc[ai][bj][m][0]; f32x4& v1 = acc[ai][bj][m][1];
                    v0[0] *= bflo(gf[0]) * __builtin_amdgcn_rcpf(bflo(ga[0])); v0[1] *= bfhi(gf[0]) * __builtin_amdgcn_rcpf(bfhi(ga[0]));
                    v0[2] *= bflo(gf[1]) * __builtin_amdgcn_rcpf(bflo(ga[1])); v0[3] *= bfhi(gf[1]) * __builtin_amdgcn_rcpf(bfhi(ga[1]));
                    v1[0] *= bflo(gf[2]) * __builtin_amdgcn_rcpf(bflo(ga[2])); v1[1] *= bfhi(gf[2]) * __builtin_amdgcn_rcpf(bfhi(ga[2]));
                    v1[2] *= bflo(gf[3]) * __builtin_amdgcn_rcpf(bflo(ga[3])); v1[3] *= bfhi(gf[3]) * __builtin_amdgcn_rcpf(bfhi(ga[3]));
                    if (bj == 1) asm volatile("" ::: "memory");
                }
    }
    __device__ __forceinline__ void operator()(f32x4 (&acc)[2][2][4][2], const pg8::Unit& u, int wr, int wc, int fr, int fq, LAS unsigned char*, int, int) const {
        if (u.x0 == 0) { mid(acc, u, wr, wc, fr, fq); return; }
        const size_t base = (size_t)(u.pm * 256 + wr * 64 + fr) * D + u.pn * 256 + wc * 64 + 8 * fq;
#pragma unroll
        for (int ai = 0; ai < 2; ++ai)
#pragma unroll
            for (int m = 0; m < 4; ++m)
#pragma unroll
                for (int bj = 0; bj < 2; ++bj) {
                    const size_t o = base + (size_t)(ai * 128 + m * 16) * D + bj * 32;
                    const u32x4 ga = *(const u32x4*)(SGA + o);
                    const f32x4 v0 = acc[ai][bj][m][0], v1 = acc[ai][bj][m][1];
                    u32x4 w; w[0] = pg8::cvt_pk_bf16(v0[0] * bflo(ga[0]), v0[1] * bfhi(ga[0])); w[1] = pg8::cvt_pk_bf16(v0[2] * bflo(ga[1]), v0[3] * bfhi(ga[1]));
                    w[2] = pg8::cvt_pk_bf16(v1[0] * bflo(ga[2]), v1[1] * bfhi(ga[2])); w[3] = pg8::cvt_pk_bf16(v1[2] * bflo(ga[3]), v1[3] * bfhi(ga[3]));
                    *(u32x4*)(SGF + o) = w;
                }
    }
};
struct EpiOut {
    const float* x; const float* mod; float* out;
    __device__ __forceinline__ void operator()(f32x4 (&acc)[2][2][4][2], const pg8::Unit& u, int wr, int wc, int fr, int fq, LAS unsigned char*, int, int) const {
        const int col = u.pn * 256 + wc * 64 + 8 * fq;
        const float* gate = mod + (size_t)(u.pm >> 3) * 3 * D + 2 * D + col;
        f32x4 gt[2][2];
#pragma unroll
        for (int bj = 0; bj < 2; ++bj) { gt[bj][0] = *(const f32x4*)(gate + bj * 32); gt[bj][1] = *(const f32x4*)(gate + bj * 32 + 4); }
#pragma unroll
        for (int ai = 0; ai < 2; ++ai)
#pragma unroll
            for (int m = 0; m < 4; ++m) {
                const size_t o = (size_t)(u.pm * 256 + ai * 128 + wr * 64 + m * 16 + fr) * D + col;
#pragma unroll
                for (int bj = 0; bj < 2; ++bj)
#pragma unroll
                    for (int n = 0; n < 2; ++n) { const f32x4 xv = *(const f32x4*)(x + o + bj * 32 + n * 4); *(f32x4*)(out + o + bj * 32 + n * 4) = xv + gt[bj][n] * acc[ai][bj][m][n]; }
            }
    }
};

namespace natt {
typedef short v4i16_t __attribute__((ext_vector_type(4)));
__device__ __forceinline__ v4i16_t vtr(const LAS unsigned char* p) { return __builtin_amdgcn_ds_read_tr16_b64_v4i16((LAS v4i16_t*)p); }
struct Tensors { const bf16_t* Q; bf16_t* O; const bf16_t* K; const bf16_t* V; const bf16_t* KC; const bf16_t* VC; const bf16_t* SZA; const float* rpb; const float* shift; };

__device__ __forceinline__ void pair(const LAS unsigned char* Kb, const LAS unsigned char* Vb, int keybase, const bf16x8 (&qf)[4], f32x4 (&o)[8], float& lsum,
                                     int fr, int fq, bool local, const int (&dcv)[2][4], const LAS float* Trow, float shift) {
    f32x4 sx = (f32x4){0.f, 0.f, 0.f, 0.f}, sy = (f32x4){0.f, 0.f, 0.f, 0.f};
    const int krow = keybase + fr;
#pragma unroll
    for (int ks = 0; ks < 4; ++ks) {
        const int pos = ((4 * ks + fq) ^ (krow & 15)) * 16;
        const bf16x8 kx = *(const LAS bf16x8*)(Kb + krow * 256 + pos), ky = *(const LAS bf16x8*)(Kb + (krow + 16) * 256 + pos);
        sx = __builtin_amdgcn_mfma_f32_16x16x32_bf16(kx, qf[ks], sx, 0, 0, 0);
        sy = __builtin_amdgcn_mfma_f32_16x16x32_bf16(ky, qf[ks], sy, 0, 0, 0);
    }
    float px[4], py[4];
#pragma unroll
    for (int j = 0; j < 4; ++j) {
        if (local) {
            const int ix = dcv[0][j], iy = dcv[1][j];
            const float bx = Trow[ix < 0 ? 0 : ix], by = Trow[iy < 0 ? 0 : iy];
            px[j] = ix < 0 ? 0.f : __builtin_amdgcn_exp2f(sx[j] + bx - shift);
            py[j] = iy < 0 ? 0.f : __builtin_amdgcn_exp2f(sy[j] + by - shift);
        } else { px[j] = __builtin_amdgcn_exp2f(sx[j] - shift); py[j] = __builtin_amdgcn_exp2f(sy[j] - shift); }
    }
    lsum += ((px[0] + px[1]) + (px[2] + px[3])) + ((py[0] + py[1]) + (py[2] + py[3]));
    u32x4 pw; pw[0] = pg8::cvt_pk_bf16(px[0], px[1]); pw[1] = pg8::cvt_pk_bf16(px[2], px[3]); pw[2] = pg8::cvt_pk_bf16(py[0], py[1]); pw[3] = pg8::cvt_pk_bf16(py[2], py[3]);
    const bf16x8 pb = __builtin_bit_cast(bf16x8, pw);
    const int vrow = keybase + 4 * fq + (fr >> 2), sw = (vrow & 7) << 1;
    const LAS unsigned char* vp = Vb + vrow * 256 + (fr & 1) * 8;
    const int ch = (fr & 3) >> 1;
#pragma unroll
    for (int db = 0; db < 8; ++db) {
        const int pos = ((2 * db + ch) ^ sw) * 16;
        const v4i16_t vx = vtr(vp + pos), vy = vtr(vp + 16 * 256 + pos);
        const bf16x8 vf = (bf16x8){vx[0], vx[1], vx[2], vx[3], vy[0], vy[1], vy[2], vy[3]};
        o[db] = __builtin_amdgcn_mfma_f32_16x16x32_bf16(vf, pb, o[db], 0, 0, 0);
    }
}

__device__ __forceinline__ void attn_phase(LAS unsigned char* lds, const Tensors& T, int vcu) {
    int tid = threadIdx.x; asm volatile("" : "+v"(tid));
    const int lane = tid & 63, wid = __builtin_amdgcn_readfirstlane(tid >> 6), fr = lane & 15, fq = lane >> 4;
    const int bh = vcu >> 1, b = bh >> 4, h = bh & 15;
    LAS float* Tb = (LAS float*)(lds + XCH_OFF);
    for (int i = tid; i < 465; i += NWAVES * 64) Tb[i] = T.rpb[h * 465 + i] * 1.4426950408889634f;
    const float shift = T.shift[0];
    const int s = wid & 3, wq = wid >> 2;
    const int cw = (s == 0) ? 0 : (s == 1) ? 8 : (s == 2) ? 24 : 32;
    const int c = 16 * s + fr, cst = min(max(c - 8, 0), 48);
    int dcv[2][4];
#pragma unroll
    for (int blk = 0; blk < 2; ++blk)
#pragma unroll
        for (int j = 0; j < 4; ++j) { const int kc = cw + 16 * blk + 4 * fq + j; dcv[blk][j] = (kc >= cst && kc < cst + 16) ? (kc - c + 15) : -1; }
    const bool isV = wid >= 4;
    const int drow = 16 * (wid & 3) + (lane >> 4), dp = lane & 15;
    for (int ui = 0; ui < 8; ++ui) {
        const int rp = (vcu & 1) * 8 + ui, r0 = 2 * rp, qrow = r0 + wq;
        const int rs0 = min(max(r0 - 4, 0), 24), rs1 = min(max(r0 - 3, 0), 24), rsq = wq ? rs1 : rs0;
        const int ntile = 4 + (rs1 + 8 - rs0);
        const size_t qtok = (size_t)b * S + qrow * 64 + 16 * s + fr;
        const bf16_t* qp = T.Q + qtok * D + h * HD; bf16_t* op = T.O + qtok * D + h * HD;
        bf16x8 qf[4];
#pragma unroll
        for (int ks = 0; ks < 4; ++ks) qf[ks] = *(const bf16x8*)(qp + 32 * ks + 8 * fq);
        f32x4 o[8];
#pragma unroll
        for (int db = 0; db < 8; ++db) o[db] = (f32x4){0.f, 0.f, 0.f, 0.f};
        float lsum = 0.f;
#define NATT_ISSUE(j) do { const int j_ = (j); const bf16_t* src_; \
            if (j_ < 4) src_ = (isV ? T.VC : T.KC) + ((size_t)b * L + 64 * j_) * D + h * HD; \
            else src_ = (isV ? T.V : T.K) + ((size_t)b * S + (rs0 + j_ - 4) * 64) * D + h * HD; \
            LAS unsigned char* dst_ = lds + (j_ & 1) * 32768 + (isV ? 16384 : 0) + (wid & 3) * 4096; \
            _Pragma("unroll") for (int e_ = 0; e_ < 4; ++e_) { const int row_ = drow + 4 * e_; const int c_ = isV ? (dp ^ ((row_ & 7) << 1)) : (dp ^ (row_ & 15)); \
                __builtin_amdgcn_global_load_lds((const unsigned*)(src_ + (size_t)row_ * D + c_ * 8), (LAS unsigned*)(dst_ + e_ * 1024), 16, 0, 0); } } while (0)
        NATT_ISSUE(0);
        for (int j = 0; j < ntile; ++j) {
            asm volatile("s_waitcnt vmcnt(0) lgkmcnt(0)" ::: "memory"); __builtin_amdgcn_s_barrier(); asm volatile("" ::: "memory");
            if (j + 1 < ntile) NATT_ISSUE(j + 1);
            const LAS unsigned char* Kb = lds + (j & 1) * 32768; const LAS unsigned char* Vb = Kb + 16384;
            if (j < 4) {
                pair(Kb, Vb, 0, qf, o, lsum, fr, fq, false, dcv, Tb, shift);
                pair(Kb, Vb, 32, qf, o, lsum, fr, fq, false, dcv, Tb, shift);
            } else {
                const int kr = rs0 + j - 4;
                if (kr >= rsq && kr < rsq + 8) pair(Kb, Vb, cw, qf, o, lsum, fr, fq, true, dcv, Tb + (kr - qrow + 7) * 31, shift);
            }
        }
#undef NATT_ISSUE
        asm volatile("s_waitcnt lgkmcnt(0)" ::: "memory"); __builtin_amdgcn_s_barrier(); asm volatile("" ::: "memory");
        lsum += __shfl_xor(lsum, 16); lsum += __shfl_xor(lsum, 32);
        const float inv = 1.0f / lsum;
        const bf16_t* zp = T.SZA + qtok * D + h * HD + 4 * fq;
#pragma unroll
        for (int db = 0; db < 8; ++db) {
            const u32x2 z = *(const u32x2*)(zp + 16 * db);
            u32x2 w; w[0] = pg8::cvt_pk_bf16(o[db][0] * inv * bflo(z[0]), o[db][1] * inv * bfhi(z[0])); w[1] = pg8::cvt_pk_bf16(o[db][2] * inv * bflo(z[1]), o[db][3] * inv * bfhi(z[1]));
            *(u32x2*)(op + 16 * db + 4 * fq) = w;
        }
    }
}
}

#ifndef REP_P0
#define REP_P0 1
#endif
#ifndef REP_P1
#define REP_P1 1
#endif
#ifndef REP_P2
#define REP_P2 1
#endif
#ifndef REP_P3C
#define REP_P3C 1
#endif
#ifndef REP_ATT
#define REP_ATT 1
#endif
#ifndef REP_P6
#define REP_P6 1
#endif

struct MArgs { const float* in[13]; float* out; unsigned char* ws; int ph_lo, ph_hi, li, pad; };
struct Frame {
    LAS unsigned char* lds; volatile LAS unsigned* MISC; unsigned* ctl; int tid, lane, wave, vcu, G;
};
__device__ __forceinline__ unsigned pk2(float lo, float hi) { return f2bf(lo) | (f2bf(hi) << 16); }

__device__ __forceinline__ void p0_transpose_item(const float* W, int N, bf16_t* WT, int ldo, int koff, int k0, int n0, int lane) {
    f32x4 v[16];
    const float* src = W + (size_t)k0 * N + n0 + 4 * lane;
#pragma unroll
    for (int kk = 0; kk < 16; ++kk) v[kk] = __builtin_nontemporal_load((const f32x4*)(src + (size_t)kk * N));
#pragma unroll
    for (int j = 0; j < 4; ++j) {
        u32x4 a, b;
        a[0] = pk2(v[0][j], v[1][j]); a[1] = pk2(v[2][j], v[3][j]); a[2] = pk2(v[4][j], v[5][j]); a[3] = pk2(v[6][j], v[7][j]);
        b[0] = pk2(v[8][j], v[9][j]); b[1] = pk2(v[10][j], v[11][j]); b[2] = pk2(v[12][j], v[13][j]); b[3] = pk2(v[14][j], v[15][j]);
        bf16_t* dst = WT + (size_t)(n0 + 4 * lane + j) * ldo + koff + k0;
        *(u32x4*)dst = a; *(u32x4*)(dst + 8) = b;
    }
}
__device__ __forceinline__ void p0_mod_item(const float* c, const float* cctx, const float* wmod, const float* bmod, float* mod, LAS float* scr, int item, int lane) {
    const int j0 = item * 16, fq = lane >> 4, fr = lane & 15;
    f32x4 acc0 = (f32x4){0.f, 0.f, 0.f, 0.f}, acc1 = (f32x4){0.f, 0.f, 0.f, 0.f};
    for (int k0 = 0; k0 < D; k0 += 256) {
#pragma unroll 4
        for (int i = 0; i < 64; ++i) { const int idx = i * 64 + lane, b = idx >> 8, kk = idx & 255; float v = 0.f; if (b < 9) { const float z = (b < 8) ? c[b * D + k0 + kk] : cctx[k0 + kk]; v = z / (1.0f + __expf(-z)); } scr[idx] = v; }
        LDS_WAIT(); asm volatile("" ::: "memory");
        const float* wp = wmod + (size_t)(k0 + fq) * (3 * D) + j0 + fr;
#pragma unroll 8
        for (int i = 0; i < 64; i += 2) {
            const float w0 = wp[(size_t)(4 * i) * (3 * D)], w1 = wp[(size_t)(4 * i + 4) * (3 * D)];
            const float a0 = scr[fr * 256 + 4 * i + fq], a1 = scr[fr * 256 + 4 * i + 4 + fq];
            acc0 = __builtin_amdgcn_mfma_f32_16x16x4f32(a0, w0, acc0, 0, 0, 0);
            acc1 = __builtin_amdgcn_mfma_f32_16x16x4f32(a1, w1, acc1, 0, 0, 0);
        }
        LDS_WAIT(); asm volatile("" ::: "memory");
    }
#pragma unroll
    for (int r = 0; r < 4; ++r) { const int b = 4 * fq + r; if (b < 9) mod[b * 3 * D + j0 + fr] = acc0[r] + acc1[r] + bmod[j0 + fr]; }
}
__device__ __forceinline__ void p0_table_item(float2* rope, bf16_t* CS, bf16_t* DFTA, const float* qg, const float* kg, const float* rpbp, float* shiftp, int item, int lane) {
    if (item == 0) {
        for (int i = 0; i < 32; ++i) { const int gid = i * 64 + lane, pos = gid >> 5, j = gid & 31;
            const float invf = exp2f(-(float)j * 0.41524101186092029f); const float ang = (float)pos * invf; float sn, cs; sincosf(ang, &sn, &cs);
            rope[gid] = make_float2(cs, sn); }
        float mq = fmaxf(fabsf(qg[lane]), fabsf(qg[lane + 64])), mk = fmaxf(fabsf(kg[lane]), fabsf(kg[lane + 64])), mb = 0.f;
        for (int i = lane; i < NH * 465; i += 64) mb = fmaxf(mb, rpbp[i]);
        mq = wave_max(mq); mk = wave_max(mk); mb = wave_max(mb);
        if (lane == 0) shiftp[0] = (11.313708498984761f * mq * mk + mb) * 1.4426950408889634f;
    } else if (item <= 32) {
        const int base = (item - 1) * 4096;
#pragma unroll
        for (int i = 0; i < 8; ++i) { const int e0 = base + (i * 64 + lane) * 8; unsigned w[4];
#pragma unroll
            for (int q = 0; q < 4; ++q) { float v[2];
#pragma unroll
                for (int z = 0; z < 2; ++z) { const int e = e0 + 2 * q + z, part = e >> 16, cp = (e >> 8) & 255, cc = e & 255, mm = (cp * cc) & 255;
                    const float rev = (float)mm * (1.0f / 256.0f); v[z] = (part == 0 ? __builtin_amdgcn_cosf(rev) : __builtin_amdgcn_sinf(rev)) * 0.0625f; }
                w[q] = pk2(v[0], v[1]); }
            *(u32x4*)(CS + e0) = (u32x4){w[0], w[1], w[2], w[3]}; }
    } else {
        const int k1 = item - 33;
#pragma unroll
        for (int i = 0; i < 8; ++i) { const int kk0 = (i * 64 + lane) * 8; unsigned w[4];
#pragma unroll
            for (int q = 0; q < 4; ++q) { float v[2];
#pragma unroll
                for (int z = 0; z < 2; ++z) { const int kk = kk0 + 2 * q + z, part = kk >> 11, n = kk & 2047, mm = (k1 * n) & 2047;
                    const float rev = (float)mm * (1.0f / 2048.0f); v[z] = (part == 0 ? __builtin_amdgcn_cosf(rev) : -__builtin_amdgcn_sinf(rev)) * 0.022097086912079608f; }
                w[q] = pk2(v[0], v[1]); }
            *(u32x4*)(DFTA + (size_t)k1 * 4096 + kk0) = (u32x4){w[0], w[1], w[2], w[3]}; }
    }
}
__device__ __forceinline__ void p1_hnorm_row(const float* src, const float* shift, const float* scale, bf16_t* dst, int lane) {
    f32x4 v[8]; float ss = 0.f;
#pragma unroll
    for (int j = 0; j < 8; ++j) { v[j] = *(const f32x4*)(src + (j * 64 + lane) * 4); ss += (v[j][0] * v[j][0] + v[j][1] * v[j][1]) + (v[j][2] * v[j][2] + v[j][3] * v[j][3]); }
    ss = wave_sum(ss);
    const float rstd = 1.0f / sqrtf(ss * (1.0f / D) + 1e-6f);
#pragma unroll
    for (int j = 0; j < 8; ++j) {
        const int k = (j * 64 + lane) * 4;
        const f32x4 sc = *(const f32x4*)(scale + k), sh = *(const f32x4*)(shift + k);
        u32x2 o;
        o[0] = pk2(v[j][0] * rstd * (1.f + sc[0]) + sh[0], v[j][1] * rstd * (1.f + sc[1]) + sh[1]);
        o[1] = pk2(v[j][2] * rstd * (1.f + sc[2]) + sh[2], v[j][3] * rstd * (1.f + sc[3]) + sh[3]);
        *(u32x2*)(dst + k) = o;
    }
}

__global__ void __launch_bounds__(NWAVES * 64, 2) mega_fwd(MArgs args) {
    extern __shared__ __attribute__((aligned(16))) unsigned char lds_raw[];
    Frame F;
    F.lds = (LAS unsigned char*)lds_raw;
    F.MISC = (volatile LAS unsigned*)(F.lds + MISC_OFF);
    F.tid = threadIdx.x; F.lane = F.tid & 63; F.wave = __builtin_amdgcn_readfirstlane(F.tid >> 6);
    F.G = gridDim.x; { const int bx = blockIdx.x; F.vcu = (F.G % 8 == 0) ? (bx % 8) * (F.G / 8) + bx / 8 : bx; }
    unsigned char* ws = args.ws; unsigned char* dob = (unsigned char*)args.out;
    F.ctl = (unsigned*)(ws + WS_CTL);
    const float* x = args.in[0]; const float* c = args.in[1]; const float* ctx = args.in[2]; const float* cctx = args.in[3];
    const float* wmod = args.in[4]; const float* bmod = args.in[5]; const float* win = args.in[6];
    const float* qg = args.in[7]; const float* kg = args.in[8]; const float* rpb = args.in[9];
    float* shiftp = (float*)(ws + WS_ROPE + 65536);
    const float* wf = args.in[10]; const float* wa = args.in[11]; const float* wo = args.in[12];
    bf16_t* Wfa_t = (bf16_t*)(ws + WS_WFA); bf16_t* Wo_t = (bf16_t*)(ws + WS_WO); bf16_t* DFTA = (bf16_t*)(ws + WS_DFTA); bf16_t* CS = (bf16_t*)(ws + WS_CS);
    float* mod = (float*)(ws + WS_MOD); float2* rope = (float2*)(ws + WS_ROPE);
    bf16_t* H = (bf16_t*)(dob + DO_H); bf16_t* Win_t = (bf16_t*)(dob + DO_WIN);
    for (int u = F.tid; u < (LDS_BYTES - LDSCTL_OFF) / 4; u += NWAVES * 64) ((LAS unsigned*)(F.lds + LDSCTL_OFF))[u] = 0u;
    __syncthreads();
    XcdBarrier bar = xcd_barrier_post(F.ctl + CW_BAR + args.li * XCD_BAR_WORDS, F.MISC + 8);
    const int lo = args.ph_lo, hi = args.ph_hi;
#define IN(k) (lo <= (k) && (k) < hi)
#define BOTH(k) (IN(k) && IN((k) + 1))

    for (int rep = 0; rep < REP_P0; ++rep) if (IN(0)) {
        LAS float* scr = (LAS float*)(F.lds + F.wave * 16384);
        {   const int gw = F.wave * F.G + F.vcu;
            constexpr int I_MOD = 384, I_TAB = 33 + 2048;
            for (int it = gw; it < I_MOD + I_TAB; it += F.G * NWAVES) {
                if (it < I_MOD) p0_mod_item(c, cctx, wmod, bmod, mod, scr, it, F.lane);
                else p0_table_item(rope, CS, DFTA, qg, kg, rpb, shiftp, it - I_MOD, F.lane);
            } }
        {   constexpr int I_WIN = 16 * 56, I_WO = 16 * 8, I_WA = 16 * 8, I_WF = 8 * 8;
            for (int wi = F.vcu; wi < I_WIN + I_WO + I_WA + I_WF; wi += F.G) {
                int r = wi;
                if (r < I_WIN) { const int kb = r & 15, nb = r >> 4; p0_transpose_item(win, INW, Win_t, D, 0, kb * 128 + F.wave * 16, nb * 256, F.lane); continue; } r -= I_WIN;
                if (r < I_WO) { const int kb = r & 15, nb = r >> 4; p0_transpose_item(wo, D, Wo_t, D, 0, kb * 128 + F.wave * 16, nb * 256, F.lane); continue; } r -= I_WO;
                if (r < I_WA) { const int kb = r & 15, nb = r >> 4; p0_transpose_item(wa, D, Wfa_t, 3072, 1024, kb * 128 + F.wave * 16, nb * 256, F.lane); continue; } r -= I_WA;
                { const int kb = r & 7, nb = r >> 3; p0_transpose_item(wf, D, Wfa_t, 3072, 0, kb * 128 + F.wave * 16, nb * 256, F.lane); }
            } }
        if (BOTH(0)) xcd_barrier(bar);
    }
    for (int rep = 0; rep < REP_P1; ++rep) if (IN(1)) {
        const int gw = F.vcu * NWAVES + F.wave, NGW = F.G * NWAVES;
        for (int row = gw; row < NB * S + NB * L; row += NGW) {
            const float* src; int mb;
            if (row < NB * S) { src = x + (size_t)row * D; mb = row / S; } else { src = ctx + (size_t)(row - NB * S) * D; mb = 8; }
            p1_hnorm_row(src, mod + (size_t)mb * 3 * D, mod + (size_t)mb * 3 * D + D, H + (size_t)row * D, F.lane);
        }
        if (BOTH(1)) xcd_barrier(bar);
    }
    for (int rep = 0; rep < REP_P2; ++rep) if (IN(2)) {
        pg8::Gemm g{H, Win_t, D, D};
        SchedInproj Sc{F.G, (int)blockIdx.x};
        EpiInproj E{ws, qg, kg, rope};
        pg8::gemm_phase<EpiInproj, SchedInproj>(F.lds, g, Sc, E);
        if (BOTH(2)) xcd_barrier(bar);
    }
    if (IN(3)) {
        pg8::Gemm g{CS, (const bf16_t*)(ws + WS_UZ), 256, D};
        SchedChan Sc{F.G, (int)blockIdx.x};
        EpiChan E{(bf16_t*)(dob + DO_PQT)};
        for (int rep = 0; rep < REP_P3C; ++rep) pg8::gemm_phase<EpiChan, SchedChan>(F.lds, g, Sc, E);
        natt::Tensors AT{(const bf16_t*)(ws + WS_Q), (bf16_t*)(ws + WS_Q), (const bf16_t*)(ws + WS_K), (const bf16_t*)(ws + WS_V), (const bf16_t*)(ws + WS_KC), (const bf16_t*)(ws + WS_VC), (const bf16_t*)(ws + WS_SZA), rpb, shiftp};
        for (int rep = 1; rep < REP_ATT; ++rep) { natt::Tensors AD = AT; AD.O = (bf16_t*)(dob + 64 * MiB); natt::attn_phase(F.lds, AD, F.vcu); }
        natt::attn_phase(F.lds, AT, F.vcu);
        if (BOTH(3)) xcd_barrier(bar);
    }
    if (IN(4)) {
        pg8::Gemm g{DFTA, (const bf16_t*)(dob + DO_PQT), 4096, 4096};
        SchedPos Sc{F.G, F.vcu};
        EpiPos E{(bf16_t*)(ws + WS_UZ)};
        pg8::gemm_phase<EpiPos, SchedPos>(F.lds, g, Sc, E);
        if (BOTH(4)) xcd_barrier(bar);
    }
    if (IN(5)) {
        pg8::Gemm g{(const bf16_t*)(ws + WS_UZ) + OFF_ZF, Wfa_t, D, 3072};
        SchedY Sc{F.G, (int)blockIdx.x, (long)(WS_Q - WS_UZ) - (long)OFF_ZF * 2};
        EpiY E{(bf16_t*)(ws + WS_SGF), (const bf16_t*)(ws + WS_SGA)};
        pg8::gemm_phase<EpiY, SchedY>(F.lds, g, Sc, E);
        if (BOTH(5)) xcd_barrier(bar);
    }
    for (int rep = 0; rep < REP_P6; ++rep) if (IN(6)) {
        pg8::Gemm g{(const bf16_t*)(ws + WS_SGF), Wo_t, D, D};
        SchedRows Sc{F.G, (int)blockIdx.x};
        EpiOut E{x, mod, args.out};
        pg8::gemm_phase<EpiOut, SchedRows>(F.lds, g, Sc, E);
    }
#undef IN
#undef BOTH
}

extern "C" void kernel_launch(void* const* d_in, const int* in_sizes, int n_in, void* d_out, int out_size, void* d_ws, size_t ws_size, hipStream_t stream) {
    unsigned char* ws = (unsigned char*)d_ws;
    if (ws_size < WS_END || n_in != 13) return;
    static int grid = 0;
    if (grid == 0) {
        int dev = 0, cus = 0, per_cu = 0;
        if (hipGetDevice(&dev) != hipSuccess || hipDeviceGetAttribute(&cus, hipDeviceAttributeMultiprocessorCount, dev) != hipSuccess) { grid = -1; return; }
        if (hipFuncSetAttribute((const void*)mega_fwd, hipFuncAttributeMaxDynamicSharedMemorySize, LDS_BYTES) != hipSuccess) { grid = -1; return; }
        if (hipOccupancyMaxActiveBlocksPerMultiprocessor(&per_cu, (const void*)mega_fwd, NWAVES * 64, LDS_BYTES) != hipSuccess || per_cu < 1) { fprintf(stderr, "occupancy query: %d\n", per_cu); grid = -1; return; }
        (void)hipGetLastError();
        grid = cus;
    }
    if (grid != 256) return;
    (void)hipMemsetAsync(ws + WS_CTL, 0, 1 * MiB, stream);
    MArgs a; memset(&a, 0, sizeof(a));
    for (int i = 0; i < 13; ++i) a.in[i] = (const float*)d_in[i];
    a.out = (float*)d_out; a.ws = ws; a.ph_lo = 0; a.ph_hi = 7; a.li = 0;
    hipLaunchKernelGGL(mega_fwd, dim3(grid), dim3(NWAVES * 64), LDS_BYTES, stream, a);
}
```

```cpp
#include <hip/hip_runtime.h>
#include <stdint.h>
#include <string.h>
#include <stdio.h>

typedef unsigned short bf16_t;
typedef short bf16x8 __attribute__((ext_vector_type(8)));
typedef float f32x4 __attribute__((ext_vector_type(4)));
typedef unsigned u32x4 __attribute__((ext_vector_type(4)));
typedef unsigned u32x2 __attribute__((ext_vector_type(2)));

constexpr int D = 2048, NB = 8, S = 2048, L = 256, NH = 16, HD = 128, FW = 1024, INW = 14336;
constexpr int OFF_ZF = 1024, OFF_Q = 2048, OFF_K = 4096, OFF_V = 6144, OFF_ZA = 8192, OFF_GF = 10240, OFF_GA = 12288;
constexpr size_t MiB = 1u << 20;
constexpr float QSCALE = 0.08838834764831845f * 1.4426950408889634f;
constexpr size_t WS_UZ = 0, WS_Q = 64 * MiB, WS_K = 128 * MiB, WS_V = 192 * MiB, WS_SZA = 256 * MiB, WS_SGF = 320 * MiB, WS_SGA = 384 * MiB,
                 WS_KC = 448 * MiB, WS_VC = 456 * MiB, WS_WFA = 464 * MiB, WS_WO = 476 * MiB, WS_DFTA = 484 * MiB,
                 WS_CTL = 500 * MiB, WS_MOD = 501 * MiB, WS_ROPE = 502 * MiB, WS_CS = 503 * MiB, WS_MODP = 504 * MiB, WS_END = 512 * MiB;
constexpr size_t DO_H = 0, DO_HC = 64 * MiB, DO_WIN = 72 * MiB, DO_PQT = 0;

__device__ __forceinline__ unsigned f2bf(float f) { unsigned u = __float_as_uint(f); return (u + 0x7fffu + ((u >> 16) & 1u)) >> 16; }
__device__ __forceinline__ float bf2f(unsigned h) { return __uint_as_float(h << 16); }
__device__ __forceinline__ float silu_f(float z) { return z / (1.0f + expf(-z)); }
__device__ __forceinline__ float sigm_f(float z) { return 1.0f / (1.0f + expf(-z)); }
__device__ __forceinline__ float wave_sum(float v) {
#pragma unroll
    for (int o = 1; o < 64; o <<= 1) v += __shfl_xor(v, o);
    return v;
}
__device__ __forceinline__ float wave_max(float v) {
#pragma unroll
    for (int o = 1; o < 64; o <<= 1) v = fmaxf(v, __shfl_xor(v, o));
    return v;
}

#define LAS __attribute__((address_space(3)))
#define GAS __attribute__((address_space(1)))
typedef GAS unsigned gu32;
#define RLX_AGENT __ATOMIC_RELAXED, __HIP_MEMORY_SCOPE_AGENT
#define LDS_WAIT() asm volatile("s_waitcnt lgkmcnt(0)" ::: "memory")
#define VM_WAIT() asm volatile("s_waitcnt vmcnt(0)" ::: "memory")
constexpr int NWAVES = 8;
constexpr int RING_BYTES = 131072, LDSCTL_OFF = RING_BYTES, MISC_OFF = LDSCTL_OFF + 320, XCH_OFF = LDSCTL_OFF + 1024, LDS_BYTES = 147456;
constexpr int CW_BAR = 4096;

#define XB_TMO      128
#define XB_XCNT(j)  (256  + 64 * (j))
#define XB_XSUB(j)  (1280 + 64 * (j))
#define XB_XGEN(j)  (2304 + 64 * (j))
#define XB_TOP      3328
#define XB_TOPGEN   3392
#define XCD_BAR_WORDS 3456
#define XB_SPIN_CAP (1u << 18)
__device__ __forceinline__ unsigned xb_ld(unsigned* p)              { return __hip_atomic_load(p, __ATOMIC_RELAXED, __HIP_MEMORY_SCOPE_AGENT); }
__device__ __forceinline__ unsigned xb_add(unsigned* p, unsigned v) { return __hip_atomic_fetch_add(p, v, __ATOMIC_RELAXED, __HIP_MEMORY_SCOPE_AGENT); }
__device__ __forceinline__ unsigned xb_xcc_id() { return (unsigned)__builtin_amdgcn_s_getreg((3 << 11) | 20) & 0xFu; }
#define XB_SPIN(cond, bar) do { unsigned _sp = 0; while (cond) { __builtin_amdgcn_s_sleep(1); \
    if ((++_sp & 255u) == 0u) { if (xb_ld(&(bar)[XB_TMO])) break; if (_sp > XB_SPIN_CAP) { atomicAdd(&(bar)[XB_TMO], 1u); break; } } } } while (0)
struct XcdBarrier { unsigned* bar; unsigned x; volatile LAS unsigned* st; };
__device__ __forceinline__ XcdBarrier xcd_barrier_post(unsigned* bar, volatile LAS unsigned* st) {
    XcdBarrier b; b.bar = bar; b.x = xb_xcc_id(); b.st = st;
    if (threadIdx.x == 0) (void)xb_add(&bar[XB_XCNT(b.x)], 1u);
    return b;
}
__device__ __forceinline__ void xcd_barrier_complete(unsigned* bar, unsigned x, unsigned& nloc, unsigned& nx) {
    const unsigned G = gridDim.x * gridDim.y * gridDim.z;
    unsigned sum, cnt, mine, sp = 0u;
    for (;;) {
        sum = 0u; cnt = 0u; mine = 0u;
#pragma unroll
        for (unsigned j = 0; j < 16; ++j) { const unsigned c = xb_ld(&bar[XB_XCNT(j)]); sum += c; cnt += (c > 0u) ? 1u : 0u; mine = (j == x) ? c : mine; }
        if (sum == G) break;
        __builtin_amdgcn_s_sleep(1);
        if ((++sp & 255u) == 0u) { if (xb_ld(&bar[XB_TMO])) break; if (sp > XB_SPIN_CAP) { atomicAdd(&bar[XB_TMO], 1u); break; } }
    }
    nloc = mine > 0u ? mine : 1u; nx = cnt > 0u ? cnt : 1u;
}
__device__ __forceinline__ void xcd_barrier(const XcdBarrier& b) {
    asm volatile("s_waitcnt vmcnt(0)" ::: "memory");
    __syncthreads();
    if (threadIdx.x == 0) {
        unsigned* bar = b.bar;
        __builtin_amdgcn_s_waitcnt(0);
        unsigned nloc = b.st[0], nx = b.st[1];
        if (nloc == 0u) { xcd_barrier_complete(bar, b.x, nloc, nx); b.st[0] = nloc; b.st[1] = nx; }
        const unsigned old = xb_add(&bar[XB_XSUB(b.x)], 1u);
        const unsigned gen = old / nloc;
        if (old + 1u == (gen + 1u) * nloc) {
            __builtin_amdgcn_fence(__ATOMIC_RELEASE, "agent");
            asm volatile("s_waitcnt vmcnt(0)" ::: "memory");
            const unsigned og = xb_add(&bar[XB_TOP], 1u);
            const unsigned tg = og / nx;
            if (og + 1u == (tg + 1u) * nx) xb_add(&bar[XB_TOPGEN], 1u);
            else XB_SPIN(xb_ld(&bar[XB_TOPGEN]) == tg, bar);
            __builtin_amdgcn_fence(__ATOMIC_ACQUIRE, "agent");
            xb_add(&bar[XB_XGEN(b.x)], 1u);
            asm volatile("s_waitcnt vmcnt(0)" ::: "memory");
        } else {
            XB_SPIN(xb_ld(&bar[XB_XGEN(b.x)]) == gen, bar);
            __builtin_amdgcn_fence(__ATOMIC_ACQUIRE, "agent");
            asm volatile("s_waitcnt vmcnt(0)" ::: "memory");
        }
    }
    __syncthreads();
}

namespace pg8 {
constexpr int BM = 256, BK = 64, HALF = 128, HTB = HALF * BK * 2, STAGE_BYTES = 8 * HTB;
__host__ __device__ __forceinline__ int lds_byte(int r, int c) { const int st = (r >> 4) * 2 + (c >> 5), rr = r & 15, cc = c & 31, ob = rr * 64 + cc * 2; return st * 1024 + (ob ^ (((ob >> 9) & 1) << 5)); }
__host__ __device__ __forceinline__ void stage_rc(int b, int& R, int& C) { const int st = b / 1024, sb = b % 1024, swz = sb ^ (((sb >> 9) & 1) << 5); R = (st >> 1) * 16 + swz / 64; C = (st & 1) * 32 + (swz % 64) / 2; }
__host__ __device__ __forceinline__ int perm32(int rho) { const int n = rho >> 4, i = rho & 15; return 8 * (i >> 2) + 4 * n + (i & 3); }
struct Unit { int pm, pn, x0, x1, nt, keep; long aoff, boff; };
struct Gemm { const bf16_t* A; const bf16_t* Bt; int lda, ldb; };
__device__ __forceinline__ unsigned cvt_pk_bf16(float lo, float hi) { unsigned r; asm volatile("v_cvt_pk_bf16_f32 %0, %1, %2" : "=v"(r) : "v"(lo), "v"(hi)); return r; }

template <class Epi, class Sched>
__device__ __forceinline__ void gemm_phase(LAS unsigned char* lds, const Gemm g, const Sched& S, const Epi& E) {
    int tid = threadIdx.x; asm volatile("" : "+v"(tid));
    const int wid = __builtin_amdgcn_readfirstlane(tid >> 6), lane = tid & 63, wr = wid >> 2, wc = wid & 3, fr = lane & 15, fq = lane >> 4;
    unsigned voffA[2], voffB[2];
#pragma unroll
    for (int i = 0; i < 2; ++i) { int R, C; stage_rc(tid * 16 + i * 8192, R, C); const int Rb = 64 * (R >> 5) + perm32(R & 31);
        voffA[i] = (unsigned)(R * g.lda + C) * 2u; voffB[i] = (unsigned)(Rb * g.ldb + C) * 2u; }
    const size_t kstep = (size_t)(BK * 2);
    const size_t hstepA = (size_t)HALF * g.lda * 2, hstepB = (size_t)32 * g.ldb * 2;
    const unsigned ldsw = (unsigned)wid * 1024u;
    const int aoff = lds_byte(wr * 64 + fr, fq * 8), boff = lds_byte(wc * 32 + fr, fq * 8);
#define PG8_SA(b, h) (((b) * 2 + (h)) * HTB)
#define PG8_SB(b, h) ((4 + (b) * 2 + (h)) * HTB)
#define PG8_STAGE(bufoff, gbase, voff) do { _Pragma("unroll") for (int _i = 0; _i < 2; ++_i) \
        __builtin_amdgcn_global_load_lds((const unsigned*)((const char*)(gbase) + (voff)[_i]), (LAS unsigned*)(lds + (bufoff) + ldsw + _i * 8192), 16, 0, 0); } while (0)
#define PG8_LDA(dst, b, h) do { _Pragma("unroll") for (int m = 0; m < 4; ++m) _Pragma("unroll") for (int k = 0; k < 2; ++k) dst[m][k] = *(const LAS bf16x8*)(lds + PG8_SA(b, h) + aoff + m * 2048 + k * 1024); } while (0)
#define PG8_LDB(dst, b, h) do { _Pragma("unroll") for (int n = 0; n < 2; ++n) _Pragma("unroll") for (int k = 0; k < 2; ++k) dst[n][k] = *(const LAS bf16x8*)(lds + PG8_SB(b, h) + boff + n * 2048 + k * 1024); } while (0)
#define PG8_MMA(ai, bj, At, Bt) do { __builtin_amdgcn_s_setprio(1); _Pragma("unroll") for (int m = 0; m < 4; ++m) _Pragma("unroll") for (int n = 0; n < 2; ++n) _Pragma("unroll") for (int k = 0; k < 2; ++k) \
        acc[ai][bj][m][n] = __builtin_amdgcn_mfma_f32_16x16x32_bf16(Bt[n][k], At[m][k], acc[ai][bj][m][n], 0, 0, 0); __builtin_amdgcn_s_setprio(0); } while (0)
#define PG8_WAIT_V(n) asm volatile("s_waitcnt vmcnt(" #n ")" ::: "memory")
#define PG8_WAIT_L(n) asm volatile("s_waitcnt lgkmcnt(" #n ")" ::: "memory")
#define PG8_BAR __builtin_amdgcn_s_barrier()
#define PG8_SCHED __builtin_amdgcn_sched_barrier(0)
    Unit cur, nxt; int ui = 0;
    if (!S.next(0, cur)) return;
    f32x4 acc[2][2][4][2];
#pragma unroll
    for (int a = 0; a < 2; ++a)
#pragma unroll
        for (int b = 0; b < 2; ++b)
#pragma unroll
            for (int m = 0; m < 4; ++m)
#pragma unroll
                for (int n = 0; n < 2; ++n) acc[a][b][m][n] = (f32x4){0.f, 0.f, 0.f, 0.f};
    bf16x8 At[4][2], B0[2][2], B1[2][2];
    const char* cA = (const char*)g.A + cur.aoff; const char* cB = (const char*)g.Bt + cur.boff;
    PG8_STAGE(PG8_SB(0, 0), cB, voffB); PG8_STAGE(PG8_SB(0, 1), cB + hstepB, voffB); PG8_STAGE(PG8_SA(0, 0), cA, voffA); PG8_STAGE(PG8_SA(0, 1), cA + hstepA, voffA);
    if (wr == 1) PG8_BAR;
    PG8_WAIT_V(2); PG8_BAR;
    PG8_STAGE(PG8_SB(1, 0), cB + kstep, voffB); PG8_STAGE(PG8_SA(1, 0), cA + kstep, voffA); PG8_STAGE(PG8_SB(1, 1), cB + hstepB + kstep, voffB);
    PG8_WAIT_V(6); PG8_BAR;
    for (;;) {
        const bool has_next = S.next(ui + 1, nxt);
        const char* nA = has_next ? (const char*)g.A + nxt.aoff : cA; const char* nB = has_next ? (const char*)g.Bt + nxt.boff : cB;
        int nt = cur.nt; asm volatile("" : "+s"(nt));
        for (int t = 0; t < nt; t += 2) {
            const bool last = (t == nt - 2);
            const char* a1 = cA + (size_t)(t + 1) * kstep;
            const char* a2 = last ? nA : cA + (size_t)(t + 2) * kstep; const char* b2 = last ? nB : cB + (size_t)(t + 2) * kstep;
            const char* a3 = a2 + kstep; const char* b3 = b2 + kstep;
            PG8_LDB(B0, 0, 0); PG8_LDB(B1, 0, 1); PG8_SCHED; PG8_LDA(At, 0, 0); PG8_STAGE(PG8_SA(1, 1), a1 + hstepA, voffA);
            PG8_WAIT_V(8); PG8_WAIT_L(0); PG8_BAR; PG8_MMA(0, 0, At, B0); PG8_MMA(0, 1, At, B1); PG8_BAR; PG8_SCHED;
            PG8_LDA(At, 0, 1); PG8_STAGE(PG8_SB(0, 0), b2, voffB); PG8_STAGE(PG8_SB(0, 1), b2 + hstepB, voffB); PG8_STAGE(PG8_SA(0, 0), a2, voffA);
            PG8_WAIT_V(8); PG8_WAIT_L(0); PG8_BAR; PG8_MMA(1, 0, At, B0); PG8_MMA(1, 1, At, B1); PG8_BAR; PG8_SCHED;
            PG8_LDB(B0, 1, 0); PG8_LDB(B1, 1, 1); PG8_SCHED; PG8_LDA(At, 1, 0); PG8_STAGE(PG8_SA(0, 1), a2 + hstepA, voffA);
            PG8_WAIT_V(8); PG8_WAIT_L(0); PG8_BAR; PG8_MMA(0, 0, At, B0); PG8_MMA(0, 1, At, B1); PG8_BAR; PG8_SCHED;
            PG8_LDA(At, 1, 1); PG8_STAGE(PG8_SB(1, 0), b3, voffB); PG8_STAGE(PG8_SB(1, 1), b3 + hstepB, voffB); PG8_STAGE(PG8_SA(1, 0), a3, voffA);
            PG8_WAIT_V(8); PG8_WAIT_L(0); PG8_BAR; PG8_MMA(1, 0, At, B0); PG8_MMA(1, 1, At, B1); PG8_BAR; PG8_SCHED;
        }
        if (wr == 0) PG8_BAR;
        E(acc, cur, wr, wc, fr, fq, lds, wid, lane);
        if (!has_next) break;
        if (!cur.keep) {
#pragma unroll
        for (int a = 0; a < 2; ++a)
#pragma unroll
            for (int b = 0; b < 2; ++b)
#pragma unroll
                for (int m = 0; m < 4; ++m)
#pragma unroll
                    for (int n = 0; n < 2; ++n) acc[a][b][m][n] = (f32x4){0.f, 0.f, 0.f, 0.f};
        }
        cur = nxt; cA = nA; cB = nB; ++ui;
        if (wr == 1) PG8_BAR;
    }
    PG8_WAIT_V(0);
    PG8_BAR;
#undef PG8_SA
#undef PG8_SB
#undef PG8_STAGE
#undef PG8_LDA
#undef PG8_LDB
#undef PG8_MMA
#undef PG8_WAIT_V
#undef PG8_WAIT_L
#undef PG8_BAR
#undef PG8_SCHED
}
}

__device__ __forceinline__ float fast_sigm(float z) { return __builtin_amdgcn_rcpf(1.0f + __builtin_amdgcn_exp2f(-1.4426950408889634f * z)); }
__device__ __forceinline__ float fast_silu(float z) { return z * fast_sigm(z); }

struct SchedInproj {
    int G, c;
    __device__ __forceinline__ bool next(int i, pg8::Unit& u) const {
        const long L = (long)i * G + c; if (L >= 3712) return false;
        if (L < 3584) { const int xcd = (int)(L & 7), off = (int)(L >> 3); u.pm = 8 * xcd + (off & 7); u.pn = off >> 3; }
        else { const int q = (int)L - 3584; u.pm = 64 + (q & 7); u.pn = 16 + (q >> 3); }
        u.x0 = 0; u.x1 = 0; u.nt = D / 64; u.keep = 0; u.aoff = (long)u.pm * 256 * D * 2; u.boff = (long)u.pn * 256 * D * 2; return true;
    }
};
struct EpiInproj {
    unsigned char* ws; const float* qg; const float* kg; const float2* rope;
    __device__ __forceinline__ void operator()(f32x4 (&acc)[2][2][4][2], const pg8::Unit& u, int wr, int wc, int fr, int fq, LAS unsigned char* lds, int wid, int lane) const {
        const bool isctx = u.pm >= 64;
        const int blk = u.pn >> 3;
        const int act = (blk == 0) ? ((u.pn >= 4) ? 1 : 0) : (blk == 1 || blk == 2) ? 3 : (blk == 3) ? 0 : (blk == 4) ? 1 : 2;
        bf16_t* dst; int row0;
        if (!isctx) { dst = (bf16_t*)(ws + (size_t)blk * 64 * MiB); row0 = u.pm * 256; }
        else { dst = (bf16_t*)(ws + (blk == 2 ? WS_KC : WS_VC)); row0 = (u.pm - 64) * 256; }
        const int colb = (u.pn & 7) * 256 + wc * 64 + 8 * fq;
        if (act != 3) {
#pragma unroll
            for (int ai = 0; ai < 2; ++ai)
#pragma unroll
                for (int m = 0; m < 4; ++m) {
                    bf16_t* rowp = dst + (size_t)(row0 + ai * 128 + wr * 64 + m * 16 + fr) * D + colb;
#pragma unroll
                    for (int bj = 0; bj < 2; ++bj) {
                        f32x4 v0 = acc[ai][bj][m][0], v1 = acc[ai][bj][m][1];
                        if (act == 1) { v0[0] = fast_silu(v0[0]); v0[1] = fast_silu(v0[1]); v0[2] = fast_silu(v0[2]); v0[3] = fast_silu(v0[3]); v1[0] = fast_silu(v1[0]); v1[1] = fast_silu(v1[1]); v1[2] = fast_silu(v1[2]); v1[3] = fast_silu(v1[3]); }
                        else if (act == 2) { v0[0] = fast_sigm(v0[0]); v0[1] = fast_sigm(v0[1]); v0[2] = fast_sigm(v0[2]); v0[3] = fast_sigm(v0[3]); v1[0] = fast_sigm(v1[0]); v1[1] = fast_sigm(v1[1]); v1[2] = fast_sigm(v1[2]); v1[3] = fast_sigm(v1[3]); }
                        u32x4 w; w[0] = pg8::cvt_pk_bf16(v0[0], v0[1]); w[1] = pg8::cvt_pk_bf16(v0[2], v0[3]); w[2] = pg8::cvt_pk_bf16(v1[0], v1[1]); w[3] = pg8::cvt_pk_bf16(v1[2], v1[3]);
                        *(u32x4*)(rowp + bj * 32) = w;
                    }
                }
            return;
        }
        LAS float* X = (LAS float*)(lds + XCH_OFF);
#pragma unroll
        for (int ai = 0; ai < 2; ++ai)
#pragma unroll
            for (int m = 0; m < 4; ++m) {
                float ss = 0.f;
#pragma unroll
                for (int bj = 0; bj < 2; ++bj)
#pragma unroll
                    for (int n = 0; n < 2; ++n) { const f32x4 v = acc[ai][bj][m][n]; ss += (v[0] * v[0] + v[1] * v[1]) + (v[2] * v[2] + v[3] * v[3]); }
                ss += __shfl_xor(ss, 16); ss += __shfl_xor(ss, 32);
                if (fq == 0) X[wid * 128 + ai * 64 + m * 16 + fr] = ss;
            }
        asm volatile("s_waitcnt lgkmcnt(0)" ::: "memory"); __builtin_amdgcn_s_barrier(); asm volatile("" ::: "memory");
        const int ax = wc & 1;
        const float* gain = (blk == 1 ? qg : kg) + ax * 64 + 8 * fq;
        const f32x4 g00 = *(const f32x4*)(gain), g01 = *(const f32x4*)(gain + 4), g10 = *(const f32x4*)(gain + 32), g11 = *(const f32x4*)(gain + 36);
        const float post = (blk == 1) ? QSCALE : 1.0f;
#pragma unroll
        for (int ai = 0; ai < 2; ++ai)
#pragma unroll
            for (int m = 0; m < 4; ++m) {
                const int ridx = ai * 64 + m * 16 + fr;
                const float tot = X[wid * 128 + ridx] + X[(wid ^ 1) * 128 + ridx];
                const float rs = post / sqrtf(tot * (1.0f / HD) + 1e-6f);
                f32x4 x0a = acc[ai][0][m][0] * g00 * rs, x0b = acc[ai][0][m][1] * g01 * rs, x1a = acc[ai][1][m][0] * g10 * rs, x1b = acc[ai][1][m][1] * g11 * rs;
                if (!isctx) {
                    const int t = (row0 + ai * 128 + wr * 64 + m * 16 + fr) & (S - 1);
                    const int pos = ax ? (t & 63) : (t >> 6);
                    const f32x4* rp = (const f32x4*)(rope + pos * 32 + 8 * fq);
                    const f32x4 c0 = rp[0], c1 = rp[1], c2 = rp[2], c3 = rp[3];
                    f32x4 y0a, y0b, y1a, y1b;
                    y0a[0] = x0a[0] * c0[0] - x1a[0] * c0[1]; y1a[0] = x1a[0] * c0[0] + x0a[0] * c0[1];
                    y0a[1] = x0a[1] * c0[2] - x1a[1] * c0[3]; y1a[1] = x1a[1] * c0[2] + x0a[1] * c0[3];
                    y0a[2] = x0a[2] * c1[0] - x1a[2] * c1[1]; y1a[2] = x1a[2] * c1[0] + x0a[2] * c1[1];
                    y0a[3] = x0a[3] * c1[2] - x1a[3] * c1[3]; y1a[3] = x1a[3] * c1[2] + x0a[3] * c1[3];
                    y0b[0] = x0b[0] * c2[0] - x1b[0] * c2[1]; y1b[0] = x1b[0] * c2[0] + x0b[0] * c2[1];
                    y0b[1] = x0b[1] * c2[2] - x1b[1] * c2[3]; y1b[1] = x1b[1] * c2[2] + x0b[1] * c2[3];
                    y0b[2] = x0b[2] * c3[0] - x1b[2] * c3[1]; y1b[2] = x1b[2] * c3[0] + x0b[2] * c3[1];
                    y0b[3] = x0b[3] * c3[2] - x1b[3] * c3[3]; y1b[3] = x1b[3] * c3[2] + x0b[3] * c3[3];
                    x0a = y0a; x0b = y0b; x1a = y1a; x1b = y1b;
                }
                bf16_t* rowp = dst + (size_t)(row0 + ai * 128 + wr * 64 + m * 16 + fr) * D + colb;
                u32x4 w0, w1;
                w0[0] = pg8::cvt_pk_bf16(x0a[0], x0a[1]); w0[1] = pg8::cvt_pk_bf16(x0a[2], x0a[3]); w0[2] = pg8::cvt_pk_bf16(x0b[0], x0b[1]); w0[3] = pg8::cvt_pk_bf16(x0b[2], x0b[3]);
                w1[0] = pg8::cvt_pk_bf16(x1a[0], x1a[1]); w1[1] = pg8::cvt_pk_bf16(x1a[2], x1a[3]); w1[2] = pg8::cvt_pk_bf16(x1b[0], x1b[1]); w1[3] = pg8::cvt_pk_bf16(x1b[2], x1b[3]);
                *(u32x4*)(rowp) = w0; *(u32x4*)(rowp + 32) = w1;
            }
    }
};

struct SchedChan {
    int G, c;
    __device__ __forceinline__ bool next(int i, pg8::Unit& u) const {
        const long L = (long)i * G + c; if (L >= 512) return false;
        const int part = (int)(L & 1), g = (int)((L >> 1) & 3), pnt = (int)(L >> 3);
        u.pm = part; u.pn = pnt; u.x0 = g; u.x1 = 0; u.nt = 4; u.keep = 0; u.aoff = (long)part * 256 * 256 * 2; u.boff = ((long)pnt * 256 * D + g * 256) * 2; return true;
    }
};
struct EpiChan {
    bf16_t* PQt;
    __device__ __forceinline__ void operator()(f32x4 (&acc)[2][2][4][2], const pg8::Unit& u, int wr, int wc, int fr, int fq, LAS unsigned char*, int, int) const {
        const int b = u.pn >> 3, n0 = (u.pn & 7) * 256, part = u.pm, g = u.x0;
        bf16_t* base = PQt + ((size_t)(b * 1024 + g * 256) * 4096 + part * 2048 + n0 + wc * 64 + 8 * fq);
#pragma unroll
        for (int ai = 0; ai < 2; ++ai)
#pragma unroll
            for (int m = 0; m < 4; ++m) {
                bf16_t* rowp = base + (size_t)(ai * 128 + wr * 64 + m * 16 + fr) * 4096;
#pragma unroll
                for (int bj = 0; bj < 2; ++bj) { const f32x4 v0 = acc[ai][bj][m][0], v1 = acc[ai][bj][m][1];
                    u32x4 w; w[0] = pg8::cvt_pk_bf16(v0[0], v0[1]); w[1] = pg8::cvt_pk_bf16(v0[2], v0[3]); w[2] = pg8::cvt_pk_bf16(v1[0], v1[1]); w[3] = pg8::cvt_pk_bf16(v1[2], v1[3]);
                    *(u32x4*)(rowp + bj * 32) = w; }
            }
    }
};
struct SchedPos {
    int G, c;
    __device__ __forceinline__ bool next(int i, pg8::Unit& u) const {
        const long L = (long)i * G + c; if (L >= 256) return false;
        const int b = (int)(L >> 5), pm = (int)((L & 31) >> 2), pn = (int)(L & 3);
        u.pm = pm; u.pn = pn; u.x0 = b; u.x1 = 0; u.nt = 64; u.keep = 0; u.aoff = (long)pm * 256 * 4096 * 2; u.boff = ((long)b * 1024 + pn * 256) * 4096 * 2; return true;
    }
};
__device__ __forceinline__ float bflo(unsigned w) { return __uint_as_float(w << 16); }
__device__ __forceinline__ float bfhi(unsigned w) { return __uint_as_float(w & 0xffff0000u); }
struct EpiPos {
    bf16_t* UZ;
    __device__ __forceinline__ void operator()(f32x4 (&acc)[2][2][4][2], const pg8::Unit& u, int wr, int wc, int fr, int fq, LAS unsigned char*, int, int) const {
        bf16_t* base = UZ + ((size_t)(u.x0 * S + u.pm * 256) * D + OFF_ZF + u.pn * 256 + wc * 64 + 8 * fq);
#pragma unroll
        for (int ai = 0; ai < 2; ++ai)
#pragma unroll
            for (int m = 0; m < 4; ++m) {
                bf16_t* rowp = base + (size_t)(ai * 128 + wr * 64 + m * 16 + fr) * D;
#pragma unroll
                for (int bj = 0; bj < 2; ++bj) { const f32x4 v0 = acc[ai][bj][m][0], v1 = acc[ai][bj][m][1];
                    const u32x4 z = *(const u32x4*)(rowp + bj * 32);
                    u32x4 w; w[0] = pg8::cvt_pk_bf16(v0[0] * bflo(z[0]), v0[1] * bfhi(z[0])); w[1] = pg8::cvt_pk_bf16(v0[2] * bflo(z[1]), v0[3] * bfhi(z[1]));
                    w[2] = pg8::cvt_pk_bf16(v1[0] * bflo(z[2]), v1[1] * bfhi(z[2])); w[3] = pg8::cvt_pk_bf16(v1[2] * bflo(z[3]), v1[3] * bfhi(z[3]));
                    *(u32x4*)(rowp + bj * 32) = w; }
            }
    }
};
struct SchedRows {
    int G, c;
    __device__ __forceinline__ bool next(int i, pg8::Unit& u) const {
        const long L = (long)i * G + c; if (L >= 512) return false;
        const int xcd = (int)(L & 7), off = (int)(L >> 3);
        u.pm = 8 * xcd + (off & 7); u.pn = off >> 3; u.x0 = 0; u.x1 = 0; u.nt = D / 64; u.keep = 0; u.aoff = (long)u.pm * 256 * D * 2; u.boff = (long)u.pn * 256 * D * 2; return true;
    }
};
struct SchedY {
    int G, c; long a2off;
    __device__ __forceinline__ bool next(int i, pg8::Unit& u) const {
        const int seg = i & 1; const long L = (long)(i >> 1) * G + c; if (L >= 512) return false;
        const int xcd = (int)(L & 7), off = (int)(L >> 3);
        u.pm = 8 * xcd + (off & 7); u.pn = off >> 3; u.x0 = seg; u.x1 = 0; u.nt = seg ? 32 : 16; u.keep = seg ? 0 : 1;
        u.aoff = (long)u.pm * 256 * D * 2 + (seg ? a2off : 0); u.boff = (long)u.pn * 256 * 3072 * 2 + (seg ? 1024 * 2 : 0); return true;
    }
};
struct EpiY {
    bf16_t* SGF; const bf16_t* SGA;
    __device__ __forceinline__ void mid(f32x4 (&acc)[2][2][4][2], const pg8::Unit& u, int wr, int wc, int fr, int fq) const {
        const size_t base = (size_t)(u.pm * 256 + wr * 64 + fr) * D + u.pn * 256 + wc * 64 + 8 * fq;
#pragma unroll
        for (int ai = 0; ai < 2; ++ai)
#pragma unroll
            for (int m = 0; m < 4; ++m)
#pragma unroll
                for (int bj = 0; bj < 2; ++bj) {
                    const size_t o = base + (size_t)(ai * 128 + m * 16) * D + bj * 32;
                    const u32x4 gf = *(const u32x4*)(SGF + o), ga = *(const u32x4*)(SGA + o);
                    f32x4& v0 = acc[ai][bj][m][0]; f32x4& v1 = acc[ai][bj][m][1];
                    v0[0] *= bflo(gf[0]) * __builtin_amdgcn_rcpf(bflo(ga[0])); v0[1] *= bfhi(gf[0]) * __builtin_amdgcn_rcpf(bfhi(ga[0]));
                    v0[2] *= bflo(gf[1]) * __builtin_amdgcn_rcpf(bflo(ga[1])); v0[3] *= bfhi(gf[1]) * __builtin_amdgcn_rcpf(bfhi(ga[1]));
                    v1[0] *= bflo(gf[2]) * __builtin_amdgcn_rcpf(bflo(ga[2])); v1[1] *= bfhi(gf[2]) * __builtin_amdgcn_rcpf(bfhi(ga[2]));
                    v1[2] *= bflo(gf[3]) * __builtin_amdgcn_rcpf(bflo(ga[3])); v1[3] *= bfhi(gf[3]) * __builtin_amdgcn_rcpf(bfhi(ga[3]));
                    if (bj == 1) asm volatile("" ::: "memory");
                }
    }
    __device__ __forceinline__ void operator()(f32x4 (&acc)[2][2][4][2], const pg8::Unit& u, int wr, int wc, int fr, int fq, LAS unsigned char*, int, int) const {
        if (u.x0 == 0) { mid(acc, u, wr, wc, fr, fq); return; }
        const size_t base = (size_t)(u.pm * 256 + wr * 64 + fr) * D + u.pn * 256 + wc * 64 + 8 * fq;
#pragma unroll
        for (int ai = 0; ai < 2; ++ai)
#pragma unroll
            for (int m = 0; m < 4; ++m)
#pragma unroll
                for (int bj = 0; bj < 2; ++bj) {
                    const size_t o = base + (size_t)(ai * 128 + m * 16) * D + bj * 32;
                    const u32x4 ga = *(const u32x4*)(SGA + o);
                    const f32x4 v0 = acc[ai][bj][m][0], v1 = acc[ai][bj][m][1];
                    u32x4 w; w[0] = pg8::cvt_pk_bf16(v0[0] * bflo(ga[0]), v0[1] * bfhi(ga[0])); w[1] = pg8::cvt_pk_bf16(v0[2] * bflo(ga[1]), v0[3] * bfhi(ga[1]));
                    w[2] = pg8::cvt_pk_bf16(v1[0] * bflo(ga[2]), v1[1] * bfhi(ga[2])); w[3] = pg8::cvt_pk_bf16(v1[2] * bflo(ga[3]), v1[3] * bfhi(ga[3]));
                    *(u32x4*)(SGF + o) = w;
                }
    }
};
struct EpiOut {
    const float* x; const float* mod; float* out;
    __device__ __forceinline__ void operator()(f32x4 (&acc)[2][2][4][2], const pg8::Unit& u, int wr, int wc, int fr, int fq, LAS unsigned char*, int, int) const {
        const int col = u.pn * 256 + wc * 64 + 8 * fq;
        const float* gate = mod + (size_t)(u.pm >> 3) * 3 * D + 2 * D + col;
        f32x4 gt[2][2];
#pragma unroll
        for (int bj = 0; bj < 2; ++bj) { gt[bj][0] = *(const f32x4*)(gate + bj * 32); gt[bj][1] = *(const f32x4*)(gate + bj * 32 + 4); }
#pragma unroll
        for (int ai = 0; ai < 2; ++ai)
#pragma unroll
            for (int m = 0; m < 4; ++m) {
                const size_t o = (size_t)(u.pm * 256 + ai * 128 + wr * 64 + m * 16 + fr) * D + col;
#pragma unroll
                for (int bj = 0; bj < 2; ++bj)
#pragma unroll
                    for (int n = 0; n < 2; ++n) { const f32x4 xv = *(const f32x4*)(x + o + bj * 32 + n * 4); *(f32x4*)(out + o + bj * 32 + n * 4) = xv + gt[bj][n] * acc[ai][bj][m][n]; }
            }
    }
};

namespace natt {
typedef short v4i16_t __attribute__((ext_vector_type(4)));
__device__ __forceinline__ v4i16_t vtr(const LAS unsigned char* p) { return __builtin_amdgcn_ds_read_tr16_b64_v4i16((LAS v4i16_t*)p); }
struct Tensors { const bf16_t* Q; bf16_t* O; const bf16_t* K; const bf16_t* V; const bf16_t* KC; const bf16_t* VC; const bf16_t* SZA; const float* rpb; const float* shift; };

__device__ __forceinline__ void pair(const LAS unsigned char* Kb, const LAS unsigned char* Vb, int keybase, const bf16x8 (&qf)[4], f32x4 (&o)[8], float& lsum,
                                     int fr, int fq, bool local, const int (&dcv)[2][4], const LAS float* Trow, float shift) {
    f32x4 sx = (f32x4){0.f, 0.f, 0.f, 0.f}, sy = (f32x4){0.f, 0.f, 0.f, 0.f};
    const int krow = keybase + fr;
#pragma unroll
    for (int ks = 0; ks < 4; ++ks) {
        const int pos = ((4 * ks + fq) ^ (krow & 15)) * 16;
        const bf16x8 kx = *(const LAS bf16x8*)(Kb + krow * 256 + pos), ky = *(const LAS bf16x8*)(Kb + (krow + 16) * 256 + pos);
        sx = __builtin_amdgcn_mfma_f32_16x16x32_bf16(kx, qf[ks], sx, 0, 0, 0);
        sy = __builtin_amdgcn_mfma_f32_16x16x32_bf16(ky, qf[ks], sy, 0, 0, 0);
    }
    float px[4], py[4];
#pragma unroll
    for (int j = 0; j < 4; ++j) {
        if (local) {
            const int ix = dcv[0][j], iy = dcv[1][j];
            const float bx = Trow[ix < 0 ? 0 : ix], by = Trow[iy < 0 ? 0 : iy];
            px[j] = ix < 0 ? 0.f : __builtin_amdgcn_exp2f(sx[j] + bx - shift);
            py[j] = iy < 0 ? 0.f : __builtin_amdgcn_exp2f(sy[j] + by - shift);
        } else { px[j] = __builtin_amdgcn_exp2f(sx[j] - shift); py[j] = __builtin_amdgcn_exp2f(sy[j] - shift); }
    }
    lsum += ((px[0] + px[1]) + (px[2] + px[3])) + ((py[0] + py[1]) + (py[2] + py[3]));
    u32x4 pw; pw[0] = pg8::cvt_pk_bf16(px[0], px[1]); pw[1] = pg8::cvt_pk_bf16(px[2], px[3]); pw[2] = pg8::cvt_pk_bf16(py[0], py[1]); pw[3] = pg8::cvt_pk_bf16(py[2], py[3]);
    const bf16x8 pb = __builtin_bit_cast(bf16x8, pw);
    const int vrow = keybase + 4 * fq + (fr >> 2), sw = (vrow & 7) << 1;
    const LAS unsigned char* vp = Vb + vrow * 256 + (fr & 1) * 8;
    const int ch = (fr & 3) >> 1;
#pragma unroll
    for (int db = 0; db < 8; ++db) {
        const int pos = ((2 * db + ch) ^ sw) * 16;
        const v4i16_t vx = vtr(vp + pos), vy = vtr(vp + 16 * 256 + pos);
        const bf16x8 vf = (bf16x8){vx[0], vx[1], vx[2], vx[3], vy[0], vy[1], vy[2], vy[3]};
        o[db] = __builtin_amdgcn_mfma_f32_16x16x32_bf16(vf, pb, o[db], 0, 0, 0);
    }
}

__device__ __forceinline__ void attn_phase(LAS unsigned char* lds, const Tensors& T, int vcu) {
    int tid = threadIdx.x; asm volatile("" : "+v"(tid));
    const int lane = tid & 63, wid = __builtin_amdgcn_readfirstlane(tid >> 6), fr = lane & 15, fq = lane >> 4;
    const int bh = vcu >> 1, b = bh >> 4, h = bh & 15;
    LAS float* Tb = (LAS float*)(lds + XCH_OFF);
    for (int i = tid; i < 465; i += NWAVES * 64) Tb[i] = T.rpb[h * 465 + i] * 1.4426950408889634f;
    const float shift = T.shift[0];
    const int s = wid & 3, wq = wid >> 2;
    const int cw = (s == 0) ? 0 : (s == 1) ? 8 : (s == 2) ? 24 : 32;
    const int c = 16 * s + fr, cst = min(max(c - 8, 0), 48);
    int dcv[2][4];
#pragma unroll
    for (int blk = 0; blk < 2; ++blk)
#pragma unroll
        for (int j = 0; j < 4; ++j) { const int kc = cw + 16 * blk + 4 * fq + j; dcv[blk][j] = (kc >= cst && kc < cst + 16) ? (kc - c + 15) : -1; }
    const bool isV = wid >= 4;
    const int drow = 16 * (wid & 3) + (lane >> 4), dp = lane & 15;
    for (int ui = 0; ui < 8; ++ui) {
        const int rp = (vcu & 1) * 8 + ui, r0 = 2 * rp, qrow = r0 + wq;
        const int rs0 = min(max(r0 - 4, 0), 24), rs1 = min(max(r0 - 3, 0), 24), rsq = wq ? rs1 : rs0;
        const int ntile = 4 + (rs1 + 8 - rs0);
        const size_t qtok = (size_t)b * S + qrow * 64 + 16 * s + fr;
        const bf16_t* qp = T.Q + qtok * D + h * HD; bf16_t* op = T.O + qtok * D + h * HD;
        bf16x8 qf[4];
#pragma unroll
        for (int ks = 0; ks < 4; ++ks) qf[ks] = *(const bf16x8*)(qp + 32 * ks + 8 * fq);
        f32x4 o[8];
#pragma unroll
        for (int db = 0; db < 8; ++db) o[db] = (f32x4){0.f, 0.f, 0.f, 0.f};
        float lsum = 0.f;
#define NATT_ISSUE(j) do { const int j_ = (j); const bf16_t* src_; \
            if (j_ < 4) src_ = (isV ? T.VC : T.KC) + ((size_t)b * L + 64 * j_) * D + h * HD; \
            else src_ = (isV ? T.V : T.K) + ((size_t)b * S + (rs0 + j_ - 4) * 64) * D + h * HD; \
            LAS unsigned char* dst_ = lds + (j_ & 1) * 32768 + (isV ? 16384 : 0) + (wid & 3) * 4096; \
            _Pragma("unroll") for (int e_ = 0; e_ < 4; ++e_) { const int row_ = drow + 4 * e_; const int c_ = isV ? (dp ^ ((row_ & 7) << 1)) : (dp ^ (row_ & 15)); \
                __builtin_amdgcn_global_load_lds((const unsigned*)(src_ + (size_t)row_ * D + c_ * 8), (LAS unsigned*)(dst_ + e_ * 1024), 16, 0, 0); } } while (0)
        NATT_ISSUE(0);
        for (int j = 0; j < ntile; ++j) {
            asm volatile("s_waitcnt vmcnt(0) lgkmcnt(0)" ::: "memory"); __builtin_amdgcn_s_barrier(); asm volatile("" ::: "memory");
            if (j + 1 < ntile) NATT_ISSUE(j + 1);
            const LAS unsigned char* Kb = lds + (j & 1) * 32768; const LAS unsigned char* Vb = Kb + 16384;
            if (j < 4) {
                pair(Kb, Vb, 0, qf, o, lsum, fr, fq, false, dcv, Tb, shift);
                pair(Kb, Vb, 32, qf, o, lsum, fr, fq, false, dcv, Tb, shift);
            } else {
                const int kr = rs0 + j - 4;
                if (kr >= rsq && kr < rsq + 8) pair(Kb, Vb, cw, qf, o, lsum, fr, fq, true, dcv, Tb + (kr - qrow + 7) * 31, shift);
            }
        }
#undef NATT_ISSUE
        asm volatile("s_waitcnt lgkmcnt(0)" ::: "memory"); __builtin_amdgcn_s_barrier(); asm volatile("" ::: "memory");
        lsum += __shfl_xor(lsum, 16); lsum += __shfl_xor(lsum, 32);
        const float inv = 1.0f / lsum;
        const bf16_t* zp = T.SZA + qtok * D + h * HD + 4 * fq;
#pragma unroll
        for (int db = 0; db < 8; ++db) {
            const u32x2 z = *(const u32x2*)(zp + 16 * db);
            u32x2 w; w[0] = pg8::cvt_pk_bf16(o[db][0] * inv * bflo(z[0]), o[db][1] * inv * bfhi(z[0])); w[1] = pg8::cvt_pk_bf16(o[db][2] * inv * bflo(z[1]), o[db][3] * inv * bfhi(z[1]));
            *(u32x2*)(op + 16 * db + 4 * fq) = w;
        }
    }
}
}

#ifndef REP_P0
#define REP_P0 1
#endif
#ifndef REP_P1
#define REP_P1 1
#endif
#ifndef REP_P2
#define REP_P2 1
#endif
#ifndef REP_P3C
#define REP_P3C 1
#endif
#ifndef REP_ATT
#define REP_ATT 1
#endif
#ifndef REP_P6
#define REP_P6 1
#endif

struct MArgs { const float* in[13]; float* out; unsigned char* ws; int ph_lo, ph_hi, li, pad; };
struct Frame {
    LAS unsigned char* lds; volatile LAS unsigned* MISC; unsigned* ctl; int tid, lane, wave, vcu, G;
};
__device__ __forceinline__ unsigned pk2(float lo, float hi) { return f2bf(lo) | (f2bf(hi) << 16); }

__device__ __forceinline__ void p0_transpose_item(const float* W, int N, bf16_t* WT, int ldo, int koff, int k0, int n0, int lane) {
    f32x4 v[16];
    const float* src = W + (size_t)k0 * N + n0 + 4 * lane;
#pragma unroll
    for (int kk = 0; kk < 16; ++kk) v[kk] = __builtin_nontemporal_load((const f32x4*)(src + (size_t)kk * N));
#pragma unroll
    for (int j = 0; j < 4; ++j) {
        u32x4 a, b;
        a[0] = pk2(v[0][j], v[1][j]); a[1] = pk2(v[2][j], v[3][j]); a[2] = pk2(v[4][j], v[5][j]); a[3] = pk2(v[6][j], v[7][j]);
        b[0] = pk2(v[8][j], v[9][j]); b[1] = pk2(v[10][j], v[11][j]); b[2] = pk2(v[12][j], v[13][j]); b[3] = pk2(v[14][j], v[15][j]);
        bf16_t* dst = WT + (size_t)(n0 + 4 * lane + j) * ldo + koff + k0;
        *(u32x4*)dst = a; *(u32x4*)(dst + 8) = b;
    }
}
__device__ __forceinline__ void p0_mod_item(const float* c, const float* cctx, const float* wmod, const float* bmod, float* mod, LAS unsigned char* lds, int item, int wave, int lane) {
    LAS float* scr = (LAS float*)(lds + wave * 16384);
    LAS f32x4* red = (LAS f32x4*)(lds + 131072 + 1024);
    const int j0 = item * 16, fq = lane >> 4, fr = lane & 15, k0 = wave * 256;
    const float* wp = wmod + (size_t)(k0 + fq) * (3 * D) + j0 + fr;
    float w[64];
#pragma unroll
    for (int i = 0; i < 64; ++i) w[i] = __builtin_nontemporal_load(wp + (size_t)(4 * i) * (3 * D));
#pragma unroll 4
    for (int i = 0; i < 64; ++i) { const int idx = i * 64 + lane, b = idx >> 8, kk = idx & 255; float v = 0.f; if (b < 9) { const float z = (b < 8) ? c[b * D + k0 + kk] : cctx[k0 + kk]; v = z / (1.0f + __expf(-z)); } scr[idx] = v; }
    LDS_WAIT(); asm volatile("" ::: "memory");
    f32x4 acc0 = (f32x4){0.f, 0.f, 0.f, 0.f}, acc1 = (f32x4){0.f, 0.f, 0.f, 0.f};
#pragma unroll
    for (int i = 0; i < 64; i += 2) {
        acc0 = __builtin_amdgcn_mfma_f32_16x16x4f32(scr[fr * 256 + 4 * i + fq], w[i], acc0, 0, 0, 0);
        acc1 = __builtin_amdgcn_mfma_f32_16x16x4f32(scr[fr * 256 + 4 * i + 4 + fq], w[i + 1], acc1, 0, 0, 0);
    }
    red[wave * 64 + lane] = acc0 + acc1;
    __syncthreads();
    if (wave == 0) {
        f32x4 t = red[lane];
#pragma unroll
        for (int ww = 1; ww < 8; ++ww) t += red[ww * 64 + lane];
#pragma unroll
        for (int r = 0; r < 4; ++r) { const int b = 4 * fq + r; if (b < 9) mod[b * 3 * D + j0 + fr] = t[r] + bmod[j0 + fr]; }
    }
    __syncthreads();
}
__device__ __forceinline__ void p0_table_item(float2* rope, bf16_t* CS, bf16_t* DFTA, const float* qg, const float* kg, const float* rpbp, float* shiftp, int item, int lane) {
    if (item == 0) {
        for (int i = 0; i < 32; ++i) { const int gid = i * 64 + lane, pos = gid >> 5, j = gid & 31;
            const float invf = exp2f(-(float)j * 0.41524101186092029f); const float ang = (float)pos * invf; float sn, cs; sincosf(ang, &sn, &cs);
            rope[gid] = make_float2(cs, sn); }
        float mq = fmaxf(fabsf(qg[lane]), fabsf(qg[lane + 64])), mk = fmaxf(fabsf(kg[lane]), fabsf(kg[lane + 64])), mb = 0.f;
        for (int i = lane; i < NH * 465; i += 64) mb = fmaxf(mb, rpbp[i]);
        mq = wave_max(mq); mk = wave_max(mk); mb = wave_max(mb);
        if (lane == 0) shiftp[0] = (11.313708498984761f * mq * mk + mb) * 1.4426950408889634f;
    } else if (item <= 32) {
        const int base = (item - 1) * 4096;
#pragma unroll
        for (int i = 0; i < 8; ++i) { const int e0 = base + (i * 64 + lane) * 8; unsigned w[4];
#pragma unroll
            for (int q = 0; q < 4; ++q) { float v[2];
#pragma unroll
                for (int z = 0; z < 2; ++z) { const int e = e0 + 2 * q + z, part = e >> 16, cp = (e >> 8) & 255, cc = e & 255, mm = (cp * cc) & 255;
                    const float rev = (float)mm * (1.0f / 256.0f); v[z] = (part == 0 ? __builtin_amdgcn_cosf(rev) : __builtin_amdgcn_sinf(rev)) * 0.0625f; }
                w[q] = pk2(v[0], v[1]); }
            *(u32x4*)(CS + e0) = (u32x4){w[0], w[1], w[2], w[3]}; }
    } else {
        const int k1 = item - 33;
#pragma unroll
        for (int i = 0; i < 8; ++i) { const int kk0 = (i * 64 + lane) * 8; unsigned w[4];
#pragma unroll
            for (int q = 0; q < 4; ++q) { float v[2];
#pragma unroll
                for (int z = 0; z < 2; ++z) { const int kk = kk0 + 2 * q + z, part = kk >> 11, n = kk & 2047, mm = (k1 * n) & 2047;
                    const float rev = (float)mm * (1.0f / 2048.0f); v[z] = (part == 0 ? __builtin_amdgcn_cosf(rev) : -__builtin_amdgcn_sinf(rev)) * 0.022097086912079608f; }
                w[q] = pk2(v[0], v[1]); }
            *(u32x4*)(DFTA + (size_t)k1 * 4096 + kk0) = (u32x4){w[0], w[1], w[2], w[3]}; }
    }
}
__device__ __forceinline__ void p1_hnorm_row(const float* src, const float* shift, const float* scale, bf16_t* dst, int lane) {
    f32x4 v[8]; float ss = 0.f;
#pragma unroll
    for (int j = 0; j < 8; ++j) { v[j] = *(const f32x4*)(src + (j * 64 + lane) * 4); ss += (v[j][0] * v[j][0] + v[j][1] * v[j][1]) + (v[j][2] * v[j][2] + v[j][3] * v[j][3]); }
    ss = wave_sum(ss);
    const float rstd = 1.0f / sqrtf(ss * (1.0f / D) + 1e-6f);
#pragma unroll
    for (int j = 0; j < 8; ++j) {
        const int k = (j * 64 + lane) * 4;
        const f32x4 sc = *(const f32x4*)(scale + k), sh = *(const f32x4*)(shift + k);
        u32x2 o;
        o[0] = pk2(v[j][0] * rstd * (1.f + sc[0]) + sh[0], v[j][1] * rstd * (1.f + sc[1]) + sh[1]);
        o[1] = pk2(v[j][2] * rstd * (1.f + sc[2]) + sh[2], v[j][3] * rstd * (1.f + sc[3]) + sh[3]);
        *(u32x2*)(dst + k) = o;
    }
}

__global__ void __launch_bounds__(NWAVES * 64, 2) mega_fwd(MArgs args) {
    extern __shared__ __attribute__((aligned(16))) unsigned char lds_raw[];
    Frame F;
    F.lds = (LAS unsigned char*)lds_raw;
    F.MISC = (volatile LAS unsigned*)(F.lds + MISC_OFF);
    F.tid = threadIdx.x; F.lane = F.tid & 63; F.wave = __builtin_amdgcn_readfirstlane(F.tid >> 6);
    F.G = gridDim.x; { const int bx = blockIdx.x; F.vcu = (F.G % 8 == 0) ? (bx % 8) * (F.G / 8) + bx / 8 : bx; }
    unsigned char* ws = args.ws; unsigned char* dob = (unsigned char*)args.out;
    F.ctl = (unsigned*)(ws + WS_CTL);
    const float* x = args.in[0]; const float* c = args.in[1]; const float* ctx = args.in[2]; const float* cctx = args.in[3];
    const float* wmod = args.in[4]; const float* bmod = args.in[5]; const float* win = args.in[6];
    const float* qg = args.in[7]; const float* kg = args.in[8]; const float* rpb = args.in[9];
    float* shiftp = (float*)(ws + WS_ROPE + 65536);
    const float* wf = args.in[10]; const float* wa = args.in[11]; const float* wo = args.in[12];
    bf16_t* Wfa_t = (bf16_t*)(ws + WS_WFA); bf16_t* Wo_t = (bf16_t*)(ws + WS_WO); bf16_t* DFTA = (bf16_t*)(ws + WS_DFTA); bf16_t* CS = (bf16_t*)(ws + WS_CS);
    float* mod = (float*)(ws + WS_MOD); float2* rope = (float2*)(ws + WS_ROPE);
    bf16_t* H = (bf16_t*)(dob + DO_H); bf16_t* Win_t = (bf16_t*)(dob + DO_WIN);
    for (int u = F.tid; u < (LDS_BYTES - LDSCTL_OFF) / 4; u += NWAVES * 64) ((LAS unsigned*)(F.lds + LDSCTL_OFF))[u] = 0u;
    __syncthreads();
    XcdBarrier bar = xcd_barrier_post(F.ctl + CW_BAR + args.li * XCD_BAR_WORDS, F.MISC + 8);
    const int lo = args.ph_lo, hi = args.ph_hi;
#define IN(k) (lo <= (k) && (k) < hi)
#define BOTH(k) (IN(k) && IN((k) + 1))

    for (int rep = 0; rep < REP_P0; ++rep) if (IN(0)) {
        for (int it = F.vcu; it < 384; it += F.G) p0_mod_item(c, cctx, wmod, bmod, mod, F.lds, it, F.wave, F.lane);
        for (int it = F.wave * F.G + F.vcu; it < 33 + 2048; it += F.G * NWAVES) p0_table_item(rope, CS, DFTA, qg, kg, rpb, shiftp, it, F.lane);
        {   constexpr int I_WIN = 16 * 56, I_WO = 16 * 8, I_WA = 16 * 8, I_WF = 8 * 8;
            for (int wi = F.vcu; wi < I_WIN + I_WO + I_WA + I_WF; wi += F.G) {
                int r = wi;
                if (r < I_WIN) { const int kb = r & 15, nb = r >> 4; p0_transpose_item(win, INW, Win_t, D, 0, kb * 128 + F.wave * 16, nb * 256, F.lane); continue; } r -= I_WIN;
                if (r < I_WO) { const int kb = r & 15, nb = r >> 4; p0_transpose_item(wo, D, Wo_t, D, 0, kb * 128 + F.wave * 16, nb * 256, F.lane); continue; } r -= I_WO;
                if (r < I_WA) { const int kb = r & 15, nb = r >> 4; p0_transpose_item(wa, D, Wfa_t, 3072, 1024, kb * 128 + F.wave * 16, nb * 256, F.lane); continue; } r -= I_WA;
                { const int kb = r & 7, nb = r >> 3; p0_transpose_item(wf, D, Wfa_t, 3072, 0, kb * 128 + F.wave * 16, nb * 256, F.lane); }
            } }
        if (BOTH(0)) xcd_barrier(bar);
    }
    for (int rep = 0; rep < REP_P1; ++rep) if (IN(1)) {
        const int gw = F.vcu * NWAVES + F.wave, NGW = F.G * NWAVES;
        for (int row = gw; row < NB * S + NB * L; row += NGW) {
            const float* src; int mb;
            if (row < NB * S) { src = x + (size_t)row * D; mb = row / S; } else { src = ctx + (size_t)(row - NB * S) * D; mb = 8; }
            p1_hnorm_row(src, mod + (size_t)mb * 3 * D, mod + (size_t)mb * 3 * D + D, H + (size_t)row * D, F.lane);
        }
        if (BOTH(1)) xcd_barrier(bar);
    }
    for (int rep = 0; rep < REP_P2; ++rep) if (IN(2)) {
        pg8::Gemm g{H, Win_t, D, D};
        SchedInproj Sc{F.G, (int)blockIdx.x};
        EpiInproj E{ws, qg, kg, rope};
        pg8::gemm_phase<EpiInproj, SchedInproj>(F.lds, g, Sc, E);
        if (BOTH(2)) xcd_barrier(bar);
    }
    if (IN(3)) {
        pg8::Gemm g{CS, (const bf16_t*)(ws + WS_UZ), 256, D};
        SchedChan Sc{F.G, (int)blockIdx.x};
        EpiChan E{(bf16_t*)(dob + DO_PQT)};
        for (int rep = 0; rep < REP_P3C; ++rep) pg8::gemm_phase<EpiChan, SchedChan>(F.lds, g, Sc, E);
        natt::Tensors AT{(const bf16_t*)(ws + WS_Q), (bf16_t*)(ws + WS_Q), (const bf16_t*)(ws + WS_K), (const bf16_t*)(ws + WS_V), (const bf16_t*)(ws + WS_KC), (const bf16_t*)(ws + WS_VC), (const bf16_t*)(ws + WS_SZA), rpb, shiftp};
        for (int rep = 1; rep < REP_ATT; ++rep) { natt::Tensors AD = AT; AD.O = (bf16_t*)(dob + 64 * MiB); natt::attn_phase(F.lds, AD, F.vcu); }
        natt::attn_phase(F.lds, AT, F.vcu);
        if (BOTH(3)) xcd_barrier(bar);
    }
    if (IN(4)) {
        pg8::Gemm g{DFTA, (const bf16_t*)(dob + DO_PQT), 4096, 4096};
        SchedPos Sc{F.G, F.vcu};
        EpiPos E{(bf16_t*)(ws + WS_UZ)};
        pg8::gemm_phase<EpiPos, SchedPos>(F.lds, g, Sc, E);
        if (BOTH(4)) xcd_barrier(bar);
    }
    if (IN(5)) {
        pg8::Gemm g{(const bf16_t*)(ws + WS_UZ) + OFF_ZF, Wfa_t, D, 3072};
        SchedY Sc{F.G, (int)blockIdx.x, (long)(WS_Q - WS_UZ) - (long)OFF_ZF * 2};
        EpiY E{(bf16_t*)(ws + WS_SGF), (const bf16_t*)(ws + WS_SGA)};
        pg8::gemm_phase<EpiY, SchedY>(F.lds, g, Sc, E);
        if (BOTH(5)) xcd_barrier(bar);
    }
    for (int rep = 0; rep < REP_P6; ++rep) if (IN(6)) {
        pg8::Gemm g{(const bf16_t*)(ws + WS_SGF), Wo_t, D, D};
        SchedRows Sc{F.G, (int)blockIdx.x};
        EpiOut E{x, mod, args.out};
        pg8::gemm_phase<EpiOut, SchedRows>(F.lds, g, Sc, E);
    }
#undef IN
#undef BOTH
}

extern "C" void kernel_launch(void* const* d_in, const int* in_sizes, int n_in, void* d_out, int out_size, void* d_ws, size_t ws_size, hipStream_t stream) {
    unsigned char* ws = (unsigned char*)d_ws;
    if (ws_size < WS_END || n_in != 13) return;
    static int grid = 0;
    if (grid == 0) {
        int dev = 0, cus = 0, per_cu = 0;
        if (hipGetDevice(&dev) != hipSuccess || hipDeviceGetAttribute(&cus, hipDeviceAttributeMultiprocessorCount, dev) != hipSuccess) { grid = -1; return; }
        if (hipFuncSetAttribute((const void*)mega_fwd, hipFuncAttributeMaxDynamicSharedMemorySize, LDS_BYTES) != hipSuccess) { grid = -1; return; }
        if (hipOccupancyMaxActiveBlocksPerMultiprocessor(&per_cu, (const void*)mega_fwd, NWAVES * 64, LDS_BYTES) != hipSuccess || per_cu < 1) { fprintf(stderr, "occupancy query: %d\n", per_cu); grid = -1; return; }
        (void)hipGetLastError();
        grid = cus;
    }
    if (grid != 256) return;
    (void)hipMemsetAsync(ws + WS_CTL, 0, 1 * MiB, stream);
    MArgs a; memset(&a, 0, sizeof(a));
    for (int i = 0; i < 13; ++i) a.in[i] = (const float*)d_in[i];
    a.out = (float*)d_out; a.ws = ws; a.ph_lo = 0; a.ph_hi = 7; a.li = 0;
    hipLaunchKernelGGL(mega_fwd, dim3(grid), dim3(NWAVES * 64), LDS_BYTES, stream, a);
}
```

```cpp
#include <hip/hip_runtime.h>
#include <stdint.h>
#include <string.h>

typedef unsigned short bf16_t;
typedef short bf16x8 __attribute__((ext_vector_type(8)));
typedef float f32x4 __attribute__((ext_vector_type(4)));
typedef unsigned u32x4 __attribute__((ext_vector_type(4)));
typedef unsigned u32x2 __attribute__((ext_vector_type(2)));

constexpr int D = 2048, NB = 8, S = 2048, L = 256, NH = 16, HD = 128, FW = 1024, INW = 14336;
constexpr int OFF_ZF = 1024, OFF_Q = 2048, OFF_K = 4096, OFF_V = 6144, OFF_ZA = 8192, OFF_GF = 10240, OFF_GA = 12288;
constexpr size_t MiB = 1u << 20;
constexpr float QSCALE = 0.08838834764831845f * 1.4426950408889634f;
constexpr size_t WS_ZFC = 0, WS_PQT = 32 * MiB, WS_Q = 64 * MiB, WS_HEO = 64 * MiB, WS_K = 128 * MiB, WS_V = 192 * MiB, WS_SZA = 256 * MiB, WS_SGF = 320 * MiB, WS_SGA = 384 * MiB,
                 WS_KC = 448 * MiB, WS_VC = 456 * MiB, WS_WFA = 464 * MiB, WS_WO = 476 * MiB, WS_DFTA = 484 * MiB, WS_WPQ = 492 * MiB,
                 WS_CTL = 500 * MiB, WS_MOD = 501 * MiB, WS_ROPE = 502 * MiB, WS_CS = 503 * MiB, WS_PN = 504 * MiB, WS_END = 512 * MiB;
constexpr size_t DO_H = 0, DO_HC = 64 * MiB, DO_WIN = 72 * MiB, DO_WUF = 72 * MiB, DO_MF = 0;

__device__ __forceinline__ unsigned f2bf(float f) { unsigned u = __float_as_uint(f); return (u + 0x7fffu + ((u >> 16) & 1u)) >> 16; }
__device__ __forceinline__ float bf2f(unsigned h) { return __uint_as_float(h << 16); }
__device__ __forceinline__ float silu_f(float z) { return z / (1.0f + expf(-z)); }
__device__ __forceinline__ float sigm_f(float z) { return 1.0f / (1.0f + expf(-z)); }
__device__ __forceinline__ float wave_sum(float v) {
#pragma unroll
    for (int o = 1; o < 64; o <<= 1) v += __shfl_xor(v, o);
    return v;
}
__device__ __forceinline__ float wave_max(float v) {
#pragma unroll
    for (int o = 1; o < 64; o <<= 1) v = fmaxf(v, __shfl_xor(v, o));
    return v;
}

#define LAS __attribute__((address_space(3)))
#define GAS __attribute__((address_space(1)))
typedef GAS unsigned gu32;
#define RLX_AGENT __ATOMIC_RELAXED, __HIP_MEMORY_SCOPE_AGENT
#define LDS_WAIT() asm volatile("s_waitcnt lgkmcnt(0)" ::: "memory")
#define VM_WAIT() asm volatile("s_waitcnt vmcnt(0)" ::: "memory")
constexpr int NWAVES = 8;
constexpr int RING_BYTES = 131072, LDSCTL_OFF = RING_BYTES, MISC_OFF = LDSCTL_OFF + 320, XCH_OFF = LDSCTL_OFF + 1024, STG_OFF = XCH_OFF + 4096, LDS_BYTES = 163840;
constexpr int CW_BAR = 4096;

#define XB_TMO      128
#define XB_XCNT(j)  (256  + 64 * (j))
#define XB_XSUB(j)  (1280 + 64 * (j))
#define XB_XGEN(j)  (2304 + 64 * (j))
#define XB_TOP      3328
#define XB_TOPGEN   3392
#define XCD_BAR_WORDS 3456
#define XB_SPIN_CAP (1u << 18)
__device__ __forceinline__ unsigned xb_ld(unsigned* p)              { return __hip_atomic_load(p, __ATOMIC_RELAXED, __HIP_MEMORY_SCOPE_AGENT); }
__device__ __forceinline__ unsigned xb_add(unsigned* p, unsigned v) { return __hip_atomic_fetch_add(p, v, __ATOMIC_RELAXED, __HIP_MEMORY_SCOPE_AGENT); }
__device__ __forceinline__ unsigned xb_xcc_id() { return (unsigned)__builtin_amdgcn_s_getreg((3 << 11) | 20) & 0xFu; }
#define XB_SPIN(cond, bar) do { unsigned _sp = 0; while (cond) { __builtin_amdgcn_s_sleep(1); \
    if ((++_sp & 255u) == 0u) { if (xb_ld(&(bar)[XB_TMO])) break; if (_sp > XB_SPIN_CAP) { atomicAdd(&(bar)[XB_TMO], 1u); break; } } } } while (0)
struct XcdBarrier { unsigned* bar; unsigned x; volatile LAS unsigned* st; };
__device__ __forceinline__ XcdBarrier xcd_barrier_post(unsigned* bar, volatile LAS unsigned* st) {
    XcdBarrier b; b.bar = bar; b.x = xb_xcc_id(); b.st = st;
    if (threadIdx.x == 0) (void)xb_add(&bar[XB_XCNT(b.x)], 1u);
    return b;
}
__device__ __forceinline__ void xcd_barrier_complete(unsigned* bar, unsigned x, unsigned& nloc, unsigned& nx) {
    const unsigned G = gridDim.x * gridDim.y * gridDim.z;
    unsigned sum, cnt, mine, sp = 0u;
    for (;;) {
        sum = 0u; cnt = 0u; mine = 0u;
#pragma unroll
        for (unsigned j = 0; j < 16; ++j) { const unsigned c = xb_ld(&bar[XB_XCNT(j)]); sum += c; cnt += (c > 0u) ? 1u : 0u; mine = (j == x) ? c : mine; }
        if (sum == G) break;
        __builtin_amdgcn_s_sleep(1);
        if ((++sp & 255u) == 0u) { if (xb_ld(&bar[XB_TMO])) break; if (sp > XB_SPIN_CAP) { atomicAdd(&bar[XB_TMO], 1u); break; } }
    }
    nloc = mine > 0u ? mine : 1u; nx = cnt > 0u ? cnt : 1u;
}
__device__ __forceinline__ void xcd_barrier(const XcdBarrier& b) {
    asm volatile("s_waitcnt vmcnt(0)" ::: "memory");
    __syncthreads();
    if (threadIdx.x == 0) {
        unsigned* bar = b.bar;
        __builtin_amdgcn_s_waitcnt(0);
        unsigned nloc = b.st[0], nx = b.st[1];
        if (nloc == 0u) { xcd_barrier_complete(bar, b.x, nloc, nx); b.st[0] = nloc; b.st[1] = nx; }
        const unsigned old = xb_add(&bar[XB_XSUB(b.x)], 1u);
        const unsigned gen = old / nloc;
        if (old + 1u == (gen + 1u) * nloc) {
            __builtin_amdgcn_fence(__ATOMIC_RELEASE, "agent");
            asm volatile("s_waitcnt vmcnt(0)" ::: "memory");
            const unsigned og = xb_add(&bar[XB_TOP], 1u);
            const unsigned tg = og / nx;
            if (og + 1u == (tg + 1u) * nx) xb_add(&bar[XB_TOPGEN], 1u);
            else XB_SPIN(xb_ld(&bar[XB_TOPGEN]) == tg, bar);
            __builtin_amdgcn_fence(__ATOMIC_ACQUIRE, "agent");
            xb_add(&bar[XB_XGEN(b.x)], 1u);
            asm volatile("s_waitcnt vmcnt(0)" ::: "memory");
        } else {
            XB_SPIN(xb_ld(&bar[XB_XGEN(b.x)]) == gen, bar);
            __builtin_amdgcn_fence(__ATOMIC_ACQUIRE, "agent");
            asm volatile("s_waitcnt vmcnt(0)" ::: "memory");
        }
    }
    __syncthreads();
}

namespace pg8 {
constexpr int BM = 256, BK = 64, HALF = 128, HTB = HALF * BK * 2, STAGE_BYTES = 8 * HTB;
__host__ __device__ __forceinline__ int lds_byte(int r, int c) { const int st = (r >> 4) * 2 + (c >> 5), rr = r & 15, cc = c & 31, ob = rr * 64 + cc * 2; return st * 1024 + (ob ^ (((ob >> 9) & 1) << 5)); }
__host__ __device__ __forceinline__ void stage_rc(int b, int& R, int& C) { const int st = b / 1024, sb = b % 1024, swz = sb ^ (((sb >> 9) & 1) << 5); R = (st >> 1) * 16 + swz / 64; C = (st & 1) * 32 + (swz % 64) / 2; }
__host__ __device__ __forceinline__ int perm32(int rho) { const int n = rho >> 4, i = rho & 15; return 8 * (i >> 2) + 4 * n + (i & 3); }
struct Unit { int pm, pn, x0, x1, nt, keep; long aoff, boff; };
struct Gemm { const bf16_t* A; const bf16_t* Bt; int lda, ldb; };
__device__ __forceinline__ unsigned cvt_pk_bf16(float lo, float hi) { unsigned r; asm volatile("v_cvt_pk_bf16_f32 %0, %1, %2" : "=v"(r) : "v"(lo), "v"(hi)); return r; }

template <class Epi, class Sched>
__device__ __forceinline__ void gemm_phase(LAS unsigned char* lds, const Gemm g, const Sched& S, const Epi& E) {
    int tid = threadIdx.x; asm volatile("" : "+v"(tid));
    const int wid = __builtin_amdgcn_readfirstlane(tid >> 6), lane = tid & 63, wr = wid >> 2, wc = wid & 3, fr = lane & 15, fq = lane >> 4;
    unsigned voffA[2], voffB[2];
#pragma unroll
    for (int i = 0; i < 2; ++i) { int R, C; stage_rc(tid * 16 + i * 8192, R, C); const int Rb = 64 * (R >> 5) + perm32(R & 31);
        voffA[i] = (unsigned)(R * g.lda + C) * 2u; voffB[i] = (unsigned)(Rb * g.ldb + C) * 2u; }
    const size_t kstep = (size_t)(BK * 2);
    const size_t hstepA = (size_t)HALF * g.lda * 2, hstepB = (size_t)32 * g.ldb * 2;
    const unsigned ldsw = (unsigned)wid * 1024u;
    const int aoff = lds_byte(wr * 64 + fr, fq * 8), boff = lds_byte(wc * 32 + fr, fq * 8);
#define PG8_SA(b, h) (((b) * 2 + (h)) * HTB)
#define PG8_SB(b, h) ((4 + (b) * 2 + (h)) * HTB)
#define PG8_STAGE(bufoff, gbase, voff) do { _Pragma("unroll") for (int _i = 0; _i < 2; ++_i) \
        __builtin_amdgcn_global_load_lds((const unsigned*)((const char*)(gbase) + (voff)[_i]), (LAS unsigned*)(lds + (bufoff) + ldsw + _i * 8192), 16, 0, 0); } while (0)
#define PG8_LDA(dst, b, h) do { _Pragma("unroll") for (int m = 0; m < 4; ++m) _Pragma("unroll") for (int k = 0; k < 2; ++k) dst[m][k] = *(const LAS bf16x8*)(lds + PG8_SA(b, h) + aoff + m * 2048 + k * 1024); } while (0)
#define PG8_LDB(dst, b, h) do { _Pragma("unroll") for (int n = 0; n < 2; ++n) _Pragma("unroll") for (int k = 0; k < 2; ++k) dst[n][k] = *(const LAS bf16x8*)(lds + PG8_SB(b, h) + boff + n * 2048 + k * 1024); } while (0)
#define PG8_MMA(ai, bj, At, Bt) do { __builtin_amdgcn_s_setprio(1); _Pragma("unroll") for (int m = 0; m < 4; ++m) _Pragma("unroll") for (int n = 0; n < 2; ++n) _Pragma("unroll") for (int k = 0; k < 2; ++k) \
        acc[ai][bj][m][n] = __builtin_amdgcn_mfma_f32_16x16x32_bf16(Bt[n][k], At[m][k], acc[ai][bj][m][n], 0, 0, 0); __builtin_amdgcn_s_setprio(0); } while (0)
#define PG8_WAIT_V(n) asm volatile("s_waitcnt vmcnt(" #n ")" ::: "memory")
#define PG8_WAIT_L(n) asm volatile("s_waitcnt lgkmcnt(" #n ")" ::: "memory")
#define PG8_BAR __builtin_amdgcn_s_barrier()
#define PG8_SCHED __builtin_amdgcn_sched_barrier(0)
    Unit cur, nxt; int ui = 0;
    if (!S.next(0, cur)) return;
    f32x4 acc[2][2][4][2];
#pragma unroll
    for (int a = 0; a < 2; ++a)
#pragma unroll
        for (int b = 0; b < 2; ++b)
#pragma unroll
            for (int m = 0; m < 4; ++m)
#pragma unroll
                for (int n = 0; n < 2; ++n) acc[a][b][m][n] = (f32x4){0.f, 0.f, 0.f, 0.f};
    bf16x8 At[4][2], B0[2][2], B1[2][2];
    const char* cA = (const char*)g.A + cur.aoff; const char* cB = (const char*)g.Bt + cur.boff;
    PG8_STAGE(PG8_SB(0, 0), cB, voffB); PG8_STAGE(PG8_SB(0, 1), cB + hstepB, voffB); PG8_STAGE(PG8_SA(0, 0), cA, voffA); PG8_STAGE(PG8_SA(0, 1), cA + hstepA, voffA);
    if (wr == 1) PG8_BAR;
    PG8_WAIT_V(2); PG8_BAR;
    PG8_STAGE(PG8_SB(1, 0), cB + kstep, voffB); PG8_STAGE(PG8_SA(1, 0), cA + kstep, voffA); PG8_STAGE(PG8_SB(1, 1), cB + hstepB + kstep, voffB);
    PG8_WAIT_V(6); PG8_BAR;
    for (;;) {
        const bool has_next = S.next(ui + 1, nxt);
        const char* nA = has_next ? (const char*)g.A + nxt.aoff : cA; const char* nB = has_next ? (const char*)g.Bt + nxt.boff : cB;
        int nt = cur.nt; asm volatile("" : "+s"(nt));
        for (int t = 0; t < nt; t += 2) {
            const bool last = (t == nt - 2);
            const char* a1 = cA + (size_t)(t + 1) * kstep;
            const char* a2 = last ? nA : cA + (size_t)(t + 2) * kstep; const char* b2 = last ? nB : cB + (size_t)(t + 2) * kstep;
            const char* a3 = a2 + kstep; const char* b3 = b2 + kstep;
            PG8_LDB(B0, 0, 0); PG8_LDB(B1, 0, 1); PG8_SCHED; PG8_LDA(At, 0, 0); PG8_STAGE(PG8_SA(1, 1), a1 + hstepA, voffA);
            PG8_WAIT_V(8); PG8_WAIT_L(0); PG8_BAR; PG8_MMA(0, 0, At, B0); PG8_MMA(0, 1, At, B1); PG8_BAR; PG8_SCHED;
            PG8_LDA(At, 0, 1); PG8_STAGE(PG8_SB(0, 0), b2, voffB); PG8_STAGE(PG8_SB(0, 1), b2 + hstepB, voffB); PG8_STAGE(PG8_SA(0, 0), a2, voffA);
            PG8_WAIT_V(8); PG8_WAIT_L(0); PG8_BAR; PG8_MMA(1, 0, At, B0); PG8_MMA(1, 1, At, B1); PG8_BAR; PG8_SCHED;
            PG8_LDB(B0, 1, 0); PG8_LDB(B1, 1, 1); PG8_SCHED; PG8_LDA(At, 1, 0); PG8_STAGE(PG8_SA(0, 1), a2 + hstepA, voffA);
            PG8_WAIT_V(8); PG8_WAIT_L(0); PG8_BAR; PG8_MMA(0, 0, At, B0); PG8_MMA(0, 1, At, B1); PG8_BAR; PG8_SCHED;
            PG8_LDA(At, 1, 1); PG8_STAGE(PG8_SB(1, 0), b3, voffB); PG8_STAGE(PG8_SB(1, 1), b3 + hstepB, voffB); PG8_STAGE(PG8_SA(1, 0), a3, voffA);
            PG8_WAIT_V(8); PG8_WAIT_L(0); PG8_BAR; PG8_MMA(1, 0, At, B0); PG8_MMA(1, 1, At, B1); PG8_BAR; PG8_SCHED;
        }
        if (wr == 0) PG8_BAR;
        E(acc, cur, wr, wc, fr, fq, lds, wid, lane);
        if (!has_next) break;
        if (!cur.keep) {
#pragma unroll
        for (int a = 0; a < 2; ++a)
#pragma unroll
            for (int b = 0; b < 2; ++b)
#pragma unroll
                for (int m = 0; m < 4; ++m)
#pragma unroll
                    for (int n = 0; n < 2; ++n) acc[a][b][m][n] = (f32x4){0.f, 0.f, 0.f, 0.f};
        }
        cur = nxt; cA = nA; cB = nB; ++ui;
        if (wr == 1) PG8_BAR;
    }
    PG8_WAIT_V(0);
    PG8_BAR;
#undef PG8_SA
#undef PG8_SB
#undef PG8_STAGE
#undef PG8_LDA
#undef PG8_LDB
#undef PG8_MMA
#undef PG8_WAIT_V
#undef PG8_WAIT_L
#undef PG8_BAR
#undef PG8_SCHED
}
}

__device__ __forceinline__ float fast_sigm(float z) { return __builtin_amdgcn_rcpf(1.0f + __builtin_amdgcn_exp2f(-1.4426950408889634f * z)); }
__device__ __forceinline__ float fast_silu(float z) { return z * fast_sigm(z); }


template <bool F32 = false>
__device__ __forceinline__ void store_rows(LAS unsigned char* scr, unsigned char* g0  , size_t row_bytes, int lane, u32x4 p0, u32x4 p1) {
    const int fr = lane & 15, fq = lane >> 4;
    *(LAS u32x4*)(scr + fr * 144 + (F32 ? 32 * fq : 16 * fq)) = p0; *(LAS u32x4*)(scr + fr * 144 + (F32 ? 32 * fq + 16 : 64 + 16 * fq)) = p1;
    const int ro = lane >> 3, pi = lane & 7;
    const u32x4 a = *(const LAS u32x4*)(scr + ro * 144 + pi * 16), b = *(const LAS u32x4*)(scr + (8 + ro) * 144 + pi * 16);
    *(u32x4*)(g0 + (size_t)ro * row_bytes + pi * 16) = a; *(u32x4*)(g0 + (size_t)(8 + ro) * row_bytes + pi * 16) = b;
}
struct RowLd { u32x4 a, b; };
__device__ __forceinline__ RowLd rows_issue(const unsigned char* g0, size_t row_bytes, int lane) {
    const int ro = lane >> 3, pi = lane & 7; RowLd r;
    r.a = *(const u32x4*)(g0 + (size_t)ro * row_bytes + pi * 16); r.b = *(const u32x4*)(g0 + (size_t)(8 + ro) * row_bytes + pi * 16); return r;
}
template <bool F32 = false>
__device__ __forceinline__ void rows_spread(LAS unsigned char* scr, int lane, const RowLd& r, u32x4& p0, u32x4& p1) {
    const int fr = lane & 15, fq = lane >> 4, ro = lane >> 3, pi = lane & 7;
    *(LAS u32x4*)(scr + ro * 144 + pi * 16) = r.a; *(LAS u32x4*)(scr + (8 + ro) * 144 + pi * 16) = r.b;
    p0 = *(const LAS u32x4*)(scr + fr * 144 + (F32 ? 32 * fq : 16 * fq)); p1 = *(const LAS u32x4*)(scr + fr * 144 + (F32 ? 32 * fq + 16 : 64 + 16 * fq));
}
struct SchedInproj {
    int G, c;
    __device__ __forceinline__ bool next(int i, pg8::Unit& u) const {
        const long L = (long)i * G + c; if (L >= 3456) return false;
        if (L < 3328) { const int xcd = (int)(L & 7), off = (int)(L >> 3); u.pm = 8 * xcd + (off & 7); u.pn = 4 + (off >> 3); }
        else { const int q = (int)L - 3328; u.pm = 64 + (q & 7); u.pn = 16 + (q >> 3); }
        u.x0 = 0; u.x1 = 0; u.nt = D / 64; u.keep = 0; u.aoff = (long)u.pm * 256 * D * 2; u.boff = (long)u.pn * 256 * D * 2; return true;
    }
};
struct EpiInproj {
    unsigned char* ws; const float* qg; const float* kg; const float2* rope;
    __device__ __forceinline__ void operator()(f32x4 (&acc)[2][2][4][2], const pg8::Unit& u, int wr, int wc, int fr, int fq, LAS unsigned char* lds, int wid, int lane) const {
        const bool isctx = u.pm >= 64;
        const int blk = u.pn >> 3;
        const int act = (blk == 0) ? 1 : (blk == 1 || blk == 2) ? 3 : (blk == 3) ? 0 : (blk == 4) ? 1 : 2;
        bf16_t* dst; int row0; int ldd = D;
        if (!isctx) { dst = (bf16_t*)(ws + (size_t)blk * 64 * MiB); row0 = u.pm * 256; if (blk == 0) { dst = (bf16_t*)(ws + WS_ZFC); ldd = FW; } }
        else { dst = (bf16_t*)(ws + (blk == 2 ? WS_KC : WS_VC)); row0 = (u.pm - 64) * 256; }
        const int colw = (blk == 0 ? (u.pn - 4) : (u.pn & 7)) * 256 + wc * 64;
        if (act != 3) {
#pragma unroll
            for (int ai = 0; ai < 2; ++ai)
#pragma unroll
                for (int m = 0; m < 4; ++m) {
                    u32x4 w[2];
#pragma unroll
                    for (int bj = 0; bj < 2; ++bj) {
                        f32x4 v0 = acc[ai][bj][m][0], v1 = acc[ai][bj][m][1];
                        if (act == 1) { v0[0] = fast_silu(v0[0]); v0[1] = fast_silu(v0[1]); v0[2] = fast_silu(v0[2]); v0[3] = fast_silu(v0[3]); v1[0] = fast_silu(v1[0]); v1[1] = fast_silu(v1[1]); v1[2] = fast_silu(v1[2]); v1[3] = fast_silu(v1[3]); }
                        else if (act == 2) { v0[0] = fast_sigm(v0[0]); v0[1] = fast_sigm(v0[1]); v0[2] = fast_sigm(v0[2]); v0[3] = fast_sigm(v0[3]); v1[0] = fast_sigm(v1[0]); v1[1] = fast_sigm(v1[1]); v1[2] = fast_sigm(v1[2]); v1[3] = fast_sigm(v1[3]); }
                        w[bj][0] = pg8::cvt_pk_bf16(v0[0], v0[1]); w[bj][1] = pg8::cvt_pk_bf16(v0[2], v0[3]); w[bj][2] = pg8::cvt_pk_bf16(v1[0], v1[1]); w[bj][3] = pg8::cvt_pk_bf16(v1[2], v1[3]);
                    }
                    store_rows(lds + STG_OFF + wid * 2304, (unsigned char*)(dst + (size_t)(row0 + ai * 128 + wr * 64 + m * 16) * ldd + colw), (size_t)ldd * 2, lane, w[0], w[1]);
                }
            return;
        }
        LAS float* X = (LAS float*)(lds + XCH_OFF);
#pragma unroll
        for (int ai = 0; ai < 2; ++ai)
#pragma unroll
            for (int m = 0; m < 4; ++m) {
                float ss = 0.f;
#pragma unroll
                for (int bj = 0; bj < 2; ++bj)
#pragma unroll
                    for (int n = 0; n < 2; ++n) { const f32x4 v = acc[ai][bj][m][n]; ss += (v[0] * v[0] + v[1] * v[1]) + (v[2] * v[2] + v[3] * v[3]); }
                ss += __shfl_xor(ss, 16); ss += __shfl_xor(ss, 32);
                if (fq == 0) X[wid * 128 + ai * 64 + m * 16 + fr] = ss;
            }
        asm volatile("s_waitcnt lgkmcnt(0)" ::: "memory"); __builtin_amdgcn_s_barrier(); asm volatile("" ::: "memory");
        const int ax = wc & 1;
        const float* gain = (blk == 1 ? qg : kg) + ax * 64 + 8 * fq;
        const f32x4 g00 = *(const f32x4*)(gain), g01 = *(const f32x4*)(gain + 4), g10 = *(const f32x4*)(gain + 32), g11 = *(const f32x4*)(gain + 36);
        const float post = (blk == 1) ? QSCALE : 1.0f;
#pragma unroll
        for (int ai = 0; ai < 2; ++ai)
#pragma unroll
            for (int m = 0; m < 4; ++m) {
                const int ridx = ai * 64 + m * 16 + fr;
                const float tot = X[wid * 128 + ridx] + X[(wid ^ 1) * 128 + ridx];
                const float rs = post / sqrtf(tot * (1.0f / HD) + 1e-6f);
                f32x4 x0a = acc[ai][0][m][0] * g00 * rs, x0b = acc[ai][0][m][1] * g01 * rs, x1a = acc[ai][1][m][0] * g10 * rs, x1b = acc[ai][1][m][1] * g11 * rs;
                if (!isctx) {
                    const int t = (row0 + ai * 128 + wr * 64 + m * 16 + fr) & (S - 1);
                    const int pos = ax ? (t & 63) : (t >> 6);
                    const f32x4* rp = (const f32x4*)(rope + pos * 32 + 8 * fq);
                    const f32x4 c0 = rp[0], c1 = rp[1], c2 = rp[2], c3 = rp[3];
                    f32x4 y0a, y0b, y1a, y1b;
                    y0a[0] = x0a[0] * c0[0] - x1a[0] * c0[1]; y1a[0] = x1a[0] * c0[0] + x0a[0] * c0[1];
                    y0a[1] = x0a[1] * c0[2] - x1a[1] * c0[3]; y1a[1] = x1a[1] * c0[2] + x0a[1] * c0[3];
                    y0a[2] = x0a[2] * c1[0] - x1a[2] * c1[1]; y1a[2] = x1a[2] * c1[0] + x0a[2] * c1[1];
                    y0a[3] = x0a[3] * c1[2] - x1a[3] * c1[3]; y1a[3] = x1a[3] * c1[2] + x0a[3] * c1[3];
                    y0b[0] = x0b[0] * c2[0] - x1b[0] * c2[1]; y1b[0] = x1b[0] * c2[0] + x0b[0] * c2[1];
                    y0b[1] = x0b[1] * c2[2] - x1b[1] * c2[3]; y1b[1] = x1b[1] * c2[2] + x0b[1] * c2[3];
                    y0b[2] = x0b[2] * c3[0] - x1b[2] * c3[1]; y1b[2] = x1b[2] * c3[0] + x0b[2] * c3[1];
                    y0b[3] = x0b[3] * c3[2] - x1b[3] * c3[3]; y1b[3] = x1b[3] * c3[2] + x0b[3] * c3[3];
                    x0a = y0a; x0b = y0b; x1a = y1a; x1b = y1b;
                }
                u32x4 w0, w1;
                w0[0] = pg8::cvt_pk_bf16(x0a[0], x0a[1]); w0[1] = pg8::cvt_pk_bf16(x0a[2], x0a[3]); w0[2] = pg8::cvt_pk_bf16(x0b[0], x0b[1]); w0[3] = pg8::cvt_pk_bf16(x0b[2], x0b[3]);
                w1[0] = pg8::cvt_pk_bf16(x1a[0], x1a[1]); w1[1] = pg8::cvt_pk_bf16(x1a[2], x1a[3]); w1[2] = pg8::cvt_pk_bf16(x1b[0], x1b[1]); w1[3] = pg8::cvt_pk_bf16(x1b[2], x1b[3]);
                store_rows(lds + STG_OFF + wid * 2304, (unsigned char*)(dst + (size_t)(row0 + ai * 128 + wr * 64 + m * 16) * D + colw), (size_t)D * 2, lane, w0, w1);
            }
    }
};

struct SchedFold {
    int G, c;
    __device__ __forceinline__ bool next(int i, pg8::Unit& u) const {
        const long L = (long)i * G + c; if (L >= 64) return false;
        const int part = (int)(L & 1), g = (int)((L >> 1) & 3), kt = (int)(L >> 3);
        u.pm = part * 4 + g; u.pn = kt; u.x0 = 0; u.x1 = 0; u.nt = 4; u.keep = 0; u.aoff = (long)part * 256 * 256 * 2; u.boff = ((long)kt * 256 * FW + g * 256) * 2; return true;
    }
};
struct SchedUft {
    int G, c;
    __device__ __forceinline__ bool next(int i, pg8::Unit& u) const {
        const long L = (long)i * G + c; if (L >= 256) return false;
        const int b = (int)(L >> 5), ct = (int)((L >> 3) & 3), tt = (int)(L & 7), part = tt >> 2;
        u.pm = ct; u.pn = tt; u.x0 = b; u.x1 = 0; u.nt = D / 64; u.keep = 0;
        u.aoff = (long)(part * 1024 + ct * 256) * D * 2; u.boff = ((long)b * 2048 + tt * 256) * D * 2; return true;
    }
};
struct EpiTile {
    bf16_t* base; long ld; int mode;
    __device__ __forceinline__ void operator()(f32x4 (&acc)[2][2][4][2], const pg8::Unit& u, int wr, int wc, int fr, int fq, LAS unsigned char* lds, int wid, int lane) const {
        const long row0 = (mode == 0) ? (long)u.pm * 256 : (long)u.x0 * 1024 + u.pm * 256;
        bf16_t* p0 = base + (row0 + wr * 64) * ld + u.pn * 256 + wc * 64;
#pragma unroll
        for (int ai = 0; ai < 2; ++ai)
#pragma unroll
            for (int m = 0; m < 4; ++m) {
                u32x4 w[2];
#pragma unroll
                for (int bj = 0; bj < 2; ++bj) { const f32x4 v0 = acc[ai][bj][m][0], v1 = acc[ai][bj][m][1];
                    w[bj][0] = pg8::cvt_pk_bf16(v0[0], v0[1]); w[bj][1] = pg8::cvt_pk_bf16(v0[2], v0[3]); w[bj][2] = pg8::cvt_pk_bf16(v1[0], v1[1]); w[bj][3] = pg8::cvt_pk_bf16(v1[2], v1[3]); }
                store_rows(lds + STG_OFF + wid * 2304, (unsigned char*)(p0 + (long)(ai * 128 + m * 16) * ld), (size_t)ld * 2, lane, w[0], w[1]);
            }
    }
};
struct SchedPos {
    int G, c;
    __device__ __forceinline__ bool next(int i, pg8::Unit& u) const {
        const long L = (long)i * G + c; if (L >= 256) return false;
        const int b = (int)(L >> 5), pm = (int)((L & 31) >> 2), pn = (int)(L & 3);
        u.pm = pm; u.pn = pn; u.x0 = b; u.x1 = 0; u.nt = D / 64; u.keep = 0; u.aoff = (long)pm * 256 * D * 2; u.boff = ((long)b * 1024 + pn * 256) * D * 2; return true;
    }
};
__device__ __forceinline__ float bflo(unsigned w) { return __uint_as_float(w << 16); }
__device__ __forceinline__ float bfhi(unsigned w) { return __uint_as_float(w & 0xffff0000u); }
struct EpiPos {
    const bf16_t* ZFC; bf16_t* MF; const float* PN;
    __device__ __forceinline__ void operator()(f32x4 (&acc)[2][2][4][2], const pg8::Unit& u, int wr, int wc, int fr, int fq, LAS unsigned char* lds, int wid, int lane) const {
        const int col = u.pn * 256 + wc * 64 + 8 * fq;
        const float sg = (fr & 1) ? -0.022097086912079608f : 0.022097086912079608f;
        const float* pn = PN + u.x0 * 1024 + col;
        f32x4 pv[2][2];
#pragma unroll
        for (int bj = 0; bj < 2; ++bj) { pv[bj][0] = *(const f32x4*)(pn + bj * 32) * sg; pv[bj][1] = *(const f32x4*)(pn + bj * 32 + 4) * sg; }
        LAS unsigned char* scr = lds + STG_OFF + wid * 2304;
        const size_t rw = (size_t)u.x0 * S + u.pm * 256 + wr * 64; const int cw = u.pn * 256 + wc * 64;
#define EPP_ROW(g) (rw + (size_t)(((g) >> 2) * 128 + ((g) & 3) * 16))
        RowLd cur = rows_issue((const unsigned char*)(ZFC + EPP_ROW(0) * FW + cw), (size_t)FW * 2, lane), nx1 = rows_issue((const unsigned char*)(ZFC + EPP_ROW(1) * FW + cw), (size_t)FW * 2, lane);
#pragma unroll
        for (int g = 0; g < 8; ++g) {
            RowLd nx2 = cur; if (g + 2 < 8) nx2 = rows_issue((const unsigned char*)(ZFC + EPP_ROW(g + 2) * FW + cw), (size_t)FW * 2, lane);
            const int ai = g >> 2, m = g & 3;
            u32x4 w[2], zz[2]; rows_spread(scr, lane, cur, zz[0], zz[1]);
#pragma unroll
            for (int bj = 0; bj < 2; ++bj) { const f32x4 v0 = acc[ai][bj][m][0] + pv[bj][0], v1 = acc[ai][bj][m][1] + pv[bj][1]; const u32x4 z = zz[bj];
                w[bj][0] = pg8::cvt_pk_bf16(v0[0] * bflo(z[0]), v0[1] * bfhi(z[0])); w[bj][1] = pg8::cvt_pk_bf16(v0[2] * bflo(z[1]), v0[3] * bfhi(z[1]));
                w[bj][2] = pg8::cvt_pk_bf16(v1[0] * bflo(z[2]), v1[1] * bfhi(z[2])); w[bj][3] = pg8::cvt_pk_bf16(v1[2] * bflo(z[3]), v1[3] * bfhi(z[3])); }
            store_rows(scr, (unsigned char*)(MF + EPP_ROW(g) * D + cw), (size_t)D * 2, lane, w[0], w[1]);
            cur = nx1; nx1 = nx2;
        }
#undef EPP_ROW
    }
};
struct SchedRows {
    int G, c;
    __device__ __forceinline__ bool next(int i, pg8::Unit& u) const {
        const long L = (long)i * G + c; if (L >= 512) return false;
        const int xcd = (int)(L & 7), off = (int)(L >> 3);
        u.pm = 8 * xcd + (off & 7); u.pn = off >> 3; u.x0 = 0; u.x1 = 0; u.nt = D / 64; u.keep = 0; u.aoff = (long)u.pm * 256 * D * 2; u.boff = (long)u.pn * 256 * D * 2; return true;
    }
};
struct SchedY {
    int G, c; long a2off;
    __device__ __forceinline__ bool next(int i, pg8::Unit& u) const {
        const int seg = i & 1; const long L = (long)(i >> 1) * G + c; if (L >= 512) return false;
        const int xcd = (int)(L & 7), off = (int)(L >> 3);
        u.pm = 8 * xcd + (off & 7); u.pn = off >> 3; u.x0 = seg; u.x1 = 0; u.nt = seg ? 32 : 16; u.keep = seg ? 0 : 1;
        u.aoff = (long)u.pm * 256 * D * 2 + (seg ? a2off : 0); u.boff = (long)u.pn * 256 * 3072 * 2 + (seg ? 1024 * 2 : 0); return true;
    }
};
struct EpiY {
    bf16_t* SGF; const bf16_t* SGA;
    __device__ __forceinline__ void mid(f32x4 (&acc)[2][2][4][2], const pg8::Unit& u, int wr, int wc, int fr, int fq, LAS unsigned char* lds, int wid, int lane) const {
        LAS unsigned char* scr = lds + STG_OFF + wid * 2304;
        const size_t o0 = (size_t)(u.pm * 256 + wr * 64) * D + u.pn * 256 + wc * 64;
#define EPY_OFF(g) (o0 + (size_t)(((g) >> 2) * 128 + ((g) & 3) * 16) * D)
        RowLd cf = rows_issue((const unsigned char*)(SGF + EPY_OFF(0)), (size_t)D * 2, lane), ca = rows_issue((const unsigned char*)(SGA + EPY_OFF(0)), (size_t)D * 2, lane);
        RowLd nf = rows_issue((const unsigned char*)(SGF + EPY_OFF(1)), (size_t)D * 2, lane), na = rows_issue((const unsigned char*)(SGA + EPY_OFF(1)), (size_t)D * 2, lane);
#pragma unroll
        for (int g = 0; g < 8; ++g) {
            RowLd n2f = cf, n2a = ca; if (g + 2 < 8) { n2f = rows_issue((const unsigned char*)(SGF + EPY_OFF(g + 2)), (size_t)D * 2, lane); n2a = rows_issue((const unsigned char*)(SGA + EPY_OFF(g + 2)), (size_t)D * 2, lane); }
            const int ai = g >> 2, m = g & 3;
            u32x4 gf[2], ga[2]; rows_spread(scr, lane, cf, gf[0], gf[1]); rows_spread(scr, lane, ca, ga[0], ga[1]);
#pragma unroll
            for (int bj = 0; bj < 2; ++bj) {
                f32x4& v0 = acc[ai][bj][m][0]; f32x4& v1 = acc[ai][bj][m][1];
                v0[0] *= bflo(gf[bj][0]) * __builtin_amdgcn_rcpf(bflo(ga[bj][0])); v0[1] *= bfhi(gf[bj][0]) * __builtin_amdgcn_rcpf(bfhi(ga[bj][0]));
                v0[2] *= bflo(gf[bj][1]) * __builtin_amdgcn_rcpf(bflo(ga[bj][1])); v0[3] *= bfhi(gf[bj][1]) * __builtin_amdgcn_rcpf(bfhi(ga[bj][1]));
                v1[0] *= bflo(gf[bj][2]) * __builtin_amdgcn_rcpf(bflo(ga[bj][2])); v1[1] *= bfhi(gf[bj][2]) * __builtin_amdgcn_rcpf(bfhi(ga[bj][2]));
                v1[2] *= bflo(gf[bj][3]) * __builtin_amdgcn_rcpf(bflo(ga[bj][3])); v1[3] *= bfhi(gf[bj][3]) * __builtin_amdgcn_rcpf(bfhi(ga[bj][3]));
            }
            cf = nf; ca = na; nf = n2f; na = n2a;
        }
    }
    __device__ __forceinline__ void operator()(f32x4 (&acc)[2][2][4][2], const pg8::Unit& u, int wr, int wc, int fr, int fq, LAS unsigned char* lds, int wid, int lane) const {
        if (u.x0 == 0) { mid(acc, u, wr, wc, fr, fq, lds, wid, lane); return; }
        LAS unsigned char* scr = lds + STG_OFF + wid * 2304;
        const size_t o0 = (size_t)(u.pm * 256 + wr * 64) * D + u.pn * 256 + wc * 64;
        RowLd cur = rows_issue((const unsigned char*)(SGA + EPY_OFF(0)), (size_t)D * 2, lane), nx1 = rows_issue((const unsigned char*)(SGA + EPY_OFF(1)), (size_t)D * 2, lane);
#pragma unroll
        for (int g = 0; g < 8; ++g) {
            RowLd nx2 = cur; if (g + 2 < 8) nx2 = rows_issue((const unsigned char*)(SGA + EPY_OFF(g + 2)), (size_t)D * 2, lane);
            const int ai = g >> 2, m = g & 3;
            u32x4 w[2], gg[2]; rows_spread(scr, lane, cur, gg[0], gg[1]);
#pragma unroll
            for (int bj = 0; bj < 2; ++bj) { const u32x4 ga = gg[bj]; const f32x4 v0 = acc[ai][bj][m][0], v1 = acc[ai][bj][m][1];
                w[bj][0] = pg8::cvt_pk_bf16(v0[0] * bflo(ga[0]), v0[1] * bfhi(ga[0])); w[bj][1] = pg8::cvt_pk_bf16(v0[2] * bflo(ga[1]), v0[3] * bfhi(ga[1]));
                w[bj][2] = pg8::cvt_pk_bf16(v1[0] * bflo(ga[2]), v1[1] * bfhi(ga[2])); w[bj][3] = pg8::cvt_pk_bf16(v1[2] * bflo(ga[3]), v1[3] * bfhi(ga[3])); }
            store_rows(scr, (unsigned char*)(SGF + EPY_OFF(g)), (size_t)D * 2, lane, w[0], w[1]);
            cur = nx1; nx1 = nx2;
        }
#undef EPY_OFF
    }
};
struct EpiOut {
    const float* x; const float* mod; float* out;
    __device__ __forceinline__ void operator()(f32x4 (&acc)[2][2][4][2], const pg8::Unit& u, int wr, int wc, int fr, int fq, LAS unsigned char* lds, int wid, int lane) const {
        const int col = u.pn * 256 + wc * 64 + 8 * fq;
        const float* gate = mod + (size_t)(u.pm >> 3) * 3 * D + 2 * D + col;
        f32x4 gt[2][2];
#pragma unroll
        for (int bj = 0; bj < 2; ++bj) { gt[bj][0] = *(const f32x4*)(gate + bj * 32); gt[bj][1] = *(const f32x4*)(gate + bj * 32 + 4); }
        LAS unsigned char* scr = lds + STG_OFF + wid * 2304;
        const size_t o0 = (size_t)(u.pm * 256 + wr * 64) * D + u.pn * 256 + wc * 64;
#define EPO_OFF(g) (o0 + (size_t)((((g) >> 3) & 1) * 128 + (((g) >> 1) & 3) * 16) * D + ((g) & 1) * 32)
        RowLd cur = rows_issue((const unsigned char*)(x + EPO_OFF(0)), (size_t)D * 4, lane), nx1 = rows_issue((const unsigned char*)(x + EPO_OFF(1)), (size_t)D * 4, lane);
#pragma unroll
        for (int g = 0; g < 16; ++g) {
            RowLd nx2 = cur; if (g + 2 < 16) nx2 = rows_issue((const unsigned char*)(x + EPO_OFF(g + 2)), (size_t)D * 4, lane);
            const int ai = (g >> 3) & 1, m = (g >> 1) & 3, bj = g & 1;
            u32x4 x0, x1; rows_spread<true>(scr, lane, cur, x0, x1);
            const f32x4 r0 = __builtin_bit_cast(f32x4, x0) + gt[bj][0] * acc[ai][bj][m][0], r1 = __builtin_bit_cast(f32x4, x1) + gt[bj][1] * acc[ai][bj][m][1];
            store_rows<true>(scr, (unsigned char*)(out + EPO_OFF(g)), (size_t)D * 4, lane, __builtin_bit_cast(u32x4, r0), __builtin_bit_cast(u32x4, r1));
            cur = nx1; nx1 = nx2;
        }
#undef EPO_OFF
    }
};

namespace natt {
typedef short v4i16_t __attribute__((ext_vector_type(4)));
__device__ __forceinline__ v4i16_t vtr(const LAS unsigned char* p) { return __builtin_amdgcn_ds_read_tr16_b64_v4i16((LAS v4i16_t*)p); }
struct Tensors { const bf16_t* Q; bf16_t* O; const bf16_t* K; const bf16_t* V; const bf16_t* KC; const bf16_t* VC; const bf16_t* SZA; const float* rpb; const float* shift; };

__device__ __forceinline__ bf16x8 softmax_pack(const f32x4& sx, const f32x4& sy, float& lsum, bool local, const int (&dcv)[2][4], const LAS float* Trow, float shift) {
    float px[4], py[4];
#pragma unroll
    for (int j = 0; j < 4; ++j) {
        if (local) {
            const int ix = dcv[0][j], iy = dcv[1][j];
            const float bx = Trow[ix < 0 ? 0 : ix], by = Trow[iy < 0 ? 0 : iy];
            px[j] = ix < 0 ? 0.f : __builtin_amdgcn_exp2f(sx[j] + bx);
            py[j] = iy < 0 ? 0.f : __builtin_amdgcn_exp2f(sy[j] + by);
        } else { px[j] = __builtin_amdgcn_exp2f(sx[j]); py[j] = __builtin_amdgcn_exp2f(sy[j]); }
    }
    lsum += ((px[0] + px[1]) + (px[2] + px[3])) + ((py[0] + py[1]) + (py[2] + py[3]));
    u32x4 pw; pw[0] = pg8::cvt_pk_bf16(px[0], px[1]); pw[1] = pg8::cvt_pk_bf16(px[2], px[3]); pw[2] = pg8::cvt_pk_bf16(py[0], py[1]); pw[3] = pg8::cvt_pk_bf16(py[2], py[3]);
    return __builtin_bit_cast(bf16x8, pw);
}
__device__ __forceinline__ void glds16(const void* gsrc, unsigned lds_dst) { unsigned keep;
    asm volatile("s_mov_b32 %0, m0\n\ts_mov_b32 m0, %2\n\ts_nop 0\n\tglobal_load_lds_dwordx4 %1, off\n\ts_mov_b32 m0, %0" : "=&s"(keep) : "v"(gsrc), "s"(lds_dst) : "memory"); }
#define NATT_R128(dst, addr, off) asm volatile("ds_read_b128 %0, %1 offset:%2" : "=v"(dst) : "v"(addr), "i"(off))
#define NATT_TR64(dst, addr, off) asm volatile("ds_read_b64_tr_b16 %0, %1 offset:%2" : "=v"(dst) : "v"(addr), "i"(off))
#define NATT_WAIT(n) do { __builtin_amdgcn_sched_barrier(0); asm volatile("s_waitcnt lgkmcnt(" #n ")" ::: "memory"); __builtin_amdgcn_sched_barrier(0); } while (0)
#define NATT_VF(x, y) (bf16x8){x[0], x[1], x[2], x[3], y[0], y[1], y[2], y[3]}
template <bool LOCAL>
__device__ __forceinline__ void step2(unsigned Kb, unsigned Vb, int kbA, int kbB, const bf16x8 (&qA)[4], const bf16x8 (&qB)[4], f32x4 (&oA)[8], f32x4 (&oB)[8],
                                      float& lA, float& lB, int fr, int fq, const int (&dcvA)[2][4], const int (&dcvB)[2][4], const LAS float* Trow, float shift) {
    if (LOCAL) asm volatile("" : "+v"(fr), "+v"(fq));
    const int krA = kbA + fr, krB = kbB + fr, ch = (fr & 3) >> 1;
    const int vrA = kbA + 4 * fq + (fr >> 2), swA = (vrA & 7) << 1, vrB = kbB + 4 * fq + (fr >> 2), swB = (vrB & 7) << 1;
    const unsigned vaA = Vb + vrA * 256 + (fr & 1) * 8, vaB = Vb + vrB * 256 + (fr & 1) * 8;
    bf16x8 kxA[4], kyA[4], kxB[4], kyB[4];
#pragma unroll
    for (int ks = 0; ks < 4; ++ks) { const unsigned a = Kb + krA * 256 + (((4 * ks + fq) ^ (krA & 15)) << 4); NATT_R128(kxA[ks], a, 0); NATT_R128(kyA[ks], a, 4096); }
    if (LOCAL) {
#pragma unroll
        for (int ks = 0; ks < 4; ++ks) { const unsigned a = Kb + krB * 256 + (((4 * ks + fq) ^ (krB & 15)) << 4); NATT_R128(kxB[ks], a, 0); NATT_R128(kyB[ks], a, 4096); }
    }
    v4i16_t x0[4], y0[4], x1[4], y1[4];
#pragma unroll
    for (int d = 0; d < 4; ++d) { const unsigned a = vaA + (((2 * d + ch) ^ swA) << 4); NATT_TR64(x0[d], a, 0); NATT_TR64(y0[d], a, 4096); }
    NATT_WAIT(8);
    f32x4 sxA = (f32x4){-shift, -shift, -shift, -shift}, syA = sxA, sxB = sxA, syB = sxA;
#pragma unroll
    for (int ks = 0; ks < 4; ++ks) {
        sxA = __builtin_amdgcn_mfma_f32_16x16x32_bf16(kxA[ks], qA[ks], sxA, 0, 0, 0);
        syA = __builtin_amdgcn_mfma_f32_16x16x32_bf16(kyA[ks], qA[ks], syA, 0, 0, 0);
        sxB = __builtin_amdgcn_mfma_f32_16x16x32_bf16(LOCAL ? kxB[ks] : kxA[ks], qB[ks], sxB, 0, 0, 0);
        syB = __builtin_amdgcn_mfma_f32_16x16x32_bf16(LOCAL ? kyB[ks] : kyA[ks], qB[ks], syB, 0, 0, 0);
    }
    const bf16x8 pbA = softmax_pack(sxA, syA, lA, LOCAL, dcvA, Trow, shift);
    const bf16x8 pbB = softmax_pack(sxB, syB, lB, LOCAL, dcvB, Trow, shift);
    NATT_WAIT(0);
#pragma unroll
    for (int d = 0; d < 4; ++d) { const unsigned a = vaA + (((2 * (d + 4) + ch) ^ swA) << 4); NATT_TR64(x1[d], a, 0); NATT_TR64(y1[d], a, 4096); }
    __builtin_amdgcn_sched_barrier(0);
#pragma unroll
    for (int d = 0; d < 4; ++d) { const bf16x8 vf = NATT_VF(x0[d], y0[d]); oA[d] = __builtin_amdgcn_mfma_f32_16x16x32_bf16(vf, pbA, oA[d], 0, 0, 0); if (!LOCAL) oB[d] = __builtin_amdgcn_mfma_f32_16x16x32_bf16(vf, pbB, oB[d], 0, 0, 0); }
    NATT_WAIT(0);
    if (LOCAL) {
#pragma unroll
        for (int d = 0; d < 4; ++d) { const unsigned a = vaB + (((2 * d + ch) ^ swB) << 4); NATT_TR64(x0[d], a, 0); NATT_TR64(y0[d], a, 4096); }
        __builtin_amdgcn_sched_barrier(0);
    }
#pragma unroll
    for (int d = 0; d < 4; ++d) { const bf16x8 vf = NATT_VF(x1[d], y1[d]); oA[d + 4] = __builtin_amdgcn_mfma_f32_16x16x32_bf16(vf, pbA, oA[d + 4], 0, 0, 0); if (!LOCAL) oB[d + 4] = __builtin_amdgcn_mfma_f32_16x16x32_bf16(vf, pbB, oB[d + 4], 0, 0, 0); }
    if (LOCAL) {
        NATT_WAIT(0);
#pragma unroll
        for (int d = 0; d < 4; ++d) { const unsigned a = vaB + (((2 * (d + 4) + ch) ^ swB) << 4); NATT_TR64(x1[d], a, 0); NATT_TR64(y1[d], a, 4096); }
        __builtin_amdgcn_sched_barrier(0);
#pragma unroll
        for (int d = 0; d < 4; ++d) { const bf16x8 vf = NATT_VF(x0[d], y0[d]); oB[d] = __builtin_amdgcn_mfma_f32_16x16x32_bf16(vf, pbB, oB[d], 0, 0, 0); }
        NATT_WAIT(0);
#pragma unroll
        for (int d = 0; d < 4; ++d) { const bf16x8 vf = NATT_VF(x1[d], y1[d]); oB[d + 4] = __builtin_amdgcn_mfma_f32_16x16x32_bf16(vf, pbB, oB[d + 4], 0, 0, 0); }
    }
}

__device__ __forceinline__ void attn_phase(LAS unsigned char* lds, const Tensors& T, int vcu) {
    int tid = threadIdx.x; asm volatile("" : "+v"(tid));
    const int lane = tid & 63, wid = __builtin_amdgcn_readfirstlane(tid >> 6), fr = lane & 15, fq = lane >> 4;
    const unsigned lds0 = (unsigned)(size_t)lds;
    LAS float* Tb = (LAS float*)(lds + XCH_OFF);
    float shift = T.shift[0]; asm volatile("" : "+v"(shift));
    const int sA = 2 * (wid & 1), sB = sA + 1, wq = wid >> 1;
    const int cwA = (sA == 0) ? 0 : 24, cwB = (sB == 1) ? 8 : 32;
    int dcvA[2][4], dcvB[2][4];
    {   const int cA = 16 * sA + fr, cstA = min(max(cA - 8, 0), 48), cB = 16 * sB + fr, cstB = min(max(cB - 8, 0), 48);
#pragma unroll
        for (int blk = 0; blk < 2; ++blk)
#pragma unroll
            for (int j = 0; j < 4; ++j) { const int kcA = cwA + 16 * blk + 4 * fq + j, kcB = cwB + 16 * blk + 4 * fq + j;
                dcvA[blk][j] = (kcA >= cstA && kcA < cstA + 16) ? (kcA - cA + 15) : -1; dcvB[blk][j] = (kcB >= cstB && kcB < cstB + 16) ? (kcB - cB + 15) : -1; } }
    const bool isV = wid >= 4;
    const int drow = 32 * (wid & 3) + (lane >> 4), dp = lane & 15;
    for (int ui = 0; ui < 4; ++ui) {
        const int bh = (vcu >> 5) * 16 + ((vcu >> 3) & 3) * 4 + ui, b = bh >> 4, h = bh & 15;
        for (int i = tid; i < 465; i += NWAVES * 64) Tb[i] = T.rpb[h * 465 + i] * 1.4426950408889634f;
        const int rq = (vcu + 2 * ui) & 7, r0 = 4 * rq, qrow = r0 + wq;
        const int rsu = min(max(r0 - 4, 0), 24), nl = min(max(r0 - 1, 0), 24) + 8 - rsu, rsq = min(max(qrow - 4, 0), 24);
        const int ntile = 2 + ((nl + 1) >> 1);
        const size_t qtok = (size_t)b * S + qrow * 64 + 16 * sA + fr;
        const bf16_t* qp = T.Q + qtok * D + h * HD; bf16_t* op = T.O + qtok * D + h * HD;
        bf16x8 qA[4], qB[4];
#pragma unroll
        for (int ks = 0; ks < 4; ++ks) { qA[ks] = *(const bf16x8*)(qp + 32 * ks + 8 * fq); qB[ks] = *(const bf16x8*)(qp + (size_t)16 * D + 32 * ks + 8 * fq); }
        f32x4 oA[8], oB[8];
#pragma unroll
        for (int db = 0; db < 8; ++db) { oA[db] = (f32x4){0.f, 0.f, 0.f, 0.f}; oB[db] = (f32x4){0.f, 0.f, 0.f, 0.f}; }
        float lA = 0.f, lB = 0.f;
        asm volatile("" : "+v"(qA[0]), "+v"(qA[1]), "+v"(qA[2]), "+v"(qA[3]), "+v"(qB[0]), "+v"(qB[1]), "+v"(qB[2]), "+v"(qB[3]));
#define NATT_ISSUE(j) do { const int j_ = (j); const bf16_t* src_; bool go_ = true; \
            if (j_ < 2) src_ = (isV ? T.VC : T.KC) + ((size_t)b * L + 128 * j_) * D + h * HD; \
            else { src_ = (isV ? T.V : T.K) + ((size_t)b * S + (rsu + 2 * (j_ - 2)) * 64) * D + h * HD; go_ = ((wid & 3) < 2) || (2 * (j_ - 2) + 1 < nl); } \
            if (go_) { int drow_ = drow, dp_ = dp; asm volatile("" : "+v"(drow_), "+v"(dp_)); \
            const unsigned dst_ = (unsigned)__builtin_amdgcn_readfirstlane(lds0 + (j_ & 1) * 65536 + (isV ? 32768 : 0) + (wid & 3) * 8192); \
            _Pragma("unroll") for (int e_ = 0; e_ < 8; ++e_) { const int row_ = drow_ + 4 * e_; const int c_ = isV ? (dp_ ^ ((row_ & 7) << 1)) : (dp_ ^ (row_ & 15)); \
                glds16(src_ + (size_t)row_ * D + c_ * 8, dst_ + e_ * 1024); } } } while (0)
#define NATT_TILE_SYNC() do { asm volatile("s_waitcnt vmcnt(0) lgkmcnt(0)\n\ts_barrier" ::: "memory"); __builtin_amdgcn_sched_barrier(0); } while (0)
        NATT_ISSUE(0);
#pragma unroll 1
        for (int j = 0; j < 2; ++j) {
            NATT_TILE_SYNC();
            NATT_ISSUE(j + 1);
            const unsigned Kb = lds0 + (j & 1) * 65536, Vb = Kb + 32768;
#pragma unroll 1
            for (int pr = 0; pr < 4; ++pr) step2<false>(Kb, Vb, 32 * pr, 32 * pr, qA, qB, oA, oB, lA, lB, fr, fq, dcvA, dcvB, Tb, shift);
        }
#pragma unroll 1
        for (int j = 2; j < ntile; ++j) {
            NATT_TILE_SYNC();
            if (j + 1 < ntile) NATT_ISSUE(j + 1);
            const unsigned Kb = lds0 + (j & 1) * 65536, Vb = Kb + 32768;
#pragma unroll 1
            for (int hr = 0; hr < 2; ++hr) {
                const int kr = rsu + 2 * (j - 2) + hr;
                if (kr >= rsq && kr < rsq + 8) step2<true>(Kb, Vb, 64 * hr + cwA, 64 * hr + cwB, qA, qB, oA, oB, lA, lB, fr, fq, dcvA, dcvB, Tb + (kr - qrow + 7) * 31, shift);
            }
        }
#undef NATT_ISSUE
        asm volatile("s_waitcnt lgkmcnt(0)\n\ts_barrier" ::: "memory"); __builtin_amdgcn_sched_barrier(0);
        lA += __shfl_xor(lA, 16); lA += __shfl_xor(lA, 32); lB += __shfl_xor(lB, 16); lB += __shfl_xor(lB, 32);
        const float invA = 1.0f / lA, invB = 1.0f / lB;
        const bf16_t* zp = T.SZA + qtok * D + h * HD + 4 * fq;
#pragma unroll
        for (int db = 0; db < 8; ++db) {
            const u32x2 zA = *(const u32x2*)(zp + 16 * db), zB = *(const u32x2*)(zp + (size_t)16 * D + 16 * db);
            u32x2 w; w[0] = pg8::cvt_pk_bf16(oA[db][0] * invA * bflo(zA[0]), oA[db][1] * invA * bfhi(zA[0])); w[1] = pg8::cvt_pk_bf16(oA[db][2] * invA * bflo(zA[1]), oA[db][3] * invA * bfhi(zA[1]));
            *(u32x2*)(op + 16 * db + 4 * fq) = w;
            w[0] = pg8::cvt_pk_bf16(oB[db][0] * invB * bflo(zB[0]), oB[db][1] * invB * bfhi(zB[0])); w[1] = pg8::cvt_pk_bf16(oB[db][2] * invB * bflo(zB[1]), oB[db][3] * invB * bfhi(zB[1]));
            *(u32x2*)(op + (size_t)16 * D + 16 * db + 4 * fq) = w;
        }
    }
}
}

struct MArgs { const float* in[13]; float* out; unsigned char* ws; int ph_lo, ph_hi, li, pad; };
struct Frame {
    LAS unsigned char* lds; volatile LAS unsigned* MISC; unsigned* ctl; int tid, lane, wave, vcu, G;
};
__device__ __forceinline__ unsigned pk2(float lo, float hi) { return f2bf(lo) | (f2bf(hi) << 16); }

__device__ __forceinline__ void p0_transpose_item(const float* W, int N, bf16_t* WT, int ldo, int koff, int k0, int n0, int lane) {
    f32x4 v[16];
    const float* src = W + (size_t)k0 * N + n0 + 4 * lane;
#pragma unroll
    for (int kk = 0; kk < 16; ++kk) v[kk] = __builtin_nontemporal_load((const f32x4*)(src + (size_t)kk * N));
#pragma unroll
    for (int j = 0; j < 4; ++j) {
        u32x4 a, b;
        a[0] = pk2(v[0][j], v[1][j]); a[1] = pk2(v[2][j], v[3][j]); a[2] = pk2(v[4][j], v[5][j]); a[3] = pk2(v[6][j], v[7][j]);
        b[0] = pk2(v[8][j], v[9][j]); b[1] = pk2(v[10][j], v[11][j]); b[2] = pk2(v[12][j], v[13][j]); b[3] = pk2(v[14][j], v[15][j]);
        bf16_t* dst = WT + (size_t)(n0 + 4 * lane + j) * ldo + koff + k0;
        *(u32x4*)dst = a; *(u32x4*)(dst + 8) = b;
    }
}
struct CopyItem { const float* W; bf16_t* WT; int N, ldo, koff, k0, n0; };
__device__ __forceinline__ void p0_copy_load(const CopyItem& c, int wave, int lane, f32x4 (&v)[8][2]) {
    const float* src = c.W + (size_t)(c.k0 + 8 * wave) * c.N + c.n0 + 4 * lane;
#pragma unroll
    for (int r = 0; r < 8; ++r) { v[r][0] = __builtin_nontemporal_load((const f32x4*)(src + (size_t)r * c.N)); v[r][1] = __builtin_nontemporal_load((const f32x4*)(src + (size_t)r * c.N + 256)); }
}
__device__ __forceinline__ void p0_copy_finish(const CopyItem& c, LAS unsigned char* T, int wave, int lane, const f32x4 (&v)[8][2]) {
#pragma unroll
    for (int i = 0; i < 2; ++i)
#pragma unroll
        for (int j = 0; j < 4; ++j) {
            u32x4 a; a[0] = pk2(v[0][i][j], v[1][i][j]); a[1] = pk2(v[2][i][j], v[3][i][j]); a[2] = pk2(v[4][i][j], v[5][i][j]); a[3] = pk2(v[6][i][j], v[7][i][j]);
            *(LAS u32x4*)(T + (256 * i + 4 * lane + j) * 144 + wave * 16) = a;
        }
    __syncthreads();
#pragma unroll
    for (int e = 0; e < 8; ++e) {
        const int n = wave * 64 + 8 * e + (lane >> 3), p = lane & 7;
        const u32x4 w = *(const LAS u32x4*)(T + n * 144 + p * 16);
        *(u32x4*)(c.WT + (size_t)(c.n0 + n) * c.ldo + c.koff + c.k0 + 8 * p) = w;
    }
    __syncthreads();
}
__device__ __forceinline__ void p0_mod_item(const float* c, const float* cctx, const float* wmod, const float* bmod, float* mod, LAS unsigned char* lds, int item, int wave, int lane) {
    LAS float* scr = (LAS float*)(lds + wave * 16384);
    LAS f32x4* red = (LAS f32x4*)(lds + 131072 + 1024);
    const int j0 = item * 16, fq = lane >> 4, fr = lane & 15, k0 = wave * 256;
    const float* wp = wmod + (size_t)(k0 + fq) * (3 * D) + j0 + fr;
    float w[64];
#pragma unroll
    for (int i = 0; i < 64; ++i) w[i] = __builtin_nontemporal_load(wp + (size_t)(4 * i) * (3 * D));
#pragma unroll 4
    for (int i = 0; i < 64; ++i) { const int idx = i * 64 + lane, b = idx >> 8, kk = idx & 255; float v = 0.f; if (b < 9) { const float z = (b < 8) ? c[b * D + k0 + kk] : cctx[k0 + kk]; v = z / (1.0f + __expf(-z)); } scr[idx] = v; }
    LDS_WAIT(); asm volatile("" ::: "memory");
    f32x4 acc0 = (f32x4){0.f, 0.f, 0.f, 0.f}, acc1 = (f32x4){0.f, 0.f, 0.f, 0.f};
#pragma unroll
    for (int i = 0; i < 64; i += 2) {
        acc0 = __builtin_amdgcn_mfma_f32_16x16x4f32(scr[fr * 256 + 4 * i + fq], w[i], acc0, 0, 0, 0);
        acc1 = __builtin_amdgcn_mfma_f32_16x16x4f32(scr[fr * 256 + 4 * i + 4 + fq], w[i + 1], acc1, 0, 0, 0);
    }
    red[wave * 64 + lane] = acc0 + acc1;
    __syncthreads();
    if (wave == 0) {
        f32x4 t = red[lane];
#pragma unroll
        for (int ww = 1; ww < 8; ++ww) t += red[ww * 64 + lane];
#pragma unroll
        for (int r = 0; r < 4; ++r) { const int b = 4 * fq + r; if (b < 9) mod[b * 3 * D + j0 + fr] = t[r] + bmod[j0 + fr]; }
    }
    __syncthreads();
}
__device__ __forceinline__ void p0_table_item(float2* rope, bf16_t* CS, bf16_t* DFTA, const float* qg, const float* kg, const float* rpbp, float* shiftp, int item, int lane) {
    if (item == 0) {
        for (int i = 0; i < 32; ++i) { const int gid = i * 64 + lane, pos = gid >> 5, j = gid & 31;
            const float invf = exp2f(-(float)j * 0.41524101186092029f); const float ang = (float)pos * invf; float sn, cs; sincosf(ang, &sn, &cs);
            rope[gid] = make_float2(cs, sn); }
        float mq = fmaxf(fabsf(qg[lane]), fabsf(qg[lane + 64])), mk = fmaxf(fabsf(kg[lane]), fabsf(kg[lane + 64])), mb = 0.f;
        for (int i = lane; i < NH * 465; i += 64) mb = fmaxf(mb, rpbp[i]);
        mq = wave_max(mq); mk = wave_max(mk); mb = wave_max(mb);
        if (lane == 0) shiftp[0] = (11.313708498984761f * mq * mk + mb) * 1.4426950408889634f;
    } else if (item <= 32) {
        const int base = (item - 1) * 4096;
#pragma unroll
        for (int i = 0; i < 8; ++i) { const int e0 = base + (i * 64 + lane) * 8; unsigned w[4];
#pragma unroll
            for (int q = 0; q < 4; ++q) { float v[2];
#pragma unroll
                for (int z = 0; z < 2; ++z) { const int e = e0 + 2 * q + z, part = e >> 16, cp = (e >> 8) & 255, cc = e & 255, mm = (cp * cc) & 255;
                    const float rev = (float)mm * (1.0f / 256.0f); v[z] = (part == 0 ? __builtin_amdgcn_cosf(rev) : -__builtin_amdgcn_sinf(rev)) * 0.0625f; }
                w[q] = pk2(v[0], v[1]); }
            *(u32x4*)(CS + e0) = (u32x4){w[0], w[1], w[2], w[3]}; }
    } else {
        const int k1 = item - 33;
#pragma unroll
        for (int i = 0; i < 4; ++i) { const int kk0 = (i * 64 + lane) * 8; unsigned w[4];
#pragma unroll
            for (int q = 0; q < 4; ++q) { float v[2];
#pragma unroll
                for (int z = 0; z < 2; ++z) { const int kk = kk0 + 2 * q + z, part = kk >> 10, n = kk & 1023, mm = (k1 * n) & 2047;
                    const float rev = (float)mm * (1.0f / 2048.0f); v[z] = (part == 0 ? __builtin_amdgcn_cosf(rev) : __builtin_amdgcn_sinf(rev)) * 0.022097086912079608f; }
                w[q] = pk2(v[0], v[1]); }
            *(u32x4*)(DFTA + (size_t)k1 * 2048 + kk0) = (u32x4){w[0], w[1], w[2], w[3]}; }
    }
}
__device__ __forceinline__ void p0_wuf_row(const float* win, bf16_t* Wuf, int k, int lane) {
    const float* src = win + (size_t)k * INW + lane * 16;
    const f32x4 a = *(const f32x4*)(src), b = *(const f32x4*)(src + 4), c = *(const f32x4*)(src + 8), d = *(const f32x4*)(src + 12);
    u32x4 w0, w1; w0[0] = pk2(a[0], a[1]); w0[1] = pk2(a[2], a[3]); w0[2] = pk2(b[0], b[1]); w0[3] = pk2(b[2], b[3]);
    w1[0] = pk2(c[0], c[1]); w1[1] = pk2(c[2], c[3]); w1[2] = pk2(d[0], d[1]); w1[3] = pk2(d[2], d[3]);
    bf16_t* dst = Wuf + (size_t)k * FW + lane * 16;
    *(u32x4*)dst = w0; *(u32x4*)(dst + 8) = w1;
}
__device__ __forceinline__ void p1_hnorm_row(const float* src, const float* shift, const float* scale, bf16_t* dst, int lane) {
    f32x4 v[8]; float ss = 0.f;
#pragma unroll
    for (int j = 0; j < 8; ++j) { v[j] = *(const f32x4*)(src + (j * 64 + lane) * 4); ss += (v[j][0] * v[j][0] + v[j][1] * v[j][1]) + (v[j][2] * v[j][2] + v[j][3] * v[j][3]); }
    ss = wave_sum(ss);
    const float rstd = 1.0f / sqrtf(ss * (1.0f / D) + 1e-6f);
#pragma unroll
    for (int j = 0; j < 8; ++j) {
        const int k = (j * 64 + lane) * 4;
        const f32x4 sc = *(const f32x4*)(scale + k), sh = *(const f32x4*)(shift + k);
        u32x2 o;
        o[0] = pk2(v[j][0] * rstd * (1.f + sc[0]) + sh[0], v[j][1] * rstd * (1.f + sc[1]) + sh[1]);
        o[1] = pk2(v[j][2] * rstd * (1.f + sc[2]) + sh[2], v[j][3] * rstd * (1.f + sc[3]) + sh[3]);
        *(u32x2*)(dst + k) = o;
    }
}
__device__ __forceinline__ void p1_pair_load(const float* xb, int n, int lane, f32x4 (&a)[8], f32x4 (&b)[8]) {
    const int n2 = (n == 0) ? 1024 : 2048 - n;
    const float* s0 = xb + (size_t)n * D; const float* s1 = xb + (size_t)n2 * D;
#pragma unroll
    for (int j = 0; j < 8; ++j) { a[j] = __builtin_nontemporal_load((const f32x4*)(s0 + (j * 64 + lane) * 4)); b[j] = __builtin_nontemporal_load((const f32x4*)(s1 + (j * 64 + lane) * 4)); }
}
__device__ __forceinline__ void p1_pair_finish(const f32x4 (&a)[8], const f32x4 (&b)[8], const float* shift, const float* scale, bf16_t* Hb, bf16_t* HEb, int n, int lane) {
    const int n2 = (n == 0) ? 1024 : 2048 - n;
    float sa = 0.f, sb = 0.f;
#pragma unroll
    for (int j = 0; j < 8; ++j) { sa += (a[j][0] * a[j][0] + a[j][1] * a[j][1]) + (a[j][2] * a[j][2] + a[j][3] * a[j][3]); sb += (b[j][0] * b[j][0] + b[j][1] * b[j][1]) + (b[j][2] * b[j][2] + b[j][3] * b[j][3]); }
    sa = wave_sum(sa); sb = wave_sum(sb);
    const float ra = 1.0f / sqrtf(sa * (1.0f / D) + 1e-6f), rb = 1.0f / sqrtf(sb * (1.0f / D) + 1e-6f);
#pragma unroll
    for (int j = 0; j < 8; ++j) {
        const int k = (j * 64 + lane) * 4;
        const f32x4 sc = *(const f32x4*)(scale + k), sh = *(const f32x4*)(shift + k);
        const f32x4 ha = a[j] * ra * (sc + 1.f) + sh, hb = b[j] * rb * (sc + 1.f) + sh;
        u32x2 o; o[0] = pk2(ha[0], ha[1]); o[1] = pk2(ha[2], ha[3]); *(u32x2*)(Hb + (size_t)n * D + k) = o;
        o[0] = pk2(hb[0], hb[1]); o[1] = pk2(hb[2], hb[3]); *(u32x2*)(Hb + (size_t)n2 * D + k) = o;
        f32x4 he, ho;
        if (n == 0) { he = ha; ho = (f32x4){0.f, 0.f, 0.f, 0.f}; } else { he = ha + hb; ho = ha - hb; }
        o[0] = pk2(he[0], he[1]); o[1] = pk2(he[2], he[3]); *(u32x2*)(HEb + (size_t)n * D + k) = o;
        o[0] = pk2(ho[0], ho[1]); o[1] = pk2(ho[2], ho[3]); *(u32x2*)(HEb + (size_t)(1024 + n) * D + k) = o;
    }
}
__device__ __forceinline__ void p3_pn_item(const bf16_t* H, const bf16_t* WPQ, float* PN, int item, int lane) {
    const int ch0 = item * 2;
    u32x4 w[2][4];
#pragma unroll
    for (int c = 0; c < 2; ++c)
#pragma unroll
        for (int q = 0; q < 4; ++q) w[c][q] = *(const u32x4*)(WPQ + (size_t)(ch0 + c) * D + (q * 64 + lane) * 8);
#pragma unroll 1
    for (int b = 0; b < NB; ++b) {
        const bf16_t* hr = H + ((size_t)b * S + 1024) * D;
        float a0 = 0.f, a1 = 0.f;
#pragma unroll
        for (int q = 0; q < 4; ++q) { const u32x4 hv = *(const u32x4*)(hr + (q * 64 + lane) * 8);
#pragma unroll
            for (int e = 0; e < 4; ++e) { a0 += bflo(hv[e]) * bflo(w[0][q][e]) + bfhi(hv[e]) * bfhi(w[0][q][e]); a1 += bflo(hv[e]) * bflo(w[1][q][e]) + bfhi(hv[e]) * bfhi(w[1][q][e]); } }
        a0 = wave_sum(a0); a1 = wave_sum(a1);
        if (lane < 2) PN[b * 1024 + ch0 + lane] = lane ? a1 : a0;
    }
}

__global__ void __launch_bounds__(NWAVES * 64, 2) mega_fwd(MArgs args) {
    extern __shared__ __attribute__((aligned(16))) unsigned char lds_raw[];
    Frame F;
    F.lds = (LAS unsigned char*)lds_raw;
    F.MISC = (volatile LAS unsigned*)(F.lds + MISC_OFF);
    F.tid = threadIdx.x; F.lane = F.tid & 63; F.wave = __builtin_amdgcn_readfirstlane(F.tid >> 6);
    F.G = gridDim.x; { const int bx = blockIdx.x; F.vcu = (F.G % 8 == 0) ? (bx % 8) * (F.G / 8) + bx / 8 : bx; }
    unsigned char* ws = args.ws; unsigned char* dob = (unsigned char*)args.out;
    F.ctl = (unsigned*)(ws + WS_CTL);
    const float* x = args.in[0]; const float* c = args.in[1]; const float* ctx = args.in[2]; const float* cctx = args.in[3];
    const float* wmod = args.in[4]; const float* bmod = args.in[5]; const float* win = args.in[6];
    const float* qg = args.in[7]; const float* kg = args.in[8]; const float* rpb = args.in[9];
    float* shiftp = (float*)(ws + WS_ROPE + 65536);
    const float* wf = args.in[10]; const float* wa = args.in[11]; const float* wo = args.in[12];
    bf16_t* Wfa_t = (bf16_t*)(ws + WS_WFA); bf16_t* Wo_t = (bf16_t*)(ws + WS_WO); bf16_t* DFTA = (bf16_t*)(ws + WS_DFTA); bf16_t* CS = (bf16_t*)(ws + WS_CS);
    bf16_t* WPQ = (bf16_t*)(ws + WS_WPQ); bf16_t* HEO = (bf16_t*)(ws + WS_HEO); bf16_t* PQT = (bf16_t*)(ws + WS_PQT); float* PN = (float*)(ws + WS_PN);
    float* mod = (float*)(ws + WS_MOD); float2* rope = (float2*)(ws + WS_ROPE);
    bf16_t* H = (bf16_t*)(dob + DO_H); bf16_t* Win_t = (bf16_t*)(dob + DO_WIN); bf16_t* Wuf = (bf16_t*)(dob + DO_WUF);
    for (int u = F.tid; u < (LDS_BYTES - LDSCTL_OFF) / 4; u += NWAVES * 64) ((LAS unsigned*)(F.lds + LDSCTL_OFF))[u] = 0u;
    __syncthreads();
    XcdBarrier bar = xcd_barrier_post(F.ctl + CW_BAR + args.li * XCD_BAR_WORDS, F.MISC + 8);
    const int lo = args.ph_lo, hi = args.ph_hi;
#define IN(k) (lo <= (k) && (k) < hi)
#define BOTH(k) (IN(k) && IN((k) + 1))

    if (IN(0)) {
        for (int it = F.vcu; it < 384; it += F.G) p0_mod_item(c, cctx, wmod, bmod, mod, F.lds, it, F.wave, F.lane);
        for (int it = F.wave * F.G + F.vcu; it < 33 + 2048 + 2048; it += F.G * NWAVES) {
            if (it < 33 + 2048) p0_table_item(rope, CS, DFTA, qg, kg, rpb, shiftp, it, F.lane); else p0_wuf_row(win, Wuf, it - (33 + 2048), F.lane); }
        {   constexpr int I_WIN = 32 * 26, I_WO = 32 * 4, I_WA = 32 * 4, I_WF = 16 * 4, NIT = I_WIN + I_WO + I_WA + I_WF;
            auto item = [&](int wi) { CopyItem ci; int r = wi;
                if (r < I_WIN) { ci = CopyItem{win, Win_t, INW, D, 0, (r & 31) * 64, 1024 + (r >> 5) * 512}; return ci; } r -= I_WIN;
                if (r < I_WO) { ci = CopyItem{wo, Wo_t, D, D, 0, (r & 31) * 64, (r >> 5) * 512}; return ci; } r -= I_WO;
                if (r < I_WA) { ci = CopyItem{wa, Wfa_t, D, 3072, 1024, (r & 31) * 64, (r >> 5) * 512}; return ci; } r -= I_WA;
                ci = CopyItem{wf, Wfa_t, D, 3072, 0, (r & 15) * 64, (r >> 4) * 512}; return ci; };
            f32x4 va[8][2], vb[8][2];
            int wi = F.vcu;
            if (wi < NIT) p0_copy_load(item(wi), F.wave, F.lane, va);
#pragma unroll 1
            for (; wi < NIT; wi += F.G) {
                const int wn = wi + F.G;
                if (wn < NIT) p0_copy_load(item(wn), F.wave, F.lane, vb);
                p0_copy_finish(item(wi), F.lds, F.wave, F.lane, va);
#pragma unroll
                for (int r = 0; r < 8; ++r) { va[r][0] = vb[r][0]; va[r][1] = vb[r][1]; }
            } }
        if (BOTH(0)) xcd_barrier(bar);
    }
    if (IN(1)) {
        {   pg8::Gemm g{CS, Wuf, 256, FW};
            SchedFold Sc{F.G, F.vcu};
            EpiTile E{WPQ, (long)D, 0};
            pg8::gemm_phase<EpiTile, SchedFold>(F.lds, g, Sc, E); }
        const int gw = F.vcu * NWAVES + F.wave, NGW = F.G * NWAVES;
        {   f32x4 ra[8], rb[8], na[8], nb[8];
            int it = gw;
            if (it < NB * 1024) p1_pair_load(x + (size_t)(it >> 10) * S * D, it & 1023, F.lane, ra, rb);
#pragma unroll 1
            for (; it < NB * 1024; it += NGW) {
                const int itn = it + NGW, b = it >> 10, n = it & 1023;
                if (itn < NB * 1024) p1_pair_load(x + (size_t)(itn >> 10) * S * D, itn & 1023, F.lane, na, nb);
                p1_pair_finish(ra, rb, mod + (size_t)b * 3 * D, mod + (size_t)b * 3 * D + D, H + (size_t)b * S * D, HEO + (size_t)b * S * D, n, F.lane);
#pragma unroll
                for (int j = 0; j < 8; ++j) { ra[j] = na[j]; rb[j] = nb[j]; }
            } }
        for (int r2 = gw; r2 < NB * L; r2 += NGW) p1_hnorm_row(ctx + (size_t)r2 * D, mod + (size_t)8 * 3 * D, mod + (size_t)8 * 3 * D + D, H + (size_t)(NB * S + r2) * D, F.lane);
        if (BOTH(1)) xcd_barrier(bar);
    }
    if (IN(2)) {
        for (int it = F.wave * F.G + F.vcu; it < 512; it += F.G * NWAVES) p3_pn_item(H, WPQ, PN, it, F.lane);
        {
            pg8::Gemm g{WPQ, HEO, D, D};
            SchedUft Sc{F.G, F.vcu};
            EpiTile E{PQT, (long)D, 1};
            pg8::gemm_phase<EpiTile, SchedUft>(F.lds, g, Sc, E);
            xcd_barrier(bar);
        }
        pg8::Gemm g{H, Win_t, D, D};
        SchedInproj Sc{F.G, (int)blockIdx.x};
        EpiInproj E{ws, qg, kg, rope};
        pg8::gemm_phase<EpiInproj, SchedInproj>(F.lds, g, Sc, E);
        if (BOTH(2)) xcd_barrier(bar);
    }
    if (IN(3)) {
        natt::Tensors AT{(const bf16_t*)(ws + WS_Q), (bf16_t*)(ws + WS_Q), (const bf16_t*)(ws + WS_K), (const bf16_t*)(ws + WS_V), (const bf16_t*)(ws + WS_KC), (const bf16_t*)(ws + WS_VC), (const bf16_t*)(ws + WS_SZA), rpb, shiftp};
        natt::attn_phase(F.lds, AT, F.vcu);
        pg8::Gemm g{DFTA, PQT, D, D};
        SchedPos Sc{F.G, F.vcu};
        EpiPos E{(const bf16_t*)(ws + WS_ZFC), (bf16_t*)(dob + DO_MF), PN};
        pg8::gemm_phase<EpiPos, SchedPos>(F.lds, g, Sc, E);
        if (BOTH(3)) xcd_barrier(bar);
    }
    if (IN(4)) {
        pg8::Gemm g{(const bf16_t*)(dob + DO_MF), Wfa_t, D, 3072};
        SchedY Sc{F.G, (int)blockIdx.x, (long)((ws + WS_Q) - (dob + DO_MF))};
        EpiY E{(bf16_t*)(ws + WS_SGF), (const bf16_t*)(ws + WS_SGA)};
        pg8::gemm_phase<EpiY, SchedY>(F.lds, g, Sc, E);
        if (BOTH(4)) xcd_barrier(bar);
    }
    if (IN(5)) {
        pg8::Gemm g{(const bf16_t*)(ws + WS_SGF), Wo_t, D, D};
        SchedRows Sc{F.G, (int)blockIdx.x};
        EpiOut E{x, mod, args.out};
        pg8::gemm_phase<EpiOut, SchedRows>(F.lds, g, Sc, E);
    }
#undef IN
#undef BOTH
}

extern "C" void kernel_launch(void* const* d_in, const int* in_sizes, int n_in, void* d_out, int out_size, void* d_ws, size_t ws_size, hipStream_t stream) {
    unsigned char* ws = (unsigned char*)d_ws;
    if (ws_size < WS_END || n_in != 13) return;
    static int grid = 0;
    if (grid == 0) {
        int dev = 0, cus = 0, per_cu = 0;
        if (hipGetDevice(&dev) != hipSuccess || hipDeviceGetAttribute(&cus, hipDeviceAttributeMultiprocessorCount, dev) != hipSuccess) { grid = -1; return; }
        if (hipFuncSetAttribute((const void*)mega_fwd, hipFuncAttributeMaxDynamicSharedMemorySize, LDS_BYTES) != hipSuccess) { grid = -1; return; }
        if (hipOccupancyMaxActiveBlocksPerMultiprocessor(&per_cu, (const void*)mega_fwd, NWAVES * 64, LDS_BYTES) != hipSuccess || per_cu < 1) { fprintf(stderr, "occupancy query: %d\n", per_cu); grid = -1; return; }
        (void)hipGetLastError();
        grid = cus;
    }
    if (grid != 256) return;
    (void)hipMemsetAsync(ws + WS_CTL, 0, 1 * MiB, stream);
    MArgs a; memset(&a, 0, sizeof(a));
    for (int i = 0; i < 13; ++i) a.in[i] = (const float*)d_in[i];
    a.out = (float*)d_out; a.ws = ws;
    a.ph_lo = 0; a.ph_hi = 6; a.li = 0;
    hipLaunchKernelGGL(mega_fwd, dim3(grid), dim3(NWAVES * 64), LDS_BYTES, stream, a);
}
```

```cpp
#include <hip/hip_runtime.h>
#include <stdint.h>
#include <string.h>

typedef unsigned short bf16_t;
typedef short bf16x8 __attribute__((ext_vector_type(8)));
typedef float f32x4 __attribute__((ext_vector_type(4)));
typedef unsigned u32x4 __attribute__((ext_vector_type(4)));
typedef unsigned u32x2 __attribute__((ext_vector_type(2)));

constexpr int D = 2048, NB = 8, S = 2048, L = 256, NH = 16, HD = 128, FW = 1024, INW = 14336;
constexpr int OFF_ZF = 1024, OFF_Q = 2048, OFF_K = 4096, OFF_V = 6144, OFF_ZA = 8192, OFF_GF = 10240, OFF_GA = 12288;
constexpr size_t MiB = 1u << 20;
constexpr float QSCALE = 0.08838834764831845f * 1.4426950408889634f;
constexpr size_t WS_ZFC = 0, WS_PQT = 32 * MiB, WS_Q = 64 * MiB, WS_HEO = 64 * MiB, WS_K = 128 * MiB, WS_V = 192 * MiB, WS_SZA = 256 * MiB, WS_SGF = 320 * MiB, WS_SGA = 384 * MiB,
                 WS_KC = 448 * MiB, WS_VC = 456 * MiB, WS_WFA = 464 * MiB, WS_WO = 476 * MiB, WS_DFTA = 484 * MiB, WS_WPQ = 492 * MiB,
                 WS_CTL = 500 * MiB, WS_MOD = 501 * MiB, WS_ROPE = 502 * MiB, WS_CS = 503 * MiB, WS_PN = 504 * MiB, WS_END = 512 * MiB;
constexpr size_t DO_H = 0, DO_HC = 64 * MiB, DO_WIN = 72 * MiB, DO_WUF = 72 * MiB, DO_MF = 0;

__device__ __forceinline__ unsigned f2bf(float f) { unsigned u = __float_as_uint(f); return (u + 0x7fffu + ((u >> 16) & 1u)) >> 16; }
__device__ __forceinline__ float bf2f(unsigned h) { return __uint_as_float(h << 16); }
__device__ __forceinline__ float silu_f(float z) { return z / (1.0f + expf(-z)); }
__device__ __forceinline__ float sigm_f(float z) { return 1.0f / (1.0f + expf(-z)); }
__device__ __forceinline__ float wave_sum(float v) {
#pragma unroll
    for (int o = 1; o < 64; o <<= 1) v += __shfl_xor(v, o);
    return v;
}
__device__ __forceinline__ float wave_max(float v) {
#pragma unroll
    for (int o = 1; o < 64; o <<= 1) v = fmaxf(v, __shfl_xor(v, o));
    return v;
}

#define LAS __attribute__((address_space(3)))
#define GAS __attribute__((address_space(1)))
typedef GAS unsigned gu32;
#define RLX_AGENT __ATOMIC_RELAXED, __HIP_MEMORY_SCOPE_AGENT
#define LDS_WAIT() asm volatile("s_waitcnt lgkmcnt(0)" ::: "memory")
#define VM_WAIT() asm volatile("s_waitcnt vmcnt(0)" ::: "memory")
constexpr int NWAVES = 8;
constexpr int RING_BYTES = 131072, LDSCTL_OFF = RING_BYTES, MISC_OFF = LDSCTL_OFF + 320, XCH_OFF = LDSCTL_OFF + 1024, STG_OFF = XCH_OFF + 4096, LDS_BYTES = 163840;
constexpr int CW_BAR = 4096;

#define XB_TMO      128
#define XB_XCNT(j)  (256  + 64 * (j))
#define XB_XSUB(j)  (1280 + 64 * (j))
#define XB_XGEN(j)  (2304 + 64 * (j))
#define XB_TOP      3328
#define XB_TOPGEN   3392
#define XCD_BAR_WORDS 3456
#define XB_SPIN_CAP (1u << 18)
__device__ __forceinline__ unsigned xb_ld(unsigned* p)              { return __hip_atomic_load(p, __ATOMIC_RELAXED, __HIP_MEMORY_SCOPE_AGENT); }
__device__ __forceinline__ unsigned xb_add(unsigned* p, unsigned v) { return __hip_atomic_fetch_add(p, v, __ATOMIC_RELAXED, __HIP_MEMORY_SCOPE_AGENT); }
__device__ __forceinline__ unsigned xb_xcc_id() { return (unsigned)__builtin_amdgcn_s_getreg((3 << 11) | 20) & 0xFu; }
#define XB_SPIN(cond, bar) do { unsigned _sp = 0; while (cond) { __builtin_amdgcn_s_sleep(1); \
    if ((++_sp & 255u) == 0u) { if (xb_ld(&(bar)[XB_TMO])) break; if (_sp > XB_SPIN_CAP) { atomicAdd(&(bar)[XB_TMO], 1u); break; } } } } while (0)
struct XcdBarrier { unsigned* bar; unsigned x; volatile LAS unsigned* st; };
__device__ __forceinline__ XcdBarrier xcd_barrier_post(unsigned* bar, volatile LAS unsigned* st) {
    XcdBarrier b; b.bar = bar; b.x = xb_xcc_id(); b.st = st;
    if (threadIdx.x == 0) (void)xb_add(&bar[XB_XCNT(b.x)], 1u);
    return b;
}
__device__ __forceinline__ void xcd_barrier_complete(unsigned* bar, unsigned x, unsigned& nloc, unsigned& nx) {
    const unsigned G = gridDim.x * gridDim.y * gridDim.z;
    unsigned sum, cnt, mine, sp = 0u;
    for (;;) {
        sum = 0u; cnt = 0u; mine = 0u;
#pragma unroll
        for (unsigned j = 0; j < 16; ++j) { const unsigned c = xb_ld(&bar[XB_XCNT(j)]); sum += c; cnt += (c > 0u) ? 1u : 0u; mine = (j == x) ? c : mine; }
        if (sum == G) break;
        __builtin_amdgcn_s_sleep(1);
        if ((++sp & 255u) == 0u) { if (xb_ld(&bar[XB_TMO])) break; if (sp > XB_SPIN_CAP) { atomicAdd(&bar[XB_TMO], 1u); break; } }
    }
    nloc = mine > 0u ? mine : 1u; nx = cnt > 0u ? cnt : 1u;
}
__device__ __forceinline__ void xcd_barrier(const XcdBarrier& b) {
    asm volatile("s_waitcnt vmcnt(0)" ::: "memory");
    __syncthreads();
    if (threadIdx.x == 0) {
        unsigned* bar = b.bar;
        __builtin_amdgcn_s_waitcnt(0);
        unsigned nloc = b.st[0], nx = b.st[1];
        if (nloc == 0u) { xcd_barrier_complete(bar, b.x, nloc, nx); b.st[0] = nloc; b.st[1] = nx; }
        const unsigned old = xb_add(&bar[XB_XSUB(b.x)], 1u);
        const unsigned gen = old / nloc;
        if (old + 1u == (gen + 1u) * nloc) {
            __builtin_amdgcn_fence(__ATOMIC_RELEASE, "agent");
            asm volatile("s_waitcnt vmcnt(0)" ::: "memory");
            const unsigned og = xb_add(&bar[XB_TOP], 1u);
            const unsigned tg = og / nx;
            if (og + 1u == (tg + 1u) * nx) xb_add(&bar[XB_TOPGEN], 1u);
            else XB_SPIN(xb_ld(&bar[XB_TOPGEN]) == tg, bar);
            __builtin_amdgcn_fence(__ATOMIC_ACQUIRE, "agent");
            xb_add(&bar[XB_XGEN(b.x)], 1u);
            asm volatile("s_waitcnt vmcnt(0)" ::: "memory");
        } else {
            XB_SPIN(xb_ld(&bar[XB_XGEN(b.x)]) == gen, bar);
            __builtin_amdgcn_fence(__ATOMIC_ACQUIRE, "agent");
            asm volatile("s_waitcnt vmcnt(0)" ::: "memory");
        }
    }
    __syncthreads();
}

namespace pg8 {
constexpr int BM = 256, BK = 64, HALF = 128, HTB = HALF * BK * 2, STAGE_BYTES = 8 * HTB;
__host__ __device__ __forceinline__ int lds_byte(int r, int c) { const int st = (r >> 4) * 2 + (c >> 5), rr = r & 15, cc = c & 31, ob = rr * 64 + cc * 2; return st * 1024 + (ob ^ (((ob >> 9) & 1) << 5)); }
__host__ __device__ __forceinline__ void stage_rc(int b, int& R, int& C) { const int st = b / 1024, sb = b % 1024, swz = sb ^ (((sb >> 9) & 1) << 5); R = (st >> 1) * 16 + swz / 64; C = (st & 1) * 32 + (swz % 64) / 2; }
__host__ __device__ __forceinline__ int perm32(int rho) { const int n = rho >> 4, i = rho & 15; return 8 * (i >> 2) + 4 * n + (i & 3); }
struct Unit { int pm, pn, x0, x1, nt, keep; long aoff, boff; };
struct Gemm { const bf16_t* A; const bf16_t* Bt; int lda, ldb; };
__device__ __forceinline__ unsigned cvt_pk_bf16(float lo, float hi) { unsigned r; asm volatile("v_cvt_pk_bf16_f32 %0, %1, %2" : "=v"(r) : "v"(lo), "v"(hi)); return r; }

template <class Epi, class Sched>
__device__ __forceinline__ void gemm_phase(LAS unsigned char* lds, const Gemm g, const Sched& S, const Epi& E, unsigned delay_ticks = 0) {
    int tid = threadIdx.x; asm volatile("" : "+v"(tid));
    const int wid = __builtin_amdgcn_readfirstlane(tid >> 6), lane = tid & 63, wr = wid >> 2, wc = wid & 3, fr = lane & 15, fq = lane >> 4;
    unsigned voffA[2], voffB[2];
#pragma unroll
    for (int i = 0; i < 2; ++i) { int R, C; stage_rc(tid * 16 + i * 8192, R, C); const int Rb = 64 * (R >> 5) + perm32(R & 31);
        voffA[i] = (unsigned)(R * g.lda + C) * 2u; voffB[i] = (unsigned)(Rb * g.ldb + C) * 2u; }
    const size_t kstep = (size_t)(BK * 2);
    const size_t hstepA = (size_t)HALF * g.lda * 2, hstepB = (size_t)32 * g.ldb * 2;
    const unsigned ldsw = (unsigned)wid * 1024u;
    const int aoff = lds_byte(wr * 64 + fr, fq * 8), boff = lds_byte(wc * 32 + fr, fq * 8);
#define PG8_SA(b, h) (((b) * 2 + (h)) * HTB)
#define PG8_SB(b, h) ((4 + (b) * 2 + (h)) * HTB)
#define PG8_STAGE(bufoff, gbase, voff) do { _Pragma("unroll") for (int _i = 0; _i < 2; ++_i) \
        __builtin_amdgcn_global_load_lds((const unsigned*)((const char*)(gbase) + (voff)[_i]), (LAS unsigned*)(lds + (bufoff) + ldsw + _i * 8192), 16, 0, 0); } while (0)
#define PG8_LDA(dst, b, h) do { _Pragma("unroll") for (int m = 0; m < 4; ++m) _Pragma("unroll") for (int k = 0; k < 2; ++k) dst[m][k] = *(const LAS bf16x8*)(lds + PG8_SA(b, h) + aoff + m * 2048 + k * 1024); } while (0)
#define PG8_LDB(dst, b, h) do { _Pragma("unroll") for (int n = 0; n < 2; ++n) _Pragma("unroll") for (int k = 0; k < 2; ++k) dst[n][k] = *(const LAS bf16x8*)(lds + PG8_SB(b, h) + boff + n * 2048 + k * 1024); } while (0)
#define PG8_MMA(ai, bj, At, Bt) do { __builtin_amdgcn_s_setprio(1); _Pragma("unroll") for (int m = 0; m < 4; ++m) _Pragma("unroll") for (int n = 0; n < 2; ++n) _Pragma("unroll") for (int k = 0; k < 2; ++k) \
        acc[ai][bj][m][n] = __builtin_amdgcn_mfma_f32_16x16x32_bf16(Bt[n][k], At[m][k], acc[ai][bj][m][n], 0, 0, 0); __builtin_amdgcn_s_setprio(0); } while (0)
#define PG8_WAIT_V(n) asm volatile("s_waitcnt vmcnt(" #n ")" ::: "memory")
#define PG8_WAIT_L(n) asm volatile("s_waitcnt lgkmcnt(" #n ")" ::: "memory")
#define PG8_BAR __builtin_amdgcn_s_barrier()
#define PG8_SCHED __builtin_amdgcn_sched_barrier(0)
    Unit cur, nxt; int ui = 0;
    if (!S.next(0, cur)) return;
    if (delay_ticks) { const unsigned long long t0 = __builtin_amdgcn_s_memrealtime(); while (__builtin_amdgcn_s_memrealtime() - t0 < delay_ticks) __builtin_amdgcn_s_sleep(8); }
    f32x4 acc[2][2][4][2];
#pragma unroll
    for (int a = 0; a < 2; ++a)
#pragma unroll
        for (int b = 0; b < 2; ++b)
#pragma unroll
            for (int m = 0; m < 4; ++m)
#pragma unroll
                for (int n = 0; n < 2; ++n) acc[a][b][m][n] = (f32x4){0.f, 0.f, 0.f, 0.f};
    bf16x8 At[4][2], B0[2][2], B1[2][2];
    const char* cA = (const char*)g.A + cur.aoff; const char* cB = (const char*)g.Bt + cur.boff;
    PG8_STAGE(PG8_SB(0, 0), cB, voffB); PG8_STAGE(PG8_SB(0, 1), cB + hstepB, voffB); PG8_STAGE(PG8_SA(0, 0), cA, voffA); PG8_STAGE(PG8_SA(0, 1), cA + hstepA, voffA);
    if (wr == 1) PG8_BAR;
    PG8_WAIT_V(2); PG8_BAR;
    PG8_STAGE(PG8_SB(1, 0), cB + kstep, voffB); PG8_STAGE(PG8_SA(1, 0), cA + kstep, voffA); PG8_STAGE(PG8_SB(1, 1), cB + hstepB + kstep, voffB);
    PG8_WAIT_V(6); PG8_BAR;
    for (;;) {
        const bool has_next = S.next(ui + 1, nxt);
        const char* nA = has_next ? (const char*)g.A + nxt.aoff : cA; const char* nB = has_next ? (const char*)g.Bt + nxt.boff : cB;
        int nt = cur.nt; asm volatile("" : "+s"(nt));
        for (int t = 0; t < nt; t += 2) {
            const bool last = (t == nt - 2);
            const char* a1 = cA + (size_t)(t + 1) * kstep;
            const char* a2 = last ? nA : cA + (size_t)(t + 2) * kstep; const char* b2 = last ? nB : cB + (size_t)(t + 2) * kstep;
            const char* a3 = a2 + kstep; const char* b3 = b2 + kstep;
            PG8_LDB(B0, 0, 0); PG8_LDB(B1, 0, 1); PG8_SCHED; PG8_LDA(At, 0, 0); PG8_STAGE(PG8_SA(1, 1), a1 + hstepA, voffA);
            PG8_WAIT_V(8); PG8_WAIT_L(0); PG8_BAR; PG8_MMA(0, 0, At, B0); PG8_MMA(0, 1, At, B1); PG8_BAR; PG8_SCHED;
            PG8_LDA(At, 0, 1); PG8_STAGE(PG8_SB(0, 0), b2, voffB); PG8_STAGE(PG8_SB(0, 1), b2 + hstepB, voffB); PG8_STAGE(PG8_SA(0, 0), a2, voffA);
            PG8_WAIT_V(8); PG8_WAIT_L(0); PG8_BAR; PG8_MMA(1, 0, At, B0); PG8_MMA(1, 1, At, B1); PG8_BAR; PG8_SCHED;
            PG8_LDB(B0, 1, 0); PG8_LDB(B1, 1, 1); PG8_SCHED; PG8_LDA(At, 1, 0); PG8_STAGE(PG8_SA(0, 1), a2 + hstepA, voffA);
            PG8_WAIT_V(8); PG8_WAIT_L(0); PG8_BAR; PG8_MMA(0, 0, At, B0); PG8_MMA(0, 1, At, B1); PG8_BAR; PG8_SCHED;
            PG8_LDA(At, 1, 1); PG8_STAGE(PG8_SB(1, 0), b3, voffB); PG8_STAGE(PG8_SB(1, 1), b3 + hstepB, voffB); PG8_STAGE(PG8_SA(1, 0), a3, voffA);
            PG8_WAIT_V(8); PG8_WAIT_L(0); PG8_BAR; PG8_MMA(1, 0, At, B0); PG8_MMA(1, 1, At, B1); PG8_BAR; PG8_SCHED;
        }
        if (wr == 0) PG8_BAR;
        E(acc, cur, wr, wc, fr, fq, lds, wid, lane);
        if (!has_next) break;
        if (!cur.keep) {
#pragma unroll
        for (int a = 0; a < 2; ++a)
#pragma unroll
            for (int b = 0; b < 2; ++b)
#pragma unroll
                for (int m = 0; m < 4; ++m)
#pragma unroll
                    for (int n = 0; n < 2; ++n) acc[a][b][m][n] = (f32x4){0.f, 0.f, 0.f, 0.f};
        }
        cur = nxt; cA = nA; cB = nB; ++ui;
        if (wr == 1) PG8_BAR;
    }
    PG8_WAIT_V(0);
    PG8_BAR;
#undef PG8_SA
#undef PG8_SB
#undef PG8_STAGE
#undef PG8_LDA
#undef PG8_LDB
#undef PG8_MMA
#undef PG8_WAIT_V
#undef PG8_WAIT_L
#undef PG8_BAR
#undef PG8_SCHED
}
}

__device__ __forceinline__ float fast_sigm(float z) { return __builtin_amdgcn_rcpf(1.0f + __builtin_amdgcn_exp2f(-1.4426950408889634f * z)); }
__device__ __forceinline__ float fast_silu(float z) { return z * fast_sigm(z); }


template <bool F32 = false>
__device__ __forceinline__ void store_rows(LAS unsigned char* scr, unsigned char* g0  , size_t row_bytes, int lane, u32x4 p0, u32x4 p1) {
    const int fr = lane & 15, fq = lane >> 4;
    *(LAS u32x4*)(scr + fr * 144 + (F32 ? 32 * fq : 16 * fq)) = p0; *(LAS u32x4*)(scr + fr * 144 + (F32 ? 32 * fq + 16 : 64 + 16 * fq)) = p1;
    const int ro = lane >> 3, pi = lane & 7;
    const u32x4 a = *(const LAS u32x4*)(scr + ro * 144 + pi * 16), b = *(const LAS u32x4*)(scr + (8 + ro) * 144 + pi * 16);
    *(u32x4*)(g0 + (size_t)ro * row_bytes + pi * 16) = a; *(u32x4*)(g0 + (size_t)(8 + ro) * row_bytes + pi * 16) = b;
}
struct RowLd { u32x4 a, b; };
__device__ __forceinline__ RowLd rows_issue(const unsigned char* g0, size_t row_bytes, int lane) {
    const int ro = lane >> 3, pi = lane & 7; RowLd r;
    r.a = *(const u32x4*)(g0 + (size_t)ro * row_bytes + pi * 16); r.b = *(const u32x4*)(g0 + (size_t)(8 + ro) * row_bytes + pi * 16); return r;
}
template <bool F32 = false>
__device__ __forceinline__ void rows_spread(LAS unsigned char* scr, int lane, const RowLd& r, u32x4& p0, u32x4& p1) {
    const int fr = lane & 15, fq = lane >> 4, ro = lane >> 3, pi = lane & 7;
    *(LAS u32x4*)(scr + ro * 144 + pi * 16) = r.a; *(LAS u32x4*)(scr + (8 + ro) * 144 + pi * 16) = r.b;
    p0 = *(const LAS u32x4*)(scr + fr * 144 + (F32 ? 32 * fq : 16 * fq)); p1 = *(const LAS u32x4*)(scr + fr * 144 + (F32 ? 32 * fq + 16 : 64 + 16 * fq));
}
struct SchedInproj {
    int G, c;
    __device__ __forceinline__ bool next(int i, pg8::Unit& u) const {
        const long L = (long)i * G + c; if (L >= 3456) return false;
        if (L < 3328) { const int xcd = c & 7, j = c >> 3, g = j >> 4, jj = j & 15;
            u.pm = 8 * xcd + 4 * g + (jj & 3); u.pn = g ? (55 - 4 * i - (jj >> 2)) : (4 + 4 * i + (jj >> 2)); }
        else { const int q = (int)L - 3328; u.pm = 64 + (q & 7); u.pn = 16 + (q >> 3); }
        u.x0 = 0; u.x1 = 0; u.nt = D / 64; u.keep = 0; u.aoff = (long)u.pm * 256 * D * 2; u.boff = (long)u.pn * 256 * D * 2; return true;
    }
};
struct EpiInproj {
    unsigned char* ws; const float* qg; const float* kg; const float2* rope;
    __device__ __forceinline__ void operator()(f32x4 (&acc)[2][2][4][2], const pg8::Unit& u, int wr, int wc, int fr, int fq, LAS unsigned char* lds, int wid, int lane) const {
        const bool isctx = u.pm >= 64;
        const int blk = u.pn >> 3;
        const int act = (blk == 0) ? 1 : (blk == 1 || blk == 2) ? 3 : (blk == 3) ? 0 : (blk == 4) ? 1 : 2;
        bf16_t* dst; int row0; int ldd = D;
        if (!isctx) { dst = (bf16_t*)(ws + (size_t)blk * 64 * MiB); row0 = u.pm * 256; if (blk == 0) { dst = (bf16_t*)(ws + WS_ZFC); ldd = FW; } }
        else { dst = (bf16_t*)(ws + (blk == 2 ? WS_KC : WS_VC)); row0 = (u.pm - 64) * 256; }
        const int colw = (blk == 0 ? (u.pn - 4) : (u.pn & 7)) * 256 + wc * 64;
        if (act != 3) {
#pragma unroll
            for (int ai = 0; ai < 2; ++ai)
#pragma unroll
                for (int m = 0; m < 4; ++m) {
                    u32x4 w[2];
#pragma unroll
                    for (int bj = 0; bj < 2; ++bj) {
                        f32x4 v0 = acc[ai][bj][m][0], v1 = acc[ai][bj][m][1];
                        if (act == 1) { v0[0] = fast_silu(v0[0]); v0[1] = fast_silu(v0[1]); v0[2] = fast_silu(v0[2]); v0[3] = fast_silu(v0[3]); v1[0] = fast_silu(v1[0]); v1[1] = fast_silu(v1[1]); v1[2] = fast_silu(v1[2]); v1[3] = fast_silu(v1[3]); }
                        else if (act == 2) { v0[0] = fast_sigm(v0[0]); v0[1] = fast_sigm(v0[1]); v0[2] = fast_sigm(v0[2]); v0[3] = fast_sigm(v0[3]); v1[0] = fast_sigm(v1[0]); v1[1] = fast_sigm(v1[1]); v1[2] = fast_sigm(v1[2]); v1[3] = fast_sigm(v1[3]); }
                        w[bj][0] = pg8::cvt_pk_bf16(v0[0], v0[1]); w[bj][1] = pg8::cvt_pk_bf16(v0[2], v0[3]); w[bj][2] = pg8::cvt_pk_bf16(v1[0], v1[1]); w[bj][3] = pg8::cvt_pk_bf16(v1[2], v1[3]);
                    }
                    store_rows(lds + STG_OFF + wid * 2304, (unsigned char*)(dst + (size_t)(row0 + ai * 128 + wr * 64 + m * 16) * ldd + colw), (size_t)ldd * 2, lane, w[0], w[1]);
                }
            return;
        }
        LAS float* X = (LAS float*)(lds + XCH_OFF);
#pragma unroll
        for (int ai = 0; ai < 2; ++ai)
#pragma unroll
            for (int m = 0; m < 4; ++m) {
                float ss = 0.f;
#pragma unroll
                for (int bj = 0; bj < 2; ++bj)
#pragma unroll
                    for (int n = 0; n < 2; ++n) { const f32x4 v = acc[ai][bj][m][n]; ss += (v[0] * v[0] + v[1] * v[1]) + (v[2] * v[2] + v[3] * v[3]); }
                ss += __shfl_xor(ss, 16); ss += __shfl_xor(ss, 32);
                if (fq == 0) X[wid * 128 + ai * 64 + m * 16 + fr] = ss;
            }
        asm volatile("s_waitcnt lgkmcnt(0)" ::: "memory"); __builtin_amdgcn_s_barrier(); asm volatile("" ::: "memory");
        const int ax = wc & 1;
        const float* gain = (blk == 1 ? qg : kg) + ax * 64 + 8 * fq;
        const f32x4 g00 = *(const f32x4*)(gain), g01 = *(const f32x4*)(gain + 4), g10 = *(const f32x4*)(gain + 32), g11 = *(const f32x4*)(gain + 36);
        const float post = (blk == 1) ? QSCALE : 1.0f;
#pragma unroll
        for (int ai = 0; ai < 2; ++ai)
#pragma unroll
            for (int m = 0; m < 4; ++m) {
                const int ridx = ai * 64 + m * 16 + fr;
                const float tot = X[wid * 128 + ridx] + X[(wid ^ 1) * 128 + ridx];
                const float rs = post / sqrtf(tot * (1.0f / HD) + 1e-6f);
                f32x4 x0a = acc[ai][0][m][0] * g00 * rs, x0b = acc[ai][0][m][1] * g01 * rs, x1a = acc[ai][1][m][0] * g10 * rs, x1b = acc[ai][1][m][1] * g11 * rs;
                if (!isctx) {
                    const int t = (row0 + ai * 128 + wr * 64 + m * 16 + fr) & (S - 1);
                    const int pos = ax ? (t & 63) : (t >> 6);
                    const f32x4* rp = (const f32x4*)(rope + pos * 32 + 8 * fq);
                    const f32x4 c0 = rp[0], c1 = rp[1], c2 = rp[2], c3 = rp[3];
                    f32x4 y0a, y0b, y1a, y1b;
                    y0a[0] = x0a[0] * c0[0] - x1a[0] * c0[1]; y1a[0] = x1a[0] * c0[0] + x0a[0] * c0[1];
                    y0a[1] = x0a[1] * c0[2] - x1a[1] * c0[3]; y1a[1] = x1a[1] * c0[2] + x0a[1] * c0[3];
                    y0a[2] = x0a[2] * c1[0] - x1a[2] * c1[1]; y1a[2] = x1a[2] * c1[0] + x0a[2] * c1[1];
                    y0a[3] = x0a[3] * c1[2] - x1a[3] * c1[3]; y1a[3] = x1a[3] * c1[2] + x0a[3] * c1[3];
                    y0b[0] = x0b[0] * c2[0] - x1b[0] * c2[1]; y1b[0] = x1b[0] * c2[0] + x0b[0] * c2[1];
                    y0b[1] = x0b[1] * c2[2] - x1b[1] * c2[3]; y1b[1] = x1b[1] * c2[2] + x0b[1] * c2[3];
                    y0b[2] = x0b[2] * c3[0] - x1b[2] * c3[1]; y1b[2] = x1b[2] * c3[0] + x0b[2] * c3[1];
                    y0b[3] = x0b[3] * c3[2] - x1b[3] * c3[3]; y1b[3] = x1b[3] * c3[2] + x0b[3] * c3[3];
                    x0a = y0a; x0b = y0b; x1a = y1a; x1b = y1b;
                }
                u32x4 w0, w1;
                w0[0] = pg8::cvt_pk_bf16(x0a[0], x0a[1]); w0[1] = pg8::cvt_pk_bf16(x0a[2], x0a[3]); w0[2] = pg8::cvt_pk_bf16(x0b[0], x0b[1]); w0[3] = pg8::cvt_pk_bf16(x0b[2], x0b[3]);
                w1[0] = pg8::cvt_pk_bf16(x1a[0], x1a[1]); w1[1] = pg8::cvt_pk_bf16(x1a[2], x1a[3]); w1[2] = pg8::cvt_pk_bf16(x1b[0], x1b[1]); w1[3] = pg8::cvt_pk_bf16(x1b[2], x1b[3]);
                store_rows(lds + STG_OFF + wid * 2304, (unsigned char*)(dst + (size_t)(row0 + ai * 128 + wr * 64 + m * 16) * D + colw), (size_t)D * 2, lane, w0, w1);
            }
    }
};

struct SchedFold {
    int G, c;
    __device__ __forceinline__ bool next(int i, pg8::Unit& u) const {
        const long L = (long)i * G + c; if (L >= 64) return false;
        const int part = (int)(L & 1), g = (int)((L >> 1) & 3), kt = (int)(L >> 3);
        u.pm = part * 4 + g; u.pn = kt; u.x0 = 0; u.x1 = 0; u.nt = 4; u.keep = 0; u.aoff = (long)part * 256 * 256 * 2; u.boff = ((long)kt * 256 * FW + g * 256) * 2; return true;
    }
};
struct SchedUft {
    int G, c;
    __device__ __forceinline__ bool next(int i, pg8::Unit& u) const {
        const long L = (long)i * G + c; if (L >= 256) return false;
        const int b = (int)(L >> 5), ct = (int)((L >> 3) & 3), tt = (int)(L & 7), part = tt >> 2;
        u.pm = ct; u.pn = tt; u.x0 = b; u.x1 = 0; u.nt = D / 64; u.keep = 0;
        u.aoff = (long)(part * 1024 + ct * 256) * D * 2; u.boff = ((long)b * 2048 + tt * 256) * D * 2; return true;
    }
};
struct EpiTile {
    bf16_t* base; long ld; int mode;
    __device__ __forceinline__ void operator()(f32x4 (&acc)[2][2][4][2], const pg8::Unit& u, int wr, int wc, int fr, int fq, LAS unsigned char* lds, int wid, int lane) const {
        const long row0 = (mode == 0) ? (long)u.pm * 256 : (long)u.x0 * 1024 + u.pm * 256;
        bf16_t* p0 = base + (row0 + wr * 64) * ld + u.pn * 256 + wc * 64;
#pragma unroll
        for (int ai = 0; ai < 2; ++ai)
#pragma unroll
            for (int m = 0; m < 4; ++m) {
                u32x4 w[2];
#pragma unroll
                for (int bj = 0; bj < 2; ++bj) { const f32x4 v0 = acc[ai][bj][m][0], v1 = acc[ai][bj][m][1];
                    w[bj][0] = pg8::cvt_pk_bf16(v0[0], v0[1]); w[bj][1] = pg8::cvt_pk_bf16(v0[2], v0[3]); w[bj][2] = pg8::cvt_pk_bf16(v1[0], v1[1]); w[bj][3] = pg8::cvt_pk_bf16(v1[2], v1[3]); }
                store_rows(lds + STG_OFF + wid * 2304, (unsigned char*)(p0 + (long)(ai * 128 + m * 16) * ld), (size_t)ld * 2, lane, w[0], w[1]);
            }
    }
};
struct SchedPos {
    int G, c;
    __device__ __forceinline__ bool next(int i, pg8::Unit& u) const {
        const long L = (long)i * G + c; if (L >= 256) return false;
        const int b = (int)(L >> 5), pm = (int)((L & 31) >> 2), pn = (int)(L & 3);
        u.pm = pm; u.pn = pn; u.x0 = b; u.x1 = 0; u.nt = D / 64; u.keep = 0; u.aoff = (long)pm * 256 * D * 2; u.boff = ((long)b * 1024 + pn * 256) * D * 2; return true;
    }
};
__device__ __forceinline__ float bflo(unsigned w) { return __uint_as_float(w << 16); }
__device__ __forceinline__ float bfhi(unsigned w) { return __uint_as_float(w & 0xffff0000u); }
struct EpiPos {
    const bf16_t* ZFC; bf16_t* MF; const float* PN;
    __device__ __forceinline__ void operator()(f32x4 (&acc)[2][2][4][2], const pg8::Unit& u, int wr, int wc, int fr, int fq, LAS unsigned char* lds, int wid, int lane) const {
        const int col = u.pn * 256 + wc * 64 + 8 * fq;
        const float sg = (fr & 1) ? -0.022097086912079608f : 0.022097086912079608f;
        const float* pn = PN + u.x0 * 1024 + col;
        f32x4 pv[2][2];
#pragma unroll
        for (int bj = 0; bj < 2; ++bj) { pv[bj][0] = *(const f32x4*)(pn + bj * 32) * sg; pv[bj][1] = *(const f32x4*)(pn + bj * 32 + 4) * sg; }
        LAS unsigned char* scr = lds + STG_OFF + wid * 2304;
        const size_t rw = (size_t)u.x0 * S + u.pm * 256 + wr * 64; const int cw = u.pn * 256 + wc * 64;
#define EPP_ROW(g) (rw + (size_t)(((g) >> 2) * 128 + ((g) & 3) * 16))
        RowLd cur = rows_issue((const unsigned char*)(ZFC + EPP_ROW(0) * FW + cw), (size_t)FW * 2, lane), nx1 = rows_issue((const unsigned char*)(ZFC + EPP_ROW(1) * FW + cw), (size_t)FW * 2, lane);
#pragma unroll
        for (int g = 0; g < 8; ++g) {
            RowLd nx2 = cur; if (g + 2 < 8) nx2 = rows_issue((const unsigned char*)(ZFC + EPP_ROW(g + 2) * FW + cw), (size_t)FW * 2, lane);
            const int ai = g >> 2, m = g & 3;
            u32x4 w[2], zz[2]; rows_spread(scr, lane, cur, zz[0], zz[1]);
#pragma unroll
            for (int bj = 0; bj < 2; ++bj) { const f32x4 v0 = acc[ai][bj][m][0] + pv[bj][0], v1 = acc[ai][bj][m][1] + pv[bj][1]; const u32x4 z = zz[bj];
                w[bj][0] = pg8::cvt_pk_bf16(v0[0] * bflo(z[0]), v0[1] * bfhi(z[0])); w[bj][1] = pg8::cvt_pk_bf16(v0[2] * bflo(z[1]), v0[3] * bfhi(z[1]));
                w[bj][2] = pg8::cvt_pk_bf16(v1[0] * bflo(z[2]), v1[1] * bfhi(z[2])); w[bj][3] = pg8::cvt_pk_bf16(v1[2] * bflo(z[3]), v1[3] * bfhi(z[3])); }
            store_rows(scr, (unsigned char*)(MF + EPP_ROW(g) * D + cw), (size_t)D * 2, lane, w[0], w[1]);
            cur = nx1; nx1 = nx2;
        }
#undef EPP_ROW
    }
};
struct SchedRows {
    int G, c;
    __device__ __forceinline__ bool next(int i, pg8::Unit& u) const {
        const long L = (long)i * G + c; if (L >= 512) return false;
        const int xcd = (int)(L & 7), off = (int)(L >> 3);
        u.pm = 8 * xcd + (off & 7); u.pn = off >> 3; u.x0 = 0; u.x1 = 0; u.nt = D / 64; u.keep = 0; u.aoff = (long)u.pm * 256 * D * 2; u.boff = (long)u.pn * 256 * D * 2; return true;
    }
};
struct SchedY {
    int G, c; long a2off;
    __device__ __forceinline__ bool next(int i, pg8::Unit& u) const {
        const int seg = i & 1; const long L = (long)(i >> 1) * G + c; if (L >= 512) return false;
        const int xcd = (int)(L & 7), off = (int)(L >> 3);
        u.pm = 8 * xcd + (off & 7); u.pn = off >> 3; u.x0 = seg; u.x1 = 0; u.nt = seg ? 32 : 16; u.keep = seg ? 0 : 1;
        u.aoff = (long)u.pm * 256 * D * 2 + (seg ? a2off : 0); u.boff = (long)u.pn * 256 * 3072 * 2 + (seg ? 1024 * 2 : 0); return true;
    }
};
struct EpiY {
    bf16_t* SGF; const bf16_t* SGA;
    __device__ __forceinline__ void mid(f32x4 (&acc)[2][2][4][2], const pg8::Unit& u, int wr, int wc, int fr, int fq, LAS unsigned char* lds, int wid, int lane) const {
        LAS unsigned char* scr = lds + STG_OFF + wid * 2304;
        const size_t o0 = (size_t)(u.pm * 256 + wr * 64) * D + u.pn * 256 + wc * 64;
#define EPY_OFF(g) (o0 + (size_t)(((g) >> 2) * 128 + ((g) & 3) * 16) * D)
        RowLd cf = rows_issue((const unsigned char*)(SGF + EPY_OFF(0)), (size_t)D * 2, lane), ca = rows_issue((const unsigned char*)(SGA + EPY_OFF(0)), (size_t)D * 2, lane);
        RowLd nf = rows_issue((const unsigned char*)(SGF + EPY_OFF(1)), (size_t)D * 2, lane), na = rows_issue((const unsigned char*)(SGA + EPY_OFF(1)), (size_t)D * 2, lane);
#pragma unroll
        for (int g = 0; g < 8; ++g) {
            RowLd n2f = cf, n2a = ca; if (g + 2 < 8) { n2f = rows_issue((const unsigned char*)(SGF + EPY_OFF(g + 2)), (size_t)D * 2, lane); n2a = rows_issue((const unsigned char*)(SGA + EPY_OFF(g + 2)), (size_t)D * 2, lane); }
            const int ai = g >> 2, m = g & 3;
            u32x4 gf[2], ga[2]; rows_spread(scr, lane, cf, gf[0], gf[1]); rows_spread(scr, lane, ca, ga[0], ga[1]);
#pragma unroll
            for (int bj = 0; bj < 2; ++bj) {
                f32x4& v0 = acc[ai][bj][m][0]; f32x4& v1 = acc[ai][bj][m][1];
                v0[0] *= bflo(gf[bj][0]) * __builtin_amdgcn_rcpf(bflo(ga[bj][0])); v0[1] *= bfhi(gf[bj][0]) * __builtin_amdgcn_rcpf(bfhi(ga[bj][0]));
                v0[2] *= bflo(gf[bj][1]) * __builtin_amdgcn_rcpf(bflo(ga[bj][1])); v0[3] *= bfhi(gf[bj][1]) * __builtin_amdgcn_rcpf(bfhi(ga[bj][1]));
                v1[0] *= bflo(gf[bj][2]) * __builtin_amdgcn_rcpf(bflo(ga[bj][2])); v1[1] *= bfhi(gf[bj][2]) * __builtin_amdgcn_rcpf(bfhi(ga[bj][2]));
                v1[2] *= bflo(gf[bj][3]) * __builtin_amdgcn_rcpf(bflo(ga[bj][3])); v1[3] *= bfhi(gf[bj][3]) * __builtin_amdgcn_rcpf(bfhi(ga[bj][3]));
            }
            cf = nf; ca = na; nf = n2f; na = n2a;
        }
    }
    __device__ __forceinline__ void operator()(f32x4 (&acc)[2][2][4][2], const pg8::Unit& u, int wr, int wc, int fr, int fq, LAS unsigned char* lds, int wid, int lane) const {
        if (u.x0 == 0) { mid(acc, u, wr, wc, fr, fq, lds, wid, lane); return; }
        LAS unsigned char* scr = lds + STG_OFF + wid * 2304;
        const size_t o0 = (size_t)(u.pm * 256 + wr * 64) * D + u.pn * 256 + wc * 64;
        RowLd cur = rows_issue((const unsigned char*)(SGA + EPY_OFF(0)), (size_t)D * 2, lane), nx1 = rows_issue((const unsigned char*)(SGA + EPY_OFF(1)), (size_t)D * 2, lane);
#pragma unroll
        for (int g = 0; g < 8; ++g) {
            RowLd nx2 = cur; if (g + 2 < 8) nx2 = rows_issue((const unsigned char*)(SGA + EPY_OFF(g + 2)), (size_t)D * 2, lane);
            const int ai = g >> 2, m = g & 3;
            u32x4 w[2], gg[2]; rows_spread(scr, lane, cur, gg[0], gg[1]);
#pragma unroll
            for (int bj = 0; bj < 2; ++bj) { const u32x4 ga = gg[bj]; const f32x4 v0 = acc[ai][bj][m][0], v1 = acc[ai][bj][m][1];
                w[bj][0] = pg8::cvt_pk_bf16(v0[0] * bflo(ga[0]), v0[1] * bfhi(ga[0])); w[bj][1] = pg8::cvt_pk_bf16(v0[2] * bflo(ga[1]), v0[3] * bfhi(ga[1]));
                w[bj][2] = pg8::cvt_pk_bf16(v1[0] * bflo(ga[2]), v1[1] * bfhi(ga[2])); w[bj][3] = pg8::cvt_pk_bf16(v1[2] * bflo(ga[3]), v1[3] * bfhi(ga[3])); }
            store_rows(scr, (unsigned char*)(SGF + EPY_OFF(g)), (size_t)D * 2, lane, w[0], w[1]);
            cur = nx1; nx1 = nx2;
        }
#undef EPY_OFF
    }
};
struct EpiOut {
    const float* x; const float* mod; float* out;
    __device__ __forceinline__ void operator()(f32x4 (&acc)[2][2][4][2], const pg8::Unit& u, int wr, int wc, int fr, int fq, LAS unsigned char* lds, int wid, int lane) const {
        const int col = u.pn * 256 + wc * 64 + 8 * fq;
        const float* gate = mod + (size_t)(u.pm >> 3) * 3 * D + 2 * D + col;
        f32x4 gt[2][2];
#pragma unroll
        for (int bj = 0; bj < 2; ++bj) { gt[bj][0] = *(const f32x4*)(gate + bj * 32); gt[bj][1] = *(const f32x4*)(gate + bj * 32 + 4); }
        LAS unsigned char* scr = lds + STG_OFF + wid * 2304;
        const size_t o0 = (size_t)(u.pm * 256 + wr * 64) * D + u.pn * 256 + wc * 64;
#define EPO_OFF(g) (o0 + (size_t)((((g) >> 3) & 1) * 128 + (((g) >> 1) & 3) * 16) * D + ((g) & 1) * 32)
        RowLd cur = rows_issue((const unsigned char*)(x + EPO_OFF(0)), (size_t)D * 4, lane), nx1 = rows_issue((const unsigned char*)(x + EPO_OFF(1)), (size_t)D * 4, lane);
#pragma unroll
        for (int g = 0; g < 16; ++g) {
            RowLd nx2 = cur; if (g + 2 < 16) nx2 = rows_issue((const unsigned char*)(x + EPO_OFF(g + 2)), (size_t)D * 4, lane);
            const int ai = (g >> 3) & 1, m = (g >> 1) & 3, bj = g & 1;
            u32x4 x0, x1; rows_spread<true>(scr, lane, cur, x0, x1);
            const f32x4 r0 = __builtin_bit_cast(f32x4, x0) + gt[bj][0] * acc[ai][bj][m][0], r1 = __builtin_bit_cast(f32x4, x1) + gt[bj][1] * acc[ai][bj][m][1];
            store_rows<true>(scr, (unsigned char*)(out + EPO_OFF(g)), (size_t)D * 4, lane, __builtin_bit_cast(u32x4, r0), __builtin_bit_cast(u32x4, r1));
            cur = nx1; nx1 = nx2;
        }
#undef EPO_OFF
    }
};

namespace natt {
typedef short v4i16_t __attribute__((ext_vector_type(4)));
__device__ __forceinline__ v4i16_t vtr(const LAS unsigned char* p) { return __builtin_amdgcn_ds_read_tr16_b64_v4i16((LAS v4i16_t*)p); }
struct Tensors { const bf16_t* Q; bf16_t* O; const bf16_t* K; const bf16_t* V; const bf16_t* KC; const bf16_t* VC; const bf16_t* SZA; const float* rpb; const float* shift; };

__device__ __forceinline__ bf16x8 softmax_pack(const f32x4& sx, const f32x4& sy, float& lsum, bool local, const int (&dcv)[2][4], const LAS float* Trow, float shift) {
    float px[4], py[4];
#pragma unroll
    for (int j = 0; j < 4; ++j) {
        if (local) {
            const int ix = dcv[0][j], iy = dcv[1][j];
            const float bx = Trow[ix < 0 ? 0 : ix], by = Trow[iy < 0 ? 0 : iy];
            px[j] = ix < 0 ? 0.f : __builtin_amdgcn_exp2f(sx[j] + bx);
            py[j] = iy < 0 ? 0.f : __builtin_amdgcn_exp2f(sy[j] + by);
        } else { px[j] = __builtin_amdgcn_exp2f(sx[j]); py[j] = __builtin_amdgcn_exp2f(sy[j]); }
    }
    lsum += ((px[0] + px[1]) + (px[2] + px[3])) + ((py[0] + py[1]) + (py[2] + py[3]));
    u32x4 pw; pw[0] = pg8::cvt_pk_bf16(px[0], px[1]); pw[1] = pg8::cvt_pk_bf16(px[2], px[3]); pw[2] = pg8::cvt_pk_bf16(py[0], py[1]); pw[3] = pg8::cvt_pk_bf16(py[2], py[3]);
    return __builtin_bit_cast(bf16x8, pw);
}
__device__ __forceinline__ void glds16(const void* gsrc, unsigned lds_dst) { unsigned keep;
    asm volatile("s_mov_b32 %0, m0\n\ts_mov_b32 m0, %2\n\ts_nop 0\n\tglobal_load_lds_dwordx4 %1, off\n\ts_mov_b32 m0, %0" : "=&s"(keep) : "v"(gsrc), "s"(lds_dst) : "memory"); }
#define NATT_R128(dst, addr, off) asm volatile("ds_read_b128 %0, %1 offset:%2" : "=v"(dst) : "v"(addr), "i"(off))
#define NATT_TR64(dst, addr, off) asm volatile("ds_read_b64_tr_b16 %0, %1 offset:%2" : "=v"(dst) : "v"(addr), "i"(off))
#define NATT_WAIT(n) do { __builtin_amdgcn_sched_barrier(0); asm volatile("s_waitcnt lgkmcnt(" #n ")" ::: "memory"); __builtin_amdgcn_sched_barrier(0); } while (0)
#define NATT_VF(x, y) (bf16x8){x[0], x[1], x[2], x[3], y[0], y[1], y[2], y[3]}
template <bool LOCAL>
__device__ __forceinline__ void step2(unsigned Kb, unsigned Vb, int kbA, int kbB, const bf16x8 (&qA)[4], const bf16x8 (&qB)[4], f32x4 (&oA)[8], f32x4 (&oB)[8],
                                      float& lA, float& lB, int fr, int fq, const int (&dcvA)[2][4], const int (&dcvB)[2][4], const LAS float* Trow, float shift) {
    if (LOCAL) asm volatile("" : "+v"(fr), "+v"(fq));
    const int krA = kbA + fr, krB = kbB + fr, ch = (fr & 3) >> 1;
    const int vrA = kbA + 4 * fq + (fr >> 2), swA = (vrA & 7) << 1, vrB = kbB + 4 * fq + (fr >> 2), swB = (vrB & 7) << 1;
    const unsigned vaA = Vb + vrA * 256 + (fr & 1) * 8, vaB = Vb + vrB * 256 + (fr & 1) * 8;
    bf16x8 kxA[4], kyA[4], kxB[4], kyB[4];
#pragma unroll
    for (int ks = 0; ks < 4; ++ks) { const unsigned a = Kb + krA * 256 + (((4 * ks + fq) ^ (krA & 15)) << 4); NATT_R128(kxA[ks], a, 0); NATT_R128(kyA[ks], a, 4096); }
    if (LOCAL) {
#pragma unroll
        for (int ks = 0; ks < 4; ++ks) { const unsigned a = Kb + krB * 256 + (((4 * ks + fq) ^ (krB & 15)) << 4); NATT_R128(kxB[ks], a, 0); NATT_R128(kyB[ks], a, 4096); }
    }
    v4i16_t x0[4], y0[4], x1[4], y1[4];
#pragma unroll
    for (int d = 0; d < 4; ++d) { const unsigned a = vaA + (((2 * d + ch) ^ swA) << 4); NATT_TR64(x0[d], a, 0); NATT_TR64(y0[d], a, 4096); }
    NATT_WAIT(8);
    f32x4 sxA = (f32x4){-shift, -shift, -shift, -shift}, syA = sxA, sxB = sxA, syB = sxA;
#pragma unroll
    for (int ks = 0; ks < 4; ++ks) {
        sxA = __builtin_amdgcn_mfma_f32_16x16x32_bf16(kxA[ks], qA[ks], sxA, 0, 0, 0);
        syA = __builtin_amdgcn_mfma_f32_16x16x32_bf16(kyA[ks], qA[ks], syA, 0, 0, 0);
        sxB = __builtin_amdgcn_mfma_f32_16x16x32_bf16(LOCAL ? kxB[ks] : kxA[ks], qB[ks], sxB, 0, 0, 0);
        syB = __builtin_amdgcn_mfma_f32_16x16x32_bf16(LOCAL ? kyB[ks] : kyA[ks], qB[ks], syB, 0, 0, 0);
    }
    const bf16x8 pbA = softmax_pack(sxA, syA, lA, LOCAL, dcvA, Trow, shift);
    const bf16x8 pbB = softmax_pack(sxB, syB, lB, LOCAL, dcvB, Trow, shift);
    NATT_WAIT(0);
#pragma unroll
    for (int d = 0; d < 4; ++d) { const unsigned a = vaA + (((2 * (d + 4) + ch) ^ swA) << 4); NATT_TR64(x1[d], a, 0); NATT_TR64(y1[d], a, 4096); }
    __builtin_amdgcn_sched_barrier(0);
#pragma unroll
    for (int d = 0; d < 4; ++d) { const bf16x8 vf = NATT_VF(x0[d], y0[d]); oA[d] = __builtin_amdgcn_mfma_f32_16x16x32_bf16(vf, pbA, oA[d], 0, 0, 0); if (!LOCAL) oB[d] = __builtin_amdgcn_mfma_f32_16x16x32_bf16(vf, pbB, oB[d], 0, 0, 0); }
    NATT_WAIT(0);
    if (LOCAL) {
#pragma unroll
        for (int d = 0; d < 4; ++d) { const unsigned a = vaB + (((2 * d + ch) ^ swB) << 4); NATT_TR64(x0[d], a, 0); NATT_TR64(y0[d], a, 4096); }
        __builtin_amdgcn_sched_barrier(0);
    }
#pragma unroll
    for (int d = 0; d < 4; ++d) { const bf16x8 vf = NATT_VF(x1[d], y1[d]); oA[d + 4] = __builtin_amdgcn_mfma_f32_16x16x32_bf16(vf, pbA, oA[d + 4], 0, 0, 0); if (!LOCAL) oB[d + 4] = __builtin_amdgcn_mfma_f32_16x16x32_bf16(vf, pbB, oB[d + 4], 0, 0, 0); }
    if (LOCAL) {
        NATT_WAIT(0);
#pragma unroll
        for (int d = 0; d < 4; ++d) { const unsigned a = vaB + (((2 * (d + 4) + ch) ^ swB) << 4); NATT_TR64(x1[d], a, 0); NATT_TR64(y1[d], a, 4096); }
        __builtin_amdgcn_sched_barrier(0);
#pragma unroll
        for (int d = 0; d < 4; ++d) { const bf16x8 vf = NATT_VF(x0[d], y0[d]); oB[d] = __builtin_amdgcn_mfma_f32_16x16x32_bf16(vf, pbB, oB[d], 0, 0, 0); }
        NATT_WAIT(0);
#pragma unroll
        for (int d = 0; d < 4; ++d) { const bf16x8 vf = NATT_VF(x1[d], y1[d]); oB[d + 4] = __builtin_amdgcn_mfma_f32_16x16x32_bf16(vf, pbB, oB[d + 4], 0, 0, 0); }
    }
}

__device__ __forceinline__ void attn_phase(LAS unsigned char* lds, const Tensors& T, int vcu) {
    int tid = threadIdx.x; asm volatile("" : "+v"(tid));
    const int lane = tid & 63, wid = __builtin_amdgcn_readfirstlane(tid >> 6), fr = lane & 15, fq = lane >> 4;
    const unsigned lds0 = (unsigned)(size_t)lds;
    LAS float* Tb = (LAS float*)(lds + XCH_OFF);
    float shift = T.shift[0]; asm volatile("" : "+v"(shift));
    const int sA = 2 * (wid & 1), sB = sA + 1, wq = wid >> 1;
    const int cwA = (sA == 0) ? 0 : 24, cwB = (sB == 1) ? 8 : 32;
    int dcvA[2][4], dcvB[2][4];
    {   const int cA = 16 * sA + fr, cstA = min(max(cA - 8, 0), 48), cB = 16 * sB + fr, cstB = min(max(cB - 8, 0), 48);
#pragma unroll
        for (int blk = 0; blk < 2; ++blk)
#pragma unroll
            for (int j = 0; j < 4; ++j) { const int kcA = cwA + 16 * blk + 4 * fq + j, kcB = cwB + 16 * blk + 4 * fq + j;
                dcvA[blk][j] = (kcA >= cstA && kcA < cstA + 16) ? (kcA - cA + 15) : -1; dcvB[blk][j] = (kcB >= cstB && kcB < cstB + 16) ? (kcB - cB + 15) : -1; } }
    const bool isV = wid >= 4;
    const int drow = 32 * (wid & 3) + (lane >> 4), dp = lane & 15;
    for (int ui = 0; ui < 4; ++ui) {
        const int bh = (vcu >> 5) * 16 + ((vcu >> 3) & 3) * 4 + ui, b = bh >> 4, h = bh & 15;
        for (int i = tid; i < 465; i += NWAVES * 64) Tb[i] = T.rpb[h * 465 + i] * 1.4426950408889634f;
        const int rq = (vcu + 2 * ui) & 7, r0 = 4 * rq, qrow = r0 + wq;
        const int rsu = min(max(r0 - 4, 0), 24), nl = min(max(r0 - 1, 0), 24) + 8 - rsu, rsq = min(max(qrow - 4, 0), 24);
        const int ntile = 2 + ((nl + 1) >> 1);
        const size_t qtok = (size_t)b * S + qrow * 64 + 16 * sA + fr;
        const bf16_t* qp = T.Q + qtok * D + h * HD; bf16_t* op = T.O + qtok * D + h * HD;
        bf16x8 qA[4], qB[4];
#pragma unroll
        for (int ks = 0; ks < 4; ++ks) { qA[ks] = *(const bf16x8*)(qp + 32 * ks + 8 * fq); qB[ks] = *(const bf16x8*)(qp + (size_t)16 * D + 32 * ks + 8 * fq); }
        f32x4 oA[8], oB[8];
#pragma unroll
        for (int db = 0; db < 8; ++db) { oA[db] = (f32x4){0.f, 0.f, 0.f, 0.f}; oB[db] = (f32x4){0.f, 0.f, 0.f, 0.f}; }
        float lA = 0.f, lB = 0.f;
        asm volatile("" : "+v"(qA[0]), "+v"(qA[1]), "+v"(qA[2]), "+v"(qA[3]), "+v"(qB[0]), "+v"(qB[1]), "+v"(qB[2]), "+v"(qB[3]));
#define NATT_ISSUE(j) do { const int j_ = (j); const bf16_t* src_; bool go_ = true; \
            if (j_ < 2) src_ = (isV ? T.VC : T.KC) + ((size_t)b * L + 128 * j_) * D + h * HD; \
            else { src_ = (isV ? T.V : T.K) + ((size_t)b * S + (rsu + 2 * (j_ - 2)) * 64) * D + h * HD; go_ = ((wid & 3) < 2) || (2 * (j_ - 2) + 1 < nl); } \
            if (go_) { int drow_ = drow, dp_ = dp; asm volatile("" : "+v"(drow_), "+v"(dp_)); \
            const unsigned dst_ = (unsigned)__builtin_amdgcn_readfirstlane(lds0 + (j_ & 1) * 65536 + (isV ? 32768 : 0) + (wid & 3) * 8192); \
            _Pragma("unroll") for (int e_ = 0; e_ < 8; ++e_) { const int row_ = drow_ + 4 * e_; const int c_ = isV ? (dp_ ^ ((row_ & 7) << 1)) : (dp_ ^ (row_ & 15)); \
                glds16(src_ + (size_t)row_ * D + c_ * 8, dst_ + e_ * 1024); } } } while (0)
#define NATT_TILE_SYNC() do { asm volatile("s_waitcnt vmcnt(0) lgkmcnt(0)\n\ts_barrier" ::: "memory"); __builtin_amdgcn_sched_barrier(0); } while (0)
        NATT_ISSUE(0);
#pragma unroll 1
        for (int j = 0; j < 2; ++j) {
            NATT_TILE_SYNC();
            NATT_ISSUE(j + 1);
            const unsigned Kb = lds0 + (j & 1) * 65536, Vb = Kb + 32768;
#pragma unroll 1
            for (int pr = 0; pr < 4; ++pr) step2<false>(Kb, Vb, 32 * pr, 32 * pr, qA, qB, oA, oB, lA, lB, fr, fq, dcvA, dcvB, Tb, shift);
        }
#pragma unroll 1
        for (int j = 2; j < ntile; ++j) {
            NATT_TILE_SYNC();
            if (j + 1 < ntile) NATT_ISSUE(j + 1);
            const unsigned Kb = lds0 + (j & 1) * 65536, Vb = Kb + 32768;
#pragma unroll 1
            for (int hr = 0; hr < 2; ++hr) {
                const int kr = rsu + 2 * (j - 2) + hr;
                if (kr >= rsq && kr < rsq + 8) step2<true>(Kb, Vb, 64 * hr + cwA, 64 * hr + cwB, qA, qB, oA, oB, lA, lB, fr, fq, dcvA, dcvB, Tb + (kr - qrow + 7) * 31, shift);
            }
        }
#undef NATT_ISSUE
        asm volatile("s_waitcnt lgkmcnt(0)\n\ts_barrier" ::: "memory"); __builtin_amdgcn_sched_barrier(0);
        lA += __shfl_xor(lA, 16); lA += __shfl_xor(lA, 32); lB += __shfl_xor(lB, 16); lB += __shfl_xor(lB, 32);
        const float invA = 1.0f / lA, invB = 1.0f / lB;
        const bf16_t* zp = T.SZA + qtok * D + h * HD + 4 * fq;
#pragma unroll
        for (int db = 0; db < 8; ++db) {
            const u32x2 zA = *(const u32x2*)(zp + 16 * db), zB = *(const u32x2*)(zp + (size_t)16 * D + 16 * db);
            u32x2 w; w[0] = pg8::cvt_pk_bf16(oA[db][0] * invA * bflo(zA[0]), oA[db][1] * invA * bfhi(zA[0])); w[1] = pg8::cvt_pk_bf16(oA[db][2] * invA * bflo(zA[1]), oA[db][3] * invA * bfhi(zA[1]));
            *(u32x2*)(op + 16 * db + 4 * fq) = w;
            w[0] = pg8::cvt_pk_bf16(oB[db][0] * invB * bflo(zB[0]), oB[db][1] * invB * bfhi(zB[0])); w[1] = pg8::cvt_pk_bf16(oB[db][2] * invB * bflo(zB[1]), oB[db][3] * invB * bfhi(zB[1]));
            *(u32x2*)(op + (size_t)16 * D + 16 * db + 4 * fq) = w;
        }
    }
}
}

struct MArgs { const float* in[13]; float* out; unsigned char* ws; int ph_lo, ph_hi, li, pad; };
struct Frame {
    LAS unsigned char* lds; volatile LAS unsigned* MISC; unsigned* ctl; int tid, lane, wave, vcu, G;
};
__device__ __forceinline__ unsigned pk2(float lo, float hi) { return f2bf(lo) | (f2bf(hi) << 16); }

__device__ __forceinline__ void p0_transpose_item(const float* W, int N, bf16_t* WT, int ldo, int koff, int k0, int n0, int lane) {
    f32x4 v[16];
    const float* src = W + (size_t)k0 * N + n0 + 4 * lane;
#pragma unroll
    for (int kk = 0; kk < 16; ++kk) v[kk] = __builtin_nontemporal_load((const f32x4*)(src + (size_t)kk * N));
#pragma unroll
    for (int j = 0; j < 4; ++j) {
        u32x4 a, b;
        a[0] = pk2(v[0][j], v[1][j]); a[1] = pk2(v[2][j], v[3][j]); a[2] = pk2(v[4][j], v[5][j]); a[3] = pk2(v[6][j], v[7][j]);
        b[0] = pk2(v[8][j], v[9][j]); b[1] = pk2(v[10][j], v[11][j]); b[2] = pk2(v[12][j], v[13][j]); b[3] = pk2(v[14][j], v[15][j]);
        bf16_t* dst = WT + (size_t)(n0 + 4 * lane + j) * ldo + koff + k0;
        *(u32x4*)dst = a; *(u32x4*)(dst + 8) = b;
    }
}
struct CopyItem { const float* W; bf16_t* WT; int N, ldo, koff, k0, n0; };
__device__ __forceinline__ void p0_copy_load(const CopyItem& c, int wave, int lane, f32x4 (&v)[8][2]) {
    const float* src = c.W + (size_t)(c.k0 + 8 * wave) * c.N + c.n0 + 4 * lane;
#pragma unroll
    for (int r = 0; r < 8; ++r) { v[r][0] = __builtin_nontemporal_load((const f32x4*)(src + (size_t)r * c.N)); v[r][1] = __builtin_nontemporal_load((const f32x4*)(src + (size_t)r * c.N + 256)); }
}
__device__ __forceinline__ void p0_copy_finish(const CopyItem& c, LAS unsigned char* T, int wave, int lane, const f32x4 (&v)[8][2]) {
#pragma unroll
    for (int i = 0; i < 2; ++i)
#pragma unroll
        for (int j = 0; j < 4; ++j) {
            u32x4 a; a[0] = pk2(v[0][i][j], v[1][i][j]); a[1] = pk2(v[2][i][j], v[3][i][j]); a[2] = pk2(v[4][i][j], v[5][i][j]); a[3] = pk2(v[6][i][j], v[7][i][j]);
            *(LAS u32x4*)(T + (256 * i + 4 * lane + j) * 144 + wave * 16) = a;
        }
    __syncthreads();
#pragma unroll
    for (int e = 0; e < 8; ++e) {
        const int n = wave * 64 + 8 * e + (lane >> 3), p = lane & 7;
        const u32x4 w = *(const LAS u32x4*)(T + n * 144 + p * 16);
        *(u32x4*)(c.WT + (size_t)(c.n0 + n) * c.ldo + c.koff + c.k0 + 8 * p) = w;
    }
    __syncthreads();
}
__device__ __forceinline__ void p0_mod_item(const float* c, const float* cctx, const float* wmod, const float* bmod, float* mod, LAS unsigned char* lds, int item, int wave, int lane) {
    LAS float* scr = (LAS float*)(lds + wave * 16384);
    LAS f32x4* red = (LAS f32x4*)(lds + 131072 + 1024);
    const int j0 = item * 16, fq = lane >> 4, fr = lane & 15, k0 = wave * 256;
    const float* wp = wmod + (size_t)(k0 + fq) * (3 * D) + j0 + fr;
    float w[64];
#pragma unroll
    for (int i = 0; i < 64; ++i) w[i] = __builtin_nontemporal_load(wp + (size_t)(4 * i) * (3 * D));
#pragma unroll 4
    for (int i = 0; i < 64; ++i) { const int idx = i * 64 + lane, b = idx >> 8, kk = idx & 255; float v = 0.f; if (b < 9) { const float z = (b < 8) ? c[b * D + k0 + kk] : cctx[k0 + kk]; v = z / (1.0f + __expf(-z)); } scr[idx] = v; }
    LDS_WAIT(); asm volatile("" ::: "memory");
    f32x4 acc0 = (f32x4){0.f, 0.f, 0.f, 0.f}, acc1 = (f32x4){0.f, 0.f, 0.f, 0.f};
#pragma unroll
    for (int i = 0; i < 64; i += 2) {
        acc0 = __builtin_amdgcn_mfma_f32_16x16x4f32(scr[fr * 256 + 4 * i + fq], w[i], acc0, 0, 0, 0);
        acc1 = __builtin_amdgcn_mfma_f32_16x16x4f32(scr[fr * 256 + 4 * i + 4 + fq], w[i + 1], acc1, 0, 0, 0);
    }
    red[wave * 64 + lane] = acc0 + acc1;
    __syncthreads();
    if (wave == 0) {
        f32x4 t = red[lane];
#pragma unroll
        for (int ww = 1; ww < 8; ++ww) t += red[ww * 64 + lane];
#pragma unroll
        for (int r = 0; r < 4; ++r) { const int b = 4 * fq + r; if (b < 9) mod[b * 3 * D + j0 + fr] = t[r] + bmod[j0 + fr]; }
    }
    __syncthreads();
}
__device__ __forceinline__ void p0_table_item(float2* rope, bf16_t* CS, bf16_t* DFTA, const float* qg, const float* kg, const float* rpbp, float* shiftp, int item, int lane) {
    if (item == 0) {
        for (int i = 0; i < 32; ++i) { const int gid = i * 64 + lane, pos = gid >> 5, j = gid & 31;
            const float invf = exp2f(-(float)j * 0.41524101186092029f); const float ang = (float)pos * invf; float sn, cs; sincosf(ang, &sn, &cs);
            rope[gid] = make_float2(cs, sn); }
        float mq = fmaxf(fabsf(qg[lane]), fabsf(qg[lane + 64])), mk = fmaxf(fabsf(kg[lane]), fabsf(kg[lane + 64])), mb = 0.f;
        for (int i = lane; i < NH * 465; i += 64) mb = fmaxf(mb, rpbp[i]);
        mq = wave_max(mq); mk = wave_max(mk); mb = wave_max(mb);
        if (lane == 0) shiftp[0] = (11.313708498984761f * mq * mk + mb) * 1.4426950408889634f;
    } else if (item <= 32) {
        const int base = (item - 1) * 4096;
#pragma unroll
        for (int i = 0; i < 8; ++i) { const int e0 = base + (i * 64 + lane) * 8; unsigned w[4];
#pragma unroll
            for (int q = 0; q < 4; ++q) { float v[2];
#pragma unroll
                for (int z = 0; z < 2; ++z) { const int e = e0 + 2 * q + z, part = e >> 16, cp = (e >> 8) & 255, cc = e & 255, mm = (cp * cc) & 255;
                    const float rev = (float)mm * (1.0f / 256.0f); v[z] = (part == 0 ? __builtin_amdgcn_cosf(rev) : -__builtin_amdgcn_sinf(rev)) * 0.0625f; }
                w[q] = pk2(v[0], v[1]); }
            *(u32x4*)(CS + e0) = (u32x4){w[0], w[1], w[2], w[3]}; }
    } else {
        const int k1 = item - 33;
#pragma unroll
        for (int i = 0; i < 4; ++i) { const int kk0 = (i * 64 + lane) * 8; unsigned w[4];
#pragma unroll
            for (int q = 0; q < 4; ++q) { float v[2];
#pragma unroll
                for (int z = 0; z < 2; ++z) { const int kk = kk0 + 2 * q + z, part = kk >> 10, n = kk & 1023, mm = (k1 * n) & 2047;
                    const float rev = (float)mm * (1.0f / 2048.0f); v[z] = (part == 0 ? __builtin_amdgcn_cosf(rev) : __builtin_amdgcn_sinf(rev)) * 0.022097086912079608f; }
                w[q] = pk2(v[0], v[1]); }
            *(u32x4*)(DFTA + (size_t)k1 * 2048 + kk0) = (u32x4){w[0], w[1], w[2], w[3]}; }
    }
}
__device__ __forceinline__ void p0_wuf_row(const float* win, bf16_t* Wuf, int k, int lane) {
    const float* src = win + (size_t)k * INW + lane * 16;
    const f32x4 a = *(const f32x4*)(src), b = *(const f32x4*)(src + 4), c = *(const f32x4*)(src + 8), d = *(const f32x4*)(src + 12);
    u32x4 w0, w1; w0[0] = pk2(a[0], a[1]); w0[1] = pk2(a[2], a[3]); w0[2] = pk2(b[0], b[1]); w0[3] = pk2(b[2], b[3]);
    w1[0] = pk2(c[0], c[1]); w1[1] = pk2(c[2], c[3]); w1[2] = pk2(d[0], d[1]); w1[3] = pk2(d[2], d[3]);
    bf16_t* dst = Wuf + (size_t)k * FW + lane * 16;
    *(u32x4*)dst = w0; *(u32x4*)(dst + 8) = w1;
}
__device__ __forceinline__ void p1_hnorm_row(const float* src, const float* shift, const float* scale, bf16_t* dst, int lane) {
    f32x4 v[8]; float ss = 0.f;
#pragma unroll
    for (int j = 0; j < 8; ++j) { v[j] = *(const f32x4*)(src + (j * 64 + lane) * 4); ss += (v[j][0] * v[j][0] + v[j][1] * v[j][1]) + (v[j][2] * v[j][2] + v[j][3] * v[j][3]); }
    ss = wave_sum(ss);
    const float rstd = 1.0f / sqrtf(ss * (1.0f / D) + 1e-6f);
#pragma unroll
    for (int j = 0; j < 8; ++j) {
        const int k = (j * 64 + lane) * 4;
        const f32x4 sc = *(const f32x4*)(scale + k), sh = *(const f32x4*)(shift + k);
        u32x2 o;
        o[0] = pk2(v[j][0] * rstd * (1.f + sc[0]) + sh[0], v[j][1] * rstd * (1.f + sc[1]) + sh[1]);
        o[1] = pk2(v[j][2] * rstd * (1.f + sc[2]) + sh[2], v[j][3] * rstd * (1.f + sc[3]) + sh[3]);
        *(u32x2*)(dst + k) = o;
    }
}
__device__ __forceinline__ void p1_pair_load(const float* xb, int n, int lane, f32x4 (&a)[8], f32x4 (&b)[8]) {
    const int n2 = (n == 0) ? 1024 : 2048 - n;
    const float* s0 = xb + (size_t)n * D; const float* s1 = xb + (size_t)n2 * D;
#pragma unroll
    for (int j = 0; j < 8; ++j) { a[j] = __builtin_nontemporal_load((const f32x4*)(s0 + (j * 64 + lane) * 4)); b[j] = __builtin_nontemporal_load((const f32x4*)(s1 + (j * 64 + lane) * 4)); }
}
__device__ __forceinline__ void p1_pair_finish(const f32x4 (&a)[8], const f32x4 (&b)[8], const float* shift, const float* scale, bf16_t* Hb, bf16_t* HEb, int n, int lane) {
    const int n2 = (n == 0) ? 1024 : 2048 - n;
    float sa = 0.f, sb = 0.f;
#pragma unroll
    for (int j = 0; j < 8; ++j) { sa += (a[j][0] * a[j][0] + a[j][1] * a[j][1]) + (a[j][2] * a[j][2] + a[j][3] * a[j][3]); sb += (b[j][0] * b[j][0] + b[j][1] * b[j][1]) + (b[j][2] * b[j][2] + b[j][3] * b[j][3]); }
    sa = wave_sum(sa); sb = wave_sum(sb);
    const float ra = 1.0f / sqrtf(sa * (1.0f / D) + 1e-6f), rb = 1.0f / sqrtf(sb * (1.0f / D) + 1e-6f);
#pragma unroll
    for (int j = 0; j < 8; ++j) {
        const int k = (j * 64 + lane) * 4;
        const f32x4 sc = *(const f32x4*)(scale + k), sh = *(const f32x4*)(shift + k);
        const f32x4 ha = a[j] * ra * (sc + 1.f) + sh, hb = b[j] * rb * (sc + 1.f) + sh;
        u32x2 o; o[0] = pk2(ha[0], ha[1]); o[1] = pk2(ha[2], ha[3]); *(u32x2*)(Hb + (size_t)n * D + k) = o;
        o[0] = pk2(hb[0], hb[1]); o[1] = pk2(hb[2], hb[3]); *(u32x2*)(Hb + (size_t)n2 * D + k) = o;
        f32x4 he, ho;
        if (n == 0) { he = ha; ho = (f32x4){0.f, 0.f, 0.f, 0.f}; } else { he = ha + hb; ho = ha - hb; }
        o[0] = pk2(he[0], he[1]); o[1] = pk2(he[2], he[3]); *(u32x2*)(HEb + (size_t)n * D + k) = o;
        o[0] = pk2(ho[0], ho[1]); o[1] = pk2(ho[2], ho[3]); *(u32x2*)(HEb + (size_t)(1024 + n) * D + k) = o;
    }
}
__device__ __forceinline__ void p3_pn_item(const bf16_t* H, const bf16_t* WPQ, float* PN, int item, int lane) {
    const int ch0 = item * 2;
    u32x4 w[2][4];
#pragma unroll
    for (int c = 0; c < 2; ++c)
#pragma unroll
        for (int q = 0; q < 4; ++q) w[c][q] = *(const u32x4*)(WPQ + (size_t)(ch0 + c) * D + (q * 64 + lane) * 8);
#pragma unroll 1
    for (int b = 0; b < NB; ++b) {
        const bf16_t* hr = H + ((size_t)b * S + 1024) * D;
        float a0 = 0.f, a1 = 0.f;
#pragma unroll
        for (int q = 0; q < 4; ++q) { const u32x4 hv = *(const u32x4*)(hr + (q * 64 + lane) * 8);
#pragma unroll
            for (int e = 0; e < 4; ++e) { a0 += bflo(hv[e]) * bflo(w[0][q][e]) + bfhi(hv[e]) * bfhi(w[0][q][e]); a1 += bflo(hv[e]) * bflo(w[1][q][e]) + bfhi(hv[e]) * bfhi(w[1][q][e]); } }
        a0 = wave_sum(a0); a1 = wave_sum(a1);
        if (lane < 2) PN[b * 1024 + ch0 + lane] = lane ? a1 : a0;
    }
}

__global__ void __launch_bounds__(NWAVES * 64, 2) mega_fwd(MArgs args) {
    extern __shared__ __attribute__((aligned(16))) unsigned char lds_raw[];
    Frame F;
    F.lds = (LAS unsigned char*)lds_raw;
    F.MISC = (volatile LAS unsigned*)(F.lds + MISC_OFF);
    F.tid = threadIdx.x; F.lane = F.tid & 63; F.wave = __builtin_amdgcn_readfirstlane(F.tid >> 6);
    F.G = gridDim.x; { const int bx = blockIdx.x; F.vcu = (F.G % 8 == 0) ? (bx % 8) * (F.G / 8) + bx / 8 : bx; }
    unsigned char* ws = args.ws; unsigned char* dob = (unsigned char*)args.out;
    F.ctl = (unsigned*)(ws + WS_CTL);
    const float* x = args.in[0]; const float* c = args.in[1]; const float* ctx = args.in[2]; const float* cctx = args.in[3];
    const float* wmod = args.in[4]; const float* bmod = args.in[5]; const float* win = args.in[6];
    const float* qg = args.in[7]; const float* kg = args.in[8]; const float* rpb = args.in[9];
    float* shiftp = (float*)(ws + WS_ROPE + 65536);
    const float* wf = args.in[10]; const float* wa = args.in[11]; const float* wo = args.in[12];
    bf16_t* Wfa_t = (bf16_t*)(ws + WS_WFA); bf16_t* Wo_t = (bf16_t*)(ws + WS_WO); bf16_t* DFTA = (bf16_t*)(ws + WS_DFTA); bf16_t* CS = (bf16_t*)(ws + WS_CS);
    bf16_t* WPQ = (bf16_t*)(ws + WS_WPQ); bf16_t* HEO = (bf16_t*)(ws + WS_HEO); bf16_t* PQT = (bf16_t*)(ws + WS_PQT); float* PN = (float*)(ws + WS_PN);
    float* mod = (float*)(ws + WS_MOD); float2* rope = (float2*)(ws + WS_ROPE);
    bf16_t* H = (bf16_t*)(dob + DO_H); bf16_t* Win_t = (bf16_t*)(dob + DO_WIN); bf16_t* Wuf = (bf16_t*)(dob + DO_WUF);
    for (int u = F.tid; u < (LDS_BYTES - LDSCTL_OFF) / 4; u += NWAVES * 64) ((LAS unsigned*)(F.lds + LDSCTL_OFF))[u] = 0u;
    __syncthreads();
    XcdBarrier bar = xcd_barrier_post(F.ctl + CW_BAR + args.li * XCD_BAR_WORDS, F.MISC + 8);
    const int lo = args.ph_lo, hi = args.ph_hi;
#define IN(k) (lo <= (k) && (k) < hi)
#define BOTH(k) (IN(k) && IN((k) + 1))

    if (IN(0)) {
        for (int it = F.vcu; it < 384; it += F.G) p0_mod_item(c, cctx, wmod, bmod, mod, F.lds, it, F.wave, F.lane);
        for (int it = F.wave * F.G + F.vcu; it < 33 + 2048 + 2048; it += F.G * NWAVES) {
            if (it < 33 + 2048) p0_table_item(rope, CS, DFTA, qg, kg, rpb, shiftp, it, F.lane); else p0_wuf_row(win, Wuf, it - (33 + 2048), F.lane); }
        {   constexpr int I_WIN = 32 * 26, I_WO = 32 * 4, I_WA = 32 * 4, I_WF = 16 * 4, NIT = I_WIN + I_WO + I_WA + I_WF;
            auto item = [&](int wi) { CopyItem ci; int r = wi;
                if (r < I_WIN) { ci = CopyItem{win, Win_t, INW, D, 0, (r & 31) * 64, 1024 + (r >> 5) * 512}; return ci; } r -= I_WIN;
                if (r < I_WO) { ci = CopyItem{wo, Wo_t, D, D, 0, (r & 31) * 64, (r >> 5) * 512}; return ci; } r -= I_WO;
                if (r < I_WA) { ci = CopyItem{wa, Wfa_t, D, 3072, 1024, (r & 31) * 64, (r >> 5) * 512}; return ci; } r -= I_WA;
                ci = CopyItem{wf, Wfa_t, D, 3072, 0, (r & 15) * 64, (r >> 4) * 512}; return ci; };
            f32x4 va[8][2], vb[8][2];
            int wi = F.vcu;
            if (wi < NIT) p0_copy_load(item(wi), F.wave, F.lane, va);
#pragma unroll 1
            for (; wi < NIT; wi += F.G) {
                const int wn = wi + F.G;
                if (wn < NIT) p0_copy_load(item(wn), F.wave, F.lane, vb);
                p0_copy_finish(item(wi), F.lds, F.wave, F.lane, va);
#pragma unroll
                for (int r = 0; r < 8; ++r) { va[r][0] = vb[r][0]; va[r][1] = vb[r][1]; }
            } }
        if (BOTH(0)) xcd_barrier(bar);
    }
    if (IN(1)) {
        {   pg8::Gemm g{CS, Wuf, 256, FW};
            SchedFold Sc{F.G, F.vcu};
            EpiTile E{WPQ, (long)D, 0};
            pg8::gemm_phase<EpiTile, SchedFold>(F.lds, g, Sc, E); }
        const int gw = F.vcu * NWAVES + F.wave, NGW = F.G * NWAVES;
        {   f32x4 ra[8], rb[8], na[8], nb[8];
            int it = gw;
            if (it < NB * 1024) p1_pair_load(x + (size_t)(it >> 10) * S * D, it & 1023, F.lane, ra, rb);
#pragma unroll 1
            for (; it < NB * 1024; it += NGW) {
                const int itn = it + NGW, b = it >> 10, n = it & 1023;
                if (itn < NB * 1024) p1_pair_load(x + (size_t)(itn >> 10) * S * D, itn & 1023, F.lane, na, nb);
                p1_pair_finish(ra, rb, mod + (size_t)b * 3 * D, mod + (size_t)b * 3 * D + D, H + (size_t)b * S * D, HEO + (size_t)b * S * D, n, F.lane);
#pragma unroll
                for (int j = 0; j < 8; ++j) { ra[j] = na[j]; rb[j] = nb[j]; }
            } }
        for (int r2 = gw; r2 < NB * L; r2 += NGW) p1_hnorm_row(ctx + (size_t)r2 * D, mod + (size_t)8 * 3 * D, mod + (size_t)8 * 3 * D + D, H + (size_t)(NB * S + r2) * D, F.lane);
        if (BOTH(1)) xcd_barrier(bar);
    }
    if (IN(2)) {
        for (int it = F.wave * F.G + F.vcu; it < 512; it += F.G * NWAVES) p3_pn_item(H, WPQ, PN, it, F.lane);
        {
            pg8::Gemm g{WPQ, HEO, D, D};
            SchedUft Sc{F.G, F.vcu};
            EpiTile E{PQT, (long)D, 1};
            pg8::gemm_phase<EpiTile, SchedUft>(F.lds, g, Sc, E);
            xcd_barrier(bar);
        }
        pg8::Gemm g{H, Win_t, D, D};
        SchedInproj Sc{F.G, (int)blockIdx.x};
        EpiInproj E{ws, qg, kg, rope};
#ifndef STAG_P2
#define STAG_P2 0
#endif
        pg8::gemm_phase<EpiInproj, SchedInproj>(F.lds, g, Sc, E, (blockIdx.x >= 128) ? STAG_P2 : 0);
        if (BOTH(2)) xcd_barrier(bar);
    }
    if (IN(3)) {
        natt::Tensors AT{(const bf16_t*)(ws + WS_Q), (bf16_t*)(ws + WS_Q), (const bf16_t*)(ws + WS_K), (const bf16_t*)(ws + WS_V), (const bf16_t*)(ws + WS_KC), (const bf16_t*)(ws + WS_VC), (const bf16_t*)(ws + WS_SZA), rpb, shiftp};
        natt::attn_phase(F.lds, AT, F.vcu);
        pg8::Gemm g{DFTA, PQT, D, D};
        SchedPos Sc{F.G, F.vcu};
        EpiPos E{(const bf16_t*)(ws + WS_ZFC), (bf16_t*)(dob + DO_MF), PN};
        pg8::gemm_phase<EpiPos, SchedPos>(F.lds, g, Sc, E);
        if (BOTH(3)) xcd_barrier(bar);
    }
    if (IN(4)) {
        pg8::Gemm g{(const bf16_t*)(dob + DO_MF), Wfa_t, D, 3072};
        SchedY Sc{F.G, (int)blockIdx.x, (long)((ws + WS_Q) - (dob + DO_MF))};
        EpiY E{(bf16_t*)(ws + WS_SGF), (const bf16_t*)(ws + WS_SGA)};
        pg8::gemm_phase<EpiY, SchedY>(F.lds, g, Sc, E);
        if (BOTH(4)) xcd_barrier(bar);
    }
    if (IN(5)) {
        pg8::Gemm g{(const bf16_t*)(ws + WS_SGF), Wo_t, D, D};
        SchedRows Sc{F.G, (int)blockIdx.x};
        EpiOut E{x, mod, args.out};
        pg8::gemm_phase<EpiOut, SchedRows>(F.lds, g, Sc, E);
    }
#undef IN
#undef BOTH
}

extern "C" void kernel_launch(void* const* d_in, const int* in_sizes, int n_in, void* d_out, int out_size, void* d_ws, size_t ws_size, hipStream_t stream) {
    unsigned char* ws = (unsigned char*)d_ws;
    if (ws_size < WS_END || n_in != 13) return;
    static int grid = 0;
    if (grid == 0) {
        int dev = 0, cus = 0, per_cu = 0;
        if (hipGetDevice(&dev) != hipSuccess || hipDeviceGetAttribute(&cus, hipDeviceAttributeMultiprocessorCount, dev) != hipSuccess) { grid = -1; return; }
        if (hipFuncSetAttribute((const void*)mega_fwd, hipFuncAttributeMaxDynamicSharedMemorySize, LDS_BYTES) != hipSuccess) { grid = -1; return; }
        if (hipOccupancyMaxActiveBlocksPerMultiprocessor(&per_cu, (const void*)mega_fwd, NWAVES * 64, LDS_BYTES) != hipSuccess || per_cu < 1) { fprintf(stderr, "occupancy query: %d\n", per_cu); grid = -1; return; }
        (void)hipGetLastError();
        grid = cus;
    }
    if (grid != 256) return;
    (void)hipMemsetAsync(ws + WS_CTL, 0, 1 * MiB, stream);
    MArgs a; memset(&a, 0, sizeof(a));
    for (int i = 0; i < 13; ++i) a.in[i] = (const float*)d_in[i];
    a.out = (float*)d_out; a.ws = ws;
    a.ph_lo = 0; a.ph_hi = 6; a.li = 0;
    hipLaunchKernelGGL(mega_fwd, dim3(grid), dim3(NWAVES * 64), LDS_BYTES, stream, a);
}
```

```cpp
#include <hip/hip_runtime.h>
#include <stdint.h>
#include <string.h>

typedef unsigned short bf16_t;
typedef short bf16x8 __attribute__((ext_vector_type(8)));
typedef float f32x4 __attribute__((ext_vector_type(4)));
typedef unsigned u32x4 __attribute__((ext_vector_type(4)));
typedef unsigned u32x2 __attribute__((ext_vector_type(2)));

constexpr int D = 2048, NB = 8, S = 2048, L = 256, NH = 16, HD = 128, FW = 1024, INW = 14336;
constexpr int OFF_ZF = 1024, OFF_Q = 2048, OFF_K = 4096, OFF_V = 6144, OFF_ZA = 8192, OFF_GF = 10240, OFF_GA = 12288;
constexpr size_t MiB = 1u << 20;
constexpr float QSCALE = 0.08838834764831845f * 1.4426950408889634f;
constexpr size_t WS_ZFC = 0, WS_PQT = 32 * MiB, WS_Q = 64 * MiB, WS_HEO = 64 * MiB, WS_K = 128 * MiB, WS_V = 192 * MiB, WS_SZA = 256 * MiB, WS_SGF = 320 * MiB, WS_SGA = 384 * MiB,
                 WS_KC = 448 * MiB, WS_VC = 456 * MiB, WS_WFA = 464 * MiB, WS_WO = 476 * MiB, WS_DFTA = 484 * MiB, WS_WPQ = 492 * MiB,
                 WS_CTL = 500 * MiB, WS_MOD = 501 * MiB, WS_ROPE = 502 * MiB, WS_CS = 503 * MiB, WS_PN = 504 * MiB, WS_END = 512 * MiB;
constexpr size_t DO_H = 0, DO_HC = 64 * MiB, DO_WIN = 72 * MiB, DO_WUF = 72 * MiB, DO_MF = 0;

__device__ __forceinline__ unsigned f2bf(float f) { unsigned u = __float_as_uint(f); return (u + 0x7fffu + ((u >> 16) & 1u)) >> 16; }
__device__ __forceinline__ float bf2f(unsigned h) { return __uint_as_float(h << 16); }
__device__ __forceinline__ float silu_f(float z) { return z / (1.0f + expf(-z)); }
__device__ __forceinline__ float sigm_f(float z) { return 1.0f / (1.0f + expf(-z)); }
__device__ __forceinline__ float wave_sum(float v) {
#pragma unroll
    for (int o = 1; o < 64; o <<= 1) v += __shfl_xor(v, o);
    return v;
}
__device__ __forceinline__ float wave_max(float v) {
#pragma unroll
    for (int o = 1; o < 64; o <<= 1) v = fmaxf(v, __shfl_xor(v, o));
    return v;
}

#define LAS __attribute__((address_space(3)))
#define GAS __attribute__((address_space(1)))
typedef GAS unsigned gu32;
#define RLX_AGENT __ATOMIC_RELAXED, __HIP_MEMORY_SCOPE_AGENT
#define LDS_WAIT() asm volatile("s_waitcnt lgkmcnt(0)" ::: "memory")
#define VM_WAIT() asm volatile("s_waitcnt vmcnt(0)" ::: "memory")
constexpr int NWAVES = 8;
constexpr int RING_BYTES = 131072, LDSCTL_OFF = RING_BYTES, MISC_OFF = LDSCTL_OFF + 320, XCH_OFF = LDSCTL_OFF + 1024, STG_OFF = XCH_OFF + 4096, LDS_BYTES = 163840;
constexpr int CW_BAR = 4096;

#define XB_TMO      128
#define XB_XCNT(j)  (256  + 64 * (j))
#define XB_XSUB(j)  (1280 + 64 * (j))
#define XB_XGEN(j)  (2304 + 64 * (j))
#define XB_TOP      3328
#define XB_TOPGEN   3392
#define XCD_BAR_WORDS 3456
#define XB_SPIN_CAP (1u << 18)
__device__ __forceinline__ unsigned xb_ld(unsigned* p)              { return __hip_atomic_load(p, __ATOMIC_RELAXED, __HIP_MEMORY_SCOPE_AGENT); }
__device__ __forceinline__ unsigned xb_add(unsigned* p, unsigned v) { return __hip_atomic_fetch_add(p, v, __ATOMIC_RELAXED, __HIP_MEMORY_SCOPE_AGENT); }
__device__ __forceinline__ unsigned xb_xcc_id() { return (unsigned)__builtin_amdgcn_s_getreg((3 << 11) | 20) & 0xFu; }
#define XB_SPIN(cond, bar) do { unsigned _sp = 0; while (cond) { __builtin_amdgcn_s_sleep(1); \
    if ((++_sp & 255u) == 0u) { if (xb_ld(&(bar)[XB_TMO])) break; if (_sp > XB_SPIN_CAP) { atomicAdd(&(bar)[XB_TMO], 1u); break; } } } } while (0)
struct XcdBarrier { unsigned* bar; unsigned x; volatile LAS unsigned* st; };
__device__ __forceinline__ XcdBarrier xcd_barrier_post(unsigned* bar, volatile LAS unsigned* st) {
    XcdBarrier b; b.bar = bar; b.x = xb_xcc_id(); b.st = st;
    if (threadIdx.x == 0) (void)xb_add(&bar[XB_XCNT(b.x)], 1u);
    return b;
}
__device__ __forceinline__ void xcd_barrier_complete(unsigned* bar, unsigned x, unsigned& nloc, unsigned& nx) {
    const unsigned G = gridDim.x * gridDim.y * gridDim.z;
    unsigned sum, cnt, mine, sp = 0u;
    for (;;) {
        sum = 0u; cnt = 0u; mine = 0u;
#pragma unroll
        for (unsigned j = 0; j < 16; ++j) { const unsigned c = xb_ld(&bar[XB_XCNT(j)]); sum += c; cnt += (c > 0u) ? 1u : 0u; mine = (j == x) ? c : mine; }
        if (sum == G) break;
        __builtin_amdgcn_s_sleep(1);
        if ((++sp & 255u) == 0u) { if (xb_ld(&bar[XB_TMO])) break; if (sp > XB_SPIN_CAP) { atomicAdd(&bar[XB_TMO], 1u); break; } }
    }
    nloc = mine > 0u ? mine : 1u; nx = cnt > 0u ? cnt : 1u;
}
__device__ __forceinline__ void xcd_barrier(const XcdBarrier& b) {
    asm volatile("s_waitcnt vmcnt(0)" ::: "memory");
    __syncthreads();
    if (threadIdx.x == 0) {
        unsigned* bar = b.bar;
        __builtin_amdgcn_s_waitcnt(0);
        unsigned nloc = b.st[0], nx = b.st[1];
        if (nloc == 0u) { xcd_barrier_complete(bar, b.x, nloc, nx); b.st[0] = nloc; b.st[1] = nx; }
        const unsigned old = xb_add(&bar[XB_XSUB(b.x)], 1u);
        const unsigned gen = old / nloc;
        if (old + 1u == (gen + 1u) * nloc) {
            __builtin_amdgcn_fence(__ATOMIC_RELEASE, "agent");
            asm volatile("s_waitcnt vmcnt(0)" ::: "memory");
            const unsigned og = xb_add(&bar[XB_TOP], 1u);
            const unsigned tg = og / nx;
            if (og + 1u == (tg + 1u) * nx) xb_add(&bar[XB_TOPGEN], 1u);
            else XB_SPIN(xb_ld(&bar[XB_TOPGEN]) == tg, bar);
            __builtin_amdgcn_fence(__ATOMIC_ACQUIRE, "agent");
            xb_add(&bar[XB_XGEN(b.x)], 1u);
            asm volatile("s_waitcnt vmcnt(0)" ::: "memory");
        } else {
            XB_SPIN(xb_ld(&bar[XB_XGEN(b.x)]) == gen, bar);
            __builtin_amdgcn_fence(__ATOMIC_ACQUIRE, "agent");
            asm volatile("s_waitcnt vmcnt(0)" ::: "memory");
        }
    }
    __syncthreads();
}

namespace pg8 {
constexpr int BM = 256, BK = 64, HALF = 128, HTB = HALF * BK * 2, STAGE_BYTES = 8 * HTB;
__host__ __device__ __forceinline__ int lds_byte(int r, int c) { const int st = (r >> 4) * 2 + (c >> 5), rr = r & 15, cc = c & 31, ob = rr * 64 + cc * 2; return st * 1024 + (ob ^ (((ob >> 9) & 1) << 5)); }
__host__ __device__ __forceinline__ void stage_rc(int b, int& R, int& C) { const int st = b / 1024, sb = b % 1024, swz = sb ^ (((sb >> 9) & 1) << 5); R = (st >> 1) * 16 + swz / 64; C = (st & 1) * 32 + (swz % 64) / 2; }
__host__ __device__ __forceinline__ int perm32(int rho) { const int n = rho >> 4, i = rho & 15; return 8 * (i >> 2) + 4 * n + (i & 3); }
struct Unit { int pm, pn, x0, x1, nt, keep; long aoff, boff; };
struct Gemm { const bf16_t* A; const bf16_t* Bt; int lda, ldb; };
__device__ __forceinline__ unsigned cvt_pk_bf16(float lo, float hi) { unsigned r; asm volatile("v_cvt_pk_bf16_f32 %0, %1, %2" : "=v"(r) : "v"(lo), "v"(hi)); return r; }

template <class Epi, class Sched, bool HALF_OK = false>
__device__ __forceinline__ void gemm_phase(LAS unsigned char* lds, const Gemm g, const Sched& S, const Epi& E, unsigned delay_ticks = 0) {
    int tid = threadIdx.x; asm volatile("" : "+v"(tid));
    const int wid = __builtin_amdgcn_readfirstlane(tid >> 6), lane = tid & 63, wr = wid >> 2, wc = wid & 3, fr = lane & 15, fq = lane >> 4;
    unsigned voffA[2], voffB[2];
#pragma unroll
    for (int i = 0; i < 2; ++i) { int R, C; stage_rc(tid * 16 + i * 8192, R, C); const int Rb = 64 * (R >> 5) + perm32(R & 31);
        voffA[i] = (unsigned)(R * g.lda + C) * 2u; voffB[i] = (unsigned)(Rb * g.ldb + C) * 2u; }
    const size_t kstep = (size_t)(BK * 2);
    const size_t hstepA = (size_t)HALF * g.lda * 2, hstepB = (size_t)32 * g.ldb * 2;
    const unsigned ldsw = (unsigned)wid * 1024u;
    const int aoff = lds_byte(wr * 64 + fr, fq * 8), boff = lds_byte(wc * 32 + fr, fq * 8);
#define PG8_SA(b, h) (((b) * 2 + (h)) * HTB)
#define PG8_SB(b, h) ((4 + (b) * 2 + (h)) * HTB)
#define PG8_STAGE(bufoff, gbase, voff) do { _Pragma("unroll") for (int _i = 0; _i < 2; ++_i) \
        __builtin_amdgcn_global_load_lds((const unsigned*)((const char*)(gbase) + (voff)[_i]), (LAS unsigned*)(lds + (bufoff) + ldsw + _i * 8192), 16, 0, 0); } while (0)
#define PG8_LDA(dst, b, h) do { _Pragma("unroll") for (int m = 0; m < 4; ++m) _Pragma("unroll") for (int k = 0; k < 2; ++k) dst[m][k] = *(const LAS bf16x8*)(lds + PG8_SA(b, h) + aoff + m * 2048 + k * 1024); } while (0)
#define PG8_LDB(dst, b, h) do { _Pragma("unroll") for (int n = 0; n < 2; ++n) _Pragma("unroll") for (int k = 0; k < 2; ++k) dst[n][k] = *(const LAS bf16x8*)(lds + PG8_SB(b, h) + boff + n * 2048 + k * 1024); } while (0)
#define PG8_MMA(ai, bj, At, Bt) do { __builtin_amdgcn_s_setprio(1); _Pragma("unroll") for (int m = 0; m < 4; ++m) _Pragma("unroll") for (int n = 0; n < 2; ++n) _Pragma("unroll") for (int k = 0; k < 2; ++k) \
        acc[ai][bj][m][n] = __builtin_amdgcn_mfma_f32_16x16x32_bf16(Bt[n][k], At[m][k], acc[ai][bj][m][n], 0, 0, 0); __builtin_amdgcn_s_setprio(0); } while (0)
#define PG8_WAIT_V(n) asm volatile("s_waitcnt vmcnt(" #n ")" ::: "memory")
#define PG8_WAIT_L(n) asm volatile("s_waitcnt lgkmcnt(" #n ")" ::: "memory")
#define PG8_BAR __builtin_amdgcn_s_barrier()
#define PG8_SCHED __builtin_amdgcn_sched_barrier(0)
    Unit cur, nxt; int ui = 0;
    if (!S.next(0, cur)) return;
    if (delay_ticks) { const unsigned long long t0 = __builtin_amdgcn_s_memrealtime(); while (__builtin_amdgcn_s_memrealtime() - t0 < delay_ticks) __builtin_amdgcn_s_sleep(8); }
    f32x4 acc[2][2][4][2];
#pragma unroll
    for (int a = 0; a < 2; ++a)
#pragma unroll
        for (int b = 0; b < 2; ++b)
#pragma unroll
            for (int m = 0; m < 4; ++m)
#pragma unroll
                for (int n = 0; n < 2; ++n) acc[a][b][m][n] = (f32x4){0.f, 0.f, 0.f, 0.f};
    bf16x8 At[4][2], B0[2][2], B1[2][2];
    const char* cA = (const char*)g.A + cur.aoff; const char* cB = (const char*)g.Bt + cur.boff;
    PG8_STAGE(PG8_SB(0, 0), cB, voffB); PG8_STAGE(PG8_SB(0, 1), cB + hstepB, voffB); PG8_STAGE(PG8_SA(0, 0), cA, voffA); PG8_STAGE(PG8_SA(0, 1), cA + hstepA, voffA);
    if (wr == 1) PG8_BAR;
    PG8_WAIT_V(2); PG8_BAR;
    PG8_STAGE(PG8_SB(1, 0), cB + kstep, voffB); PG8_STAGE(PG8_SA(1, 0), cA + kstep, voffA); PG8_STAGE(PG8_SB(1, 1), cB + hstepB + kstep, voffB);
    PG8_WAIT_V(6); PG8_BAR;
    for (;;) {
        const bool has_next = S.next(ui + 1, nxt);
        const char* nA = has_next ? (const char*)g.A + nxt.aoff : cA; const char* nB = has_next ? (const char*)g.Bt + nxt.boff : cB;
        const bool half = HALF_OK && cur.x1 != 0;
        int nt = cur.nt; asm volatile("" : "+s"(nt));
        for (int t = 0; t < nt; t += 2) {
            const bool last = (t == nt - 2);
            const char* a1 = cA + (size_t)(t + 1) * kstep;
            const char* a2 = last ? nA : cA + (size_t)(t + 2) * kstep; const char* b2 = last ? nB : cB + (size_t)(t + 2) * kstep;
            const char* a3 = a2 + kstep; const char* b3 = b2 + kstep;
            PG8_LDB(B0, 0, 0); PG8_LDB(B1, 0, 1); PG8_SCHED; PG8_LDA(At, 0, 0); PG8_STAGE(PG8_SA(1, 1), a1 + hstepA, voffA);
            PG8_WAIT_V(8); PG8_WAIT_L(0); PG8_BAR; PG8_MMA(0, 0, At, B0); PG8_MMA(0, 1, At, B1); PG8_BAR; PG8_SCHED;
            PG8_LDA(At, 0, 1); PG8_STAGE(PG8_SB(0, 0), b2, voffB); PG8_STAGE(PG8_SB(0, 1), b2 + hstepB, voffB); PG8_STAGE(PG8_SA(0, 0), a2, voffA);
            PG8_WAIT_V(8); PG8_WAIT_L(0); PG8_BAR; if (!(HALF_OK && half)) { PG8_MMA(1, 0, At, B0); PG8_MMA(1, 1, At, B1); } PG8_BAR; PG8_SCHED;
            PG8_LDB(B0, 1, 0); PG8_LDB(B1, 1, 1); PG8_SCHED; PG8_LDA(At, 1, 0); PG8_STAGE(PG8_SA(0, 1), a2 + hstepA, voffA);
            PG8_WAIT_V(8); PG8_WAIT_L(0); PG8_BAR; PG8_MMA(0, 0, At, B0); PG8_MMA(0, 1, At, B1); PG8_BAR; PG8_SCHED;
            PG8_LDA(At, 1, 1); PG8_STAGE(PG8_SB(1, 0), b3, voffB); PG8_STAGE(PG8_SB(1, 1), b3 + hstepB, voffB); PG8_STAGE(PG8_SA(1, 0), a3, voffA);
            PG8_WAIT_V(8); PG8_WAIT_L(0); PG8_BAR; if (!(HALF_OK && half)) { PG8_MMA(1, 0, At, B0); PG8_MMA(1, 1, At, B1); } PG8_BAR; PG8_SCHED;
        }
        if (wr == 0) PG8_BAR;
        E(acc, cur, wr, wc, fr, fq, lds, wid, lane);
        if (!has_next) break;
        if (!cur.keep) {
#pragma unroll
        for (int a = 0; a < 2; ++a)
#pragma unroll
            for (int b = 0; b < 2; ++b)
#pragma unroll
                for (int m = 0; m < 4; ++m)
#pragma unroll
                    for (int n = 0; n < 2; ++n) acc[a][b][m][n] = (f32x4){0.f, 0.f, 0.f, 0.f};
        }
        cur = nxt; cA = nA; cB = nB; ++ui;
        if (wr == 1) PG8_BAR;
    }
    PG8_WAIT_V(0);
    PG8_BAR;
#undef PG8_SA
#undef PG8_SB
#undef PG8_STAGE
#undef PG8_LDA
#undef PG8_LDB
#undef PG8_MMA
#undef PG8_WAIT_V
#undef PG8_WAIT_L
#undef PG8_BAR
#undef PG8_SCHED
}
}

__device__ __forceinline__ float fast_sigm(float z) { return __builtin_amdgcn_rcpf(1.0f + __builtin_amdgcn_exp2f(-1.4426950408889634f * z)); }
__device__ __forceinline__ float fast_silu(float z) { return z * fast_sigm(z); }


template <bool F32 = false>
__device__ __forceinline__ void store_rows(LAS unsigned char* scr, unsigned char* g0  , size_t row_bytes, int lane, u32x4 p0, u32x4 p1) {
    const int fr = lane & 15, fq = lane >> 4;
    *(LAS u32x4*)(scr + fr * 144 + (F32 ? 32 * fq : 16 * fq)) = p0; *(LAS u32x4*)(scr + fr * 144 + (F32 ? 32 * fq + 16 : 64 + 16 * fq)) = p1;
    const int ro = lane >> 3, pi = lane & 7;
    const u32x4 a = *(const LAS u32x4*)(scr + ro * 144 + pi * 16), b = *(const LAS u32x4*)(scr + (8 + ro) * 144 + pi * 16);
    *(u32x4*)(g0 + (size_t)ro * row_bytes + pi * 16) = a; *(u32x4*)(g0 + (size_t)(8 + ro) * row_bytes + pi * 16) = b;
}
struct RowLd { u32x4 a, b; };
__device__ __forceinline__ RowLd rows_issue(const unsigned char* g0, size_t row_bytes, int lane) {
    const int ro = lane >> 3, pi = lane & 7; RowLd r;
    r.a = *(const u32x4*)(g0 + (size_t)ro * row_bytes + pi * 16); r.b = *(const u32x4*)(g0 + (size_t)(8 + ro) * row_bytes + pi * 16); return r;
}
template <bool F32 = false>
__device__ __forceinline__ void rows_spread(LAS unsigned char* scr, int lane, const RowLd& r, u32x4& p0, u32x4& p1) {
    const int fr = lane & 15, fq = lane >> 4, ro = lane >> 3, pi = lane & 7;
    *(LAS u32x4*)(scr + ro * 144 + pi * 16) = r.a; *(LAS u32x4*)(scr + (8 + ro) * 144 + pi * 16) = r.b;
    p0 = *(const LAS u32x4*)(scr + fr * 144 + (F32 ? 32 * fq : 16 * fq)); p1 = *(const LAS u32x4*)(scr + fr * 144 + (F32 ? 32 * fq + 16 : 64 + 16 * fq));
}
struct SchedInproj {
    int G, c;
    __device__ __forceinline__ bool next(int i, pg8::Unit& u) const {
        const int grp = c >> 7;
        const int ii = grp ? i - 1 : i;
        if (i > 13) return false;
        u.x0 = 0; u.x1 = 0; u.nt = D / 64; u.keep = 0;
        if (ii >= 0 && ii < 13) { const int xcd = c & 7, jj = (c >> 3) & 15;
            u.pm = 8 * xcd + 4 * grp + (jj & 3); u.pn = grp ? (55 - 4 * ii - (jj >> 2)) : (4 + 4 * ii + (jj >> 2));
            u.aoff = (long)u.pm * 256 * D * 2; }
        else { const int pmh = c & 15; u.pm = 64 + (pmh >> 1); u.pn = 16 + (c >> 4); u.x0 = (pmh & 1) * 128; u.x1 = 1;
            u.aoff = (long)(NB * S + pmh * 128) * D * 2; }
        u.boff = (long)u.pn * 256 * D * 2; return true;
    }
};
struct EpiInproj {
    unsigned char* ws; const float* qg; const float* kg; const float2* rope;
    __device__ __forceinline__ void operator()(f32x4 (&acc)[2][2][4][2], const pg8::Unit& u, int wr, int wc, int fr, int fq, LAS unsigned char* lds, int wid, int lane) const {
        const bool isctx = u.pm >= 64;
        const int blk = u.pn >> 3;
        const int act = (blk == 0) ? 1 : (blk == 1 || blk == 2) ? 3 : (blk == 3) ? 0 : (blk == 4) ? 1 : 2;
        bf16_t* dst; int row0; int ldd = D;
        if (!isctx) { dst = (bf16_t*)(ws + (size_t)blk * 64 * MiB); row0 = u.pm * 256; if (blk == 0) { dst = (bf16_t*)(ws + WS_ZFC); ldd = FW; } }
        else { dst = (bf16_t*)(ws + (blk == 2 ? WS_KC : WS_VC)); row0 = (u.pm - 64) * 256 + u.x0; }
        const bool half = u.x1 != 0;
        const int colw = (blk == 0 ? (u.pn - 4) : (u.pn & 7)) * 256 + wc * 64;
        if (act != 3) {
#pragma unroll
            for (int ai = 0; ai < 2; ++ai)
#pragma unroll
                for (int m = 0; m < 4; ++m) {
                    if (ai == 1 && half) continue;
                    u32x4 w[2];
#pragma unroll
                    for (int bj = 0; bj < 2; ++bj) {
                        f32x4 v0 = acc[ai][bj][m][0], v1 = acc[ai][bj][m][1];
                        if (act == 1) { v0[0] = fast_silu(v0[0]); v0[1] = fast_silu(v0[1]); v0[2] = fast_silu(v0[2]); v0[3] = fast_silu(v0[3]); v1[0] = fast_silu(v1[0]); v1[1] = fast_silu(v1[1]); v1[2] = fast_silu(v1[2]); v1[3] = fast_silu(v1[3]); }
                        else if (act == 2) { v0[0] = fast_sigm(v0[0]); v0[1] = fast_sigm(v0[1]); v0[2] = fast_sigm(v0[2]); v0[3] = fast_sigm(v0[3]); v1[0] = fast_sigm(v1[0]); v1[1] = fast_sigm(v1[1]); v1[2] = fast_sigm(v1[2]); v1[3] = fast_sigm(v1[3]); }
                        w[bj][0] = pg8::cvt_pk_bf16(v0[0], v0[1]); w[bj][1] = pg8::cvt_pk_bf16(v0[2], v0[3]); w[bj][2] = pg8::cvt_pk_bf16(v1[0], v1[1]); w[bj][3] = pg8::cvt_pk_bf16(v1[2], v1[3]);
                    }
                    store_rows(lds + STG_OFF + wid * 2304, (unsigned char*)(dst + (size_t)(row0 + ai * 128 + wr * 64 + m * 16) * ldd + colw), (size_t)ldd * 2, lane, w[0], w[1]);
                }
            return;
        }
        LAS float* X = (LAS float*)(lds + XCH_OFF);
#pragma unroll
        for (int ai = 0; ai < 2; ++ai)
#pragma unroll
            for (int m = 0; m < 4; ++m) {
                float ss = 0.f;
#pragma unroll
                for (int bj = 0; bj < 2; ++bj)
#pragma unroll
                    for (int n = 0; n < 2; ++n) { const f32x4 v = acc[ai][bj][m][n]; ss += (v[0] * v[0] + v[1] * v[1]) + (v[2] * v[2] + v[3] * v[3]); }
                ss += __shfl_xor(ss, 16); ss += __shfl_xor(ss, 32);
                if (fq == 0) X[wid * 128 + ai * 64 + m * 16 + fr] = ss;
            }
        asm volatile("s_waitcnt lgkmcnt(0)" ::: "memory"); __builtin_amdgcn_s_barrier(); asm volatile("" ::: "memory");
        const int ax = wc & 1;
        const float* gain = (blk == 1 ? qg : kg) + ax * 64 + 8 * fq;
        const f32x4 g00 = *(const f32x4*)(gain), g01 = *(const f32x4*)(gain + 4), g10 = *(const f32x4*)(gain + 32), g11 = *(const f32x4*)(gain + 36);
        const float post = (blk == 1) ? QSCALE : 1.0f;
#pragma unroll
        for (int ai = 0; ai < 2; ++ai)
#pragma unroll
            for (int m = 0; m < 4; ++m) {
                if (ai == 1 && half) continue;
                const int ridx = ai * 64 + m * 16 + fr;
                const float tot = X[wid * 128 + ridx] + X[(wid ^ 1) * 128 + ridx];
                const float rs = post / sqrtf(tot * (1.0f / HD) + 1e-6f);
                f32x4 x0a = acc[ai][0][m][0] * g00 * rs, x0b = acc[ai][0][m][1] * g01 * rs, x1a = acc[ai][1][m][0] * g10 * rs, x1b = acc[ai][1][m][1] * g11 * rs;
                if (!isctx) {
                    const int t = (row0 + ai * 128 + wr * 64 + m * 16 + fr) & (S - 1);
                    const int pos = ax ? (t & 63) : (t >> 6);
                    const f32x4* rp = (const f32x4*)(rope + pos * 32 + 8 * fq);
                    const f32x4 c0 = rp[0], c1 = rp[1], c2 = rp[2], c3 = rp[3];
                    f32x4 y0a, y0b, y1a, y1b;
                    y0a[0] = x0a[0] * c0[0] - x1a[0] * c0[1]; y1a[0] = x1a[0] * c0[0] + x0a[0] * c0[1];
                    y0a[1] = x0a[1] * c0[2] - x1a[1] * c0[3]; y1a[1] = x1a[1] * c0[2] + x0a[1] * c0[3];
                    y0a[2] = x0a[2] * c1[0] - x1a[2] * c1[1]; y1a[2] = x1a[2] * c1[0] + x0a[2] * c1[1];
                    y0a[3] = x0a[3] * c1[2] - x1a[3] * c1[3]; y1a[3] = x1a[3] * c1[2] + x0a[3] * c1[3];
                    y0b[0] = x0b[0] * c2[0] - x1b[0] * c2[1]; y1b[0] = x1b[0] * c2[0] + x0b[0] * c2[1];
                    y0b[1] = x0b[1] * c2[2] - x1b[1] * c2[3]; y1b[1] = x1b[1] * c2[2] + x0b[1] * c2[3];
                    y0b[2] = x0b[2] * c3[0] - x1b[2] * c3[1]; y1b[2] = x1b[2] * c3[0] + x0b[2] * c3[1];
                    y0b[3] = x0b[3] * c3[2] - x1b[3] * c3[3]; y1b[3] = x1b[3] * c3[2] + x0b[3] * c3[3];
                    x0a = y0a; x0b = y0b; x1a = y1a; x1b = y1b;
                }
                u32x4 w0, w1;
                w0[0] = pg8::cvt_pk_bf16(x0a[0], x0a[1]); w0[1] = pg8::cvt_pk_bf16(x0a[2], x0a[3]); w0[2] = pg8::cvt_pk_bf16(x0b[0], x0b[1]); w0[3] = pg8::cvt_pk_bf16(x0b[2], x0b[3]);
                w1[0] = pg8::cvt_pk_bf16(x1a[0], x1a[1]); w1[1] = pg8::cvt_pk_bf16(x1a[2], x1a[3]); w1[2] = pg8::cvt_pk_bf16(x1b[0], x1b[1]); w1[3] = pg8::cvt_pk_bf16(x1b[2], x1b[3]);
                store_rows(lds + STG_OFF + wid * 2304, (unsigned char*)(dst + (size_t)(row0 + ai * 128 + wr * 64 + m * 16) * D + colw), (size_t)D * 2, lane, w0, w1);
            }
    }
};

struct SchedFold {
    int G, c;
    __device__ __forceinline__ bool next(int i, pg8::Unit& u) const {
        const long L = (long)i * G + c; if (L >= 64) return false;
        const int part = (int)(L & 1), g = (int)((L >> 1) & 3), kt = (int)(L >> 3);
        u.pm = part * 4 + g; u.pn = kt; u.x0 = 0; u.x1 = 0; u.nt = 4; u.keep = 0; u.aoff = (long)part * 256 * 256 * 2; u.boff = ((long)kt * 256 * FW + g * 256) * 2; return true;
    }
};
struct SchedUft {
    int G, c;
    __device__ __forceinline__ bool next(int i, pg8::Unit& u) const {
        const long L = (long)i * G + c; if (L >= 256) return false;
        const int b = (int)(L >> 5), ct = (int)((L >> 3) & 3), tt = (int)(L & 7), part = tt >> 2;
        u.pm = ct; u.pn = tt; u.x0 = b; u.x1 = 0; u.nt = D / 64; u.keep = 0;
        u.aoff = (long)(part * 1024 + ct * 256) * D * 2; u.boff = ((long)b * 2048 + tt * 256) * D * 2; return true;
    }
};
struct EpiTile {
    bf16_t* base; long ld; int mode;
    __device__ __forceinline__ void operator()(f32x4 (&acc)[2][2][4][2], const pg8::Unit& u, int wr, int wc, int fr, int fq, LAS unsigned char* lds, int wid, int lane) const {
        const long row0 = (mode == 0) ? (long)u.pm * 256 : (long)u.x0 * 1024 + u.pm * 256;
        bf16_t* p0 = base + (row0 + wr * 64) * ld + u.pn * 256 + wc * 64;
#pragma unroll
        for (int ai = 0; ai < 2; ++ai)
#pragma unroll
            for (int m = 0; m < 4; ++m) {
                u32x4 w[2];
#pragma unroll
                for (int bj = 0; bj < 2; ++bj) { const f32x4 v0 = acc[ai][bj][m][0], v1 = acc[ai][bj][m][1];
                    w[bj][0] = pg8::cvt_pk_bf16(v0[0], v0[1]); w[bj][1] = pg8::cvt_pk_bf16(v0[2], v0[3]); w[bj][2] = pg8::cvt_pk_bf16(v1[0], v1[1]); w[bj][3] = pg8::cvt_pk_bf16(v1[2], v1[3]); }
                store_rows(lds + STG_OFF + wid * 2304, (unsigned char*)(p0 + (long)(ai * 128 + m * 16) * ld), (size_t)ld * 2, lane, w[0], w[1]);
            }
    }
};
struct SchedPos {
    int G, c;
    __device__ __forceinline__ bool next(int i, pg8::Unit& u) const {
        const long L = (long)i * G + c; if (L >= 256) return false;
        const int b = (int)(L >> 5), pm = (int)((L & 31) >> 2), pn = (int)(L & 3);
        u.pm = pm; u.pn = pn; u.x0 = b; u.x1 = 0; u.nt = D / 64; u.keep = 0; u.aoff = (long)pm * 256 * D * 2; u.boff = ((long)b * 1024 + pn * 256) * D * 2; return true;
    }
};
__device__ __forceinline__ float bflo(unsigned w) { return __uint_as_float(w << 16); }
__device__ __forceinline__ float bfhi(unsigned w) { return __uint_as_float(w & 0xffff0000u); }
struct EpiPos {
    const bf16_t* ZFC; bf16_t* MF; const float* PN;
    __device__ __forceinline__ void operator()(f32x4 (&acc)[2][2][4][2], const pg8::Unit& u, int wr, int wc, int fr, int fq, LAS unsigned char* lds, int wid, int lane) const {
        const int col = u.pn * 256 + wc * 64 + 8 * fq;
        const float sg = (fr & 1) ? -0.022097086912079608f : 0.022097086912079608f;
        const float* pn = PN + u.x0 * 1024 + col;
        f32x4 pv[2][2];
#pragma unroll
        for (int bj = 0; bj < 2; ++bj) { pv[bj][0] = *(const f32x4*)(pn + bj * 32) * sg; pv[bj][1] = *(const f32x4*)(pn + bj * 32 + 4) * sg; }
        LAS unsigned char* scr = lds + STG_OFF + wid * 2304;
        const size_t rw = (size_t)u.x0 * S + u.pm * 256 + wr * 64; const int cw = u.pn * 256 + wc * 64;
#define EPP_ROW(g) (rw + (size_t)(((g) >> 2) * 128 + ((g) & 3) * 16))
        RowLd cur = rows_issue((const unsigned char*)(ZFC + EPP_ROW(0) * FW + cw), (size_t)FW * 2, lane), nx1 = rows_issue((const unsigned char*)(ZFC + EPP_ROW(1) * FW + cw), (size_t)FW * 2, lane);
#pragma unroll
        for (int g = 0; g < 8; ++g) {
            RowLd nx2 = cur; if (g + 2 < 8) nx2 = rows_issue((const unsigned char*)(ZFC + EPP_ROW(g + 2) * FW + cw), (size_t)FW * 2, lane);
            const int ai = g >> 2, m = g & 3;
            u32x4 w[2], zz[2]; rows_spread(scr, lane, cur, zz[0], zz[1]);
#pragma unroll
            for (int bj = 0; bj < 2; ++bj) { const f32x4 v0 = acc[ai][bj][m][0] + pv[bj][0], v1 = acc[ai][bj][m][1] + pv[bj][1]; const u32x4 z = zz[bj];
                w[bj][0] = pg8::cvt_pk_bf16(v0[0] * bflo(z[0]), v0[1] * bfhi(z[0])); w[bj][1] = pg8::cvt_pk_bf16(v0[2] * bflo(z[1]), v0[3] * bfhi(z[1]));
                w[bj][2] = pg8::cvt_pk_bf16(v1[0] * bflo(z[2]), v1[1] * bfhi(z[2])); w[bj][3] = pg8::cvt_pk_bf16(v1[2] * bflo(z[3]), v1[3] * bfhi(z[3])); }
            store_rows(scr, (unsigned char*)(MF + EPP_ROW(g) * D + cw), (size_t)D * 2, lane, w[0], w[1]);
            cur = nx1; nx1 = nx2;
        }
#undef EPP_ROW
    }
};
struct SchedRows {
    int G, c;
    __device__ __forceinline__ bool next(int i, pg8::Unit& u) const {
        const long L = (long)i * G + c; if (L >= 512) return false;
        const int xcd = (int)(L & 7), off = (int)(L >> 3);
        u.pm = 8 * xcd + (off & 7); u.pn = off >> 3; u.x0 = 0; u.x1 = 0; u.nt = D / 64; u.keep = 0; u.aoff = (long)u.pm * 256 * D * 2; u.boff = (long)u.pn * 256 * D * 2; return true;
    }
};
struct SchedY {
    int G, c; long a2off;
    __device__ __forceinline__ bool next(int i, pg8::Unit& u) const {
        const int seg = i & 1; const long L = (long)(i >> 1) * G + c; if (L >= 512) return false;
        const int xcd = (int)(L & 7), off = (int)(L >> 3);
        u.pm = 8 * xcd + (off & 7); u.pn = off >> 3; u.x0 = seg; u.x1 = 0; u.nt = seg ? 32 : 16; u.keep = seg ? 0 : 1;
        u.aoff = (long)u.pm * 256 * D * 2 + (seg ? a2off : 0); u.boff = (long)u.pn * 256 * 3072 * 2 + (seg ? 1024 * 2 : 0); return true;
    }
};
struct EpiY {
    bf16_t* SGF; const bf16_t* SGA;
    __device__ __forceinline__ void mid(f32x4 (&acc)[2][2][4][2], const pg8::Unit& u, int wr, int wc, int fr, int fq, LAS unsigned char* lds, int wid, int lane) const {
        LAS unsigned char* scr = lds + STG_OFF + wid * 2304;
        const size_t o0 = (size_t)(u.pm * 256 + wr * 64) * D + u.pn * 256 + wc * 64;
#define EPY_OFF(g) (o0 + (size_t)(((g) >> 2) * 128 + ((g) & 3) * 16) * D)
        RowLd cf = rows_issue((const unsigned char*)(SGF + EPY_OFF(0)), (size_t)D * 2, lane), ca = rows_issue((const unsigned char*)(SGA + EPY_OFF(0)), (size_t)D * 2, lane);
        RowLd nf = rows_issue((const unsigned char*)(SGF + EPY_OFF(1)), (size_t)D * 2, lane), na = rows_issue((const unsigned char*)(SGA + EPY_OFF(1)), (size_t)D * 2, lane);
#pragma unroll
        for (int g = 0; g < 8; ++g) {
            RowLd n2f = cf, n2a = ca; if (g + 2 < 8) { n2f = rows_issue((const unsigned char*)(SGF + EPY_OFF(g + 2)), (size_t)D * 2, lane); n2a = rows_issue((const unsigned char*)(SGA + EPY_OFF(g + 2)), (size_t)D * 2, lane); }
            const int ai = g >> 2, m = g & 3;
            u32x4 gf[2], ga[2]; rows_spread(scr, lane, cf, gf[0], gf[1]); rows_spread(scr, lane, ca, ga[0], ga[1]);
#pragma unroll
            for (int bj = 0; bj < 2; ++bj) {
                f32x4& v0 = acc[ai][bj][m][0]; f32x4& v1 = acc[ai][bj][m][1];
                v0[0] *= bflo(gf[bj][0]) * __builtin_amdgcn_rcpf(bflo(ga[bj][0])); v0[1] *= bfhi(gf[bj][0]) * __builtin_amdgcn_rcpf(bfhi(ga[bj][0]));
                v0[2] *= bflo(gf[bj][1]) * __builtin_amdgcn_rcpf(bflo(ga[bj][1])); v0[3] *= bfhi(gf[bj][1]) * __builtin_amdgcn_rcpf(bfhi(ga[bj][1]));
                v1[0] *= bflo(gf[bj][2]) * __builtin_amdgcn_rcpf(bflo(ga[bj][2])); v1[1] *= bfhi(gf[bj][2]) * __builtin_amdgcn_rcpf(bfhi(ga[bj][2]));
                v1[2] *= bflo(gf[bj][3]) * __builtin_amdgcn_rcpf(bflo(ga[bj][3])); v1[3] *= bfhi(gf[bj][3]) * __builtin_amdgcn_rcpf(bfhi(ga[bj][3]));
            }
            cf = nf; ca = na; nf = n2f; na = n2a;
        }
    }
    __device__ __forceinline__ void operator()(f32x4 (&acc)[2][2][4][2], const pg8::Unit& u, int wr, int wc, int fr, int fq, LAS unsigned char* lds, int wid, int lane) const {
        if (u.x0 == 0) { mid(acc, u, wr, wc, fr, fq, lds, wid, lane); return; }
        LAS unsigned char* scr = lds + STG_OFF + wid * 2304;
        const size_t o0 = (size_t)(u.pm * 256 + wr * 64) * D + u.pn * 256 + wc * 64;
        RowLd cur = rows_issue((const unsigned char*)(SGA + EPY_OFF(0)), (size_t)D * 2, lane), nx1 = rows_issue((const unsigned char*)(SGA + EPY_OFF(1)), (size_t)D * 2, lane);
#pragma unroll
        for (int g = 0; g < 8; ++g) {
            RowLd nx2 = cur; if (g + 2 < 8) nx2 = rows_issue((const unsigned char*)(SGA + EPY_OFF(g + 2)), (size_t)D * 2, lane);
            const int ai = g >> 2, m = g & 3;
            u32x4 w[2], gg[2]; rows_spread(scr, lane, cur, gg[0], gg[1]);
#pragma unroll
            for (int bj = 0; bj < 2; ++bj) { const u32x4 ga = gg[bj]; const f32x4 v0 = acc[ai][bj][m][0], v1 = acc[ai][bj][m][1];
                w[bj][0] = pg8::cvt_pk_bf16(v0[0] * bflo(ga[0]), v0[1] * bfhi(ga[0])); w[bj][1] = pg8::cvt_pk_bf16(v0[2] * bflo(ga[1]), v0[3] * bfhi(ga[1]));
                w[bj][2] = pg8::cvt_pk_bf16(v1[0] * bflo(ga[2]), v1[1] * bfhi(ga[2])); w[bj][3] = pg8::cvt_pk_bf16(v1[2] * bflo(ga[3]), v1[3] * bfhi(ga[3])); }
            store_rows(scr, (unsigned char*)(SGF + EPY_OFF(g)), (size_t)D * 2, lane, w[0], w[1]);
            cur = nx1; nx1 = nx2;
        }
#undef EPY_OFF
    }
};
struct EpiOut {
    const float* x; const float* mod; float* out;
    __device__ __forceinline__ void operator()(f32x4 (&acc)[2][2][4][2], const pg8::Unit& u, int wr, int wc, int fr, int fq, LAS unsigned char* lds, int wid, int lane) const {
        const int col = u.pn * 256 + wc * 64 + 8 * fq;
        const float* gate = mod + (size_t)(u.pm >> 3) * 3 * D + 2 * D + col;
        f32x4 gt[2][2];
#pragma unroll
        for (int bj = 0; bj < 2; ++bj) { gt[bj][0] = *(const f32x4*)(gate + bj * 32); gt[bj][1] = *(const f32x4*)(gate + bj * 32 + 4); }
        LAS unsigned char* scr = lds + STG_OFF + wid * 2304;
        const size_t o0 = (size_t)(u.pm * 256 + wr * 64) * D + u.pn * 256 + wc * 64;
#define EPO_OFF(g) (o0 + (size_t)((((g) >> 3) & 1) * 128 + (((g) >> 1) & 3) * 16) * D + ((g) & 1) * 32)
        RowLd cur = rows_issue((const unsigned char*)(x + EPO_OFF(0)), (size_t)D * 4, lane), nx1 = rows_issue((const unsigned char*)(x + EPO_OFF(1)), (size_t)D * 4, lane);
#pragma unroll
        for (int g = 0; g < 16; ++g) {
            RowLd nx2 = cur; if (g + 2 < 16) nx2 = rows_issue((const unsigned char*)(x + EPO_OFF(g + 2)), (size_t)D * 4, lane);
            const int ai = (g >> 3) & 1, m = (g >> 1) & 3, bj = g & 1;
            u32x4 x0, x1; rows_spread<true>(scr, lane, cur, x0, x1);
            const f32x4 r0 = __builtin_bit_cast(f32x4, x0) + gt[bj][0] * acc[ai][bj][m][0], r1 = __builtin_bit_cast(f32x4, x1) + gt[bj][1] * acc[ai][bj][m][1];
            store_rows<true>(scr, (unsigned char*)(out + EPO_OFF(g)), (size_t)D * 4, lane, __builtin_bit_cast(u32x4, r0), __builtin_bit_cast(u32x4, r1));
            cur = nx1; nx1 = nx2;
        }
#undef EPO_OFF
    }
};

namespace natt {
typedef short v4i16_t __attribute__((ext_vector_type(4)));
__device__ __forceinline__ v4i16_t vtr(const LAS unsigned char* p) { return __builtin_amdgcn_ds_read_tr16_b64_v4i16((LAS v4i16_t*)p); }
struct Tensors { const bf16_t* Q; bf16_t* O; const bf16_t* K; const bf16_t* V; const bf16_t* KC; const bf16_t* VC; const bf16_t* SZA; const float* rpb; const float* shift; };

__device__ __forceinline__ bf16x8 softmax_pack(const f32x4& sx, const f32x4& sy, float& lsum, bool local, const int (&dcv)[2][4], const LAS float* Trow, float shift) {
    float px[4], py[4];
#pragma unroll
    for (int j = 0; j < 4; ++j) {
        if (local) {
            const int ix = dcv[0][j], iy = dcv[1][j];
            const float bx = Trow[ix < 0 ? 0 : ix], by = Trow[iy < 0 ? 0 : iy];
            px[j] = ix < 0 ? 0.f : __builtin_amdgcn_exp2f(sx[j] + bx);
            py[j] = iy < 0 ? 0.f : __builtin_amdgcn_exp2f(sy[j] + by);
        } else { px[j] = __builtin_amdgcn_exp2f(sx[j]); py[j] = __builtin_amdgcn_exp2f(sy[j]); }
    }
    lsum += ((px[0] + px[1]) + (px[2] + px[3])) + ((py[0] + py[1]) + (py[2] + py[3]));
    u32x4 pw; pw[0] = pg8::cvt_pk_bf16(px[0], px[1]); pw[1] = pg8::cvt_pk_bf16(px[2], px[3]); pw[2] = pg8::cvt_pk_bf16(py[0], py[1]); pw[3] = pg8::cvt_pk_bf16(py[2], py[3]);
    return __builtin_bit_cast(bf16x8, pw);
}
__device__ __forceinline__ void glds16(const void* gsrc, unsigned lds_dst) { unsigned keep;
    asm volatile("s_mov_b32 %0, m0\n\ts_mov_b32 m0, %2\n\ts_nop 0\n\tglobal_load_lds_dwordx4 %1, off\n\ts_mov_b32 m0, %0" : "=&s"(keep) : "v"(gsrc), "s"(lds_dst) : "memory"); }
#define NATT_R128(dst, addr, off) asm volatile("ds_read_b128 %0, %1 offset:%2" : "=v"(dst) : "v"(addr), "i"(off))
#define NATT_TR64(dst, addr, off) asm volatile("ds_read_b64_tr_b16 %0, %1 offset:%2" : "=v"(dst) : "v"(addr), "i"(off))
#define NATT_WAIT(n) do { __builtin_amdgcn_sched_barrier(0); asm volatile("s_waitcnt lgkmcnt(" #n ")" ::: "memory"); __builtin_amdgcn_sched_barrier(0); } while (0)
#define NATT_VF(x, y) (bf16x8){x[0], x[1], x[2], x[3], y[0], y[1], y[2], y[3]}
template <bool LOCAL>
__device__ __forceinline__ void step2(unsigned Kb, unsigned Vb, int kbA, int kbB, const bf16x8 (&qA)[4], const bf16x8 (&qB)[4], f32x4 (&oA)[8], f32x4 (&oB)[8],
                                      float& lA, float& lB, int fr, int fq, const int (&dcvA)[2][4], const int (&dcvB)[2][4], const LAS float* Trow, float shift) {
    if (LOCAL) asm volatile("" : "+v"(fr), "+v"(fq));
    const int krA = kbA + fr, krB = kbB + fr, ch = (fr & 3) >> 1;
    const int vrA = kbA + 4 * fq + (fr >> 2), swA = (vrA & 7) << 1, vrB = kbB + 4 * fq + (fr >> 2), swB = (vrB & 7) << 1;
    const unsigned vaA = Vb + vrA * 256 + (fr & 1) * 8, vaB = Vb + vrB * 256 + (fr & 1) * 8;
    bf16x8 kxA[4], kyA[4], kxB[4], kyB[4];
#pragma unroll
    for (int ks = 0; ks < 4; ++ks) { const unsigned a = Kb + krA * 256 + (((4 * ks + fq) ^ (krA & 15)) << 4); NATT_R128(kxA[ks], a, 0); NATT_R128(kyA[ks], a, 4096); }
    if (LOCAL) {
#pragma unroll
        for (int ks = 0; ks < 4; ++ks) { const unsigned a = Kb + krB * 256 + (((4 * ks + fq) ^ (krB & 15)) << 4); NATT_R128(kxB[ks], a, 0); NATT_R128(kyB[ks], a, 4096); }
    }
    v4i16_t x0[4], y0[4], x1[4], y1[4];
#pragma unroll
    for (int d = 0; d < 4; ++d) { const unsigned a = vaA + (((2 * d + ch) ^ swA) << 4); NATT_TR64(x0[d], a, 0); NATT_TR64(y0[d], a, 4096); }
    NATT_WAIT(8);
    f32x4 sxA = (f32x4){-shift, -shift, -shift, -shift}, syA = sxA, sxB = sxA, syB = sxA;
#pragma unroll
    for (int ks = 0; ks < 4; ++ks) {
        sxA = __builtin_amdgcn_mfma_f32_16x16x32_bf16(kxA[ks], qA[ks], sxA, 0, 0, 0);
        syA = __builtin_amdgcn_mfma_f32_16x16x32_bf16(kyA[ks], qA[ks], syA, 0, 0, 0);
        sxB = __builtin_amdgcn_mfma_f32_16x16x32_bf16(LOCAL ? kxB[ks] : kxA[ks], qB[ks], sxB, 0, 0, 0);
        syB = __builtin_amdgcn_mfma_f32_16x16x32_bf16(LOCAL ? kyB[ks] : kyA[ks], qB[ks], syB, 0, 0, 0);
    }
    const bf16x8 pbA = softmax_pack(sxA, syA, lA, LOCAL, dcvA, Trow, shift);
    const bf16x8 pbB = softmax_pack(sxB, syB, lB, LOCAL, dcvB, Trow, shift);
    NATT_WAIT(0);
#pragma unroll
    for (int d = 0; d < 4; ++d) { const unsigned a = vaA + (((2 * (d + 4) + ch) ^ swA) << 4); NATT_TR64(x1[d], a, 0); NATT_TR64(y1[d], a, 4096); }
    __builtin_amdgcn_sched_barrier(0);
#pragma unroll
    for (int d = 0; d < 4; ++d) { const bf16x8 vf = NATT_VF(x0[d], y0[d]); oA[d] = __builtin_amdgcn_mfma_f32_16x16x32_bf16(vf, pbA, oA[d], 0, 0, 0); if (!LOCAL) oB[d] = __builtin_amdgcn_mfma_f32_16x16x32_bf16(vf, pbB, oB[d], 0, 0, 0); }
    NATT_WAIT(0);
    if (LOCAL) {
#pragma unroll
        for (int d = 0; d < 4; ++d) { const unsigned a = vaB + (((2 * d + ch) ^ swB) << 4); NATT_TR64(x0[d], a, 0); NATT_TR64(y0[d], a, 4096); }
        __builtin_amdgcn_sched_barrier(0);
    }
#pragma unroll
    for (int d = 0; d < 4; ++d) { const bf16x8 vf = NATT_VF(x1[d], y1[d]); oA[d + 4] = __builtin_amdgcn_mfma_f32_16x16x32_bf16(vf, pbA, oA[d + 4], 0, 0, 0); if (!LOCAL) oB[d + 4] = __builtin_amdgcn_mfma_f32_16x16x32_bf16(vf, pbB, oB[d + 4], 0, 0, 0); }
    if (LOCAL) {
        NATT_WAIT(0);
#pragma unroll
        for (int d = 0; d < 4; ++d) { const unsigned a = vaB + (((2 * (d + 4) + ch) ^ swB) << 4); NATT_TR64(x1[d], a, 0); NATT_TR64(y1[d], a, 4096); }
        __builtin_amdgcn_sched_barrier(0);
#pragma unroll
        for (int d = 0; d < 4; ++d) { const bf16x8 vf = NATT_VF(x0[d], y0[d]); oB[d] = __builtin_amdgcn_mfma_f32_16x16x32_bf16(vf, pbB, oB[d], 0, 0, 0); }
        NATT_WAIT(0);
#pragma unroll
        for (int d = 0; d < 4; ++d) { const bf16x8 vf = NATT_VF(x1[d], y1[d]); oB[d + 4] = __builtin_amdgcn_mfma_f32_16x16x32_bf16(vf, pbB, oB[d + 4], 0, 0, 0); }
    }
}

__device__ __forceinline__ void attn_phase(LAS unsigned char* lds, const Tensors& T, int vcu) {
    int tid = threadIdx.x; asm volatile("" : "+v"(tid));
    const int lane = tid & 63, wid = __builtin_amdgcn_readfirstlane(tid >> 6), fr = lane & 15, fq = lane >> 4;
    const unsigned lds0 = (unsigned)(size_t)lds;
    LAS float* Tb = (LAS float*)(lds + XCH_OFF);
    float shift = T.shift[0]; asm volatile("" : "+v"(shift));
    const int sA = 2 * (wid & 1), sB = sA + 1, wq = wid >> 1;
    const int cwA = (sA == 0) ? 0 : 24, cwB = (sB == 1) ? 8 : 32;
    int dcvA[2][4], dcvB[2][4];
    {   const int cA = 16 * sA + fr, cstA = min(max(cA - 8, 0), 48), cB = 16 * sB + fr, cstB = min(max(cB - 8, 0), 48);
#pragma unroll
        for (int blk = 0; blk < 2; ++blk)
#pragma unroll
            for (int j = 0; j < 4; ++j) { const int kcA = cwA + 16 * blk + 4 * fq + j, kcB = cwB + 16 * blk + 4 * fq + j;
                dcvA[blk][j] = (kcA >= cstA && kcA < cstA + 16) ? (kcA - cA + 15) : -1; dcvB[blk][j] = (kcB >= cstB && kcB < cstB + 16) ? (kcB - cB + 15) : -1; } }
    const bool isV = wid >= 4;
    const int drow = 32 * (wid & 3) + (lane >> 4), dp = lane & 15;
    for (int ui = 0; ui < 4; ++ui) {
        const int bh = (vcu >> 5) * 16 + ((vcu >> 3) & 3) * 4 + ui, b = bh >> 4, h = bh & 15;
        for (int i = tid; i < 465; i += NWAVES * 64) Tb[i] = T.rpb[h * 465 + i] * 1.4426950408889634f;
        const int rq = (vcu + 2 * ui) & 7, r0 = 4 * rq, qrow = r0 + wq;
        const int rsu = min(max(r0 - 4, 0), 24), nl = min(max(r0 - 1, 0), 24) + 8 - rsu, rsq = min(max(qrow - 4, 0), 24);
        const int ntile = 2 + ((nl + 1) >> 1);
        const size_t qtok = (size_t)b * S + qrow * 64 + 16 * sA + fr;
        const bf16_t* qp = T.Q + qtok * D + h * HD; bf16_t* op = T.O + qtok * D + h * HD;
        bf16x8 qA[4], qB[4];
#pragma unroll
        for (int ks = 0; ks < 4; ++ks) { qA[ks] = *(const bf16x8*)(qp + 32 * ks + 8 * fq); qB[ks] = *(const bf16x8*)(qp + (size_t)16 * D + 32 * ks + 8 * fq); }
        f32x4 oA[8], oB[8];
#pragma unroll
        for (int db = 0; db < 8; ++db) { oA[db] = (f32x4){0.f, 0.f, 0.f, 0.f}; oB[db] = (f32x4){0.f, 0.f, 0.f, 0.f}; }
        float lA = 0.f, lB = 0.f;
        asm volatile("" : "+v"(qA[0]), "+v"(qA[1]), "+v"(qA[2]), "+v"(qA[3]), "+v"(qB[0]), "+v"(qB[1]), "+v"(qB[2]), "+v"(qB[3]));
#define NATT_ISSUE(j) do { const int j_ = (j); const bf16_t* src_; bool go_ = true; \
            if (j_ < 2) src_ = (isV ? T.VC : T.KC) + ((size_t)b * L + 128 * j_) * D + h * HD; \
            else { src_ = (isV ? T.V : T.K) + ((size_t)b * S + (rsu + 2 * (j_ - 2)) * 64) * D + h * HD; go_ = ((wid & 3) < 2) || (2 * (j_ - 2) + 1 < nl); } \
            if (go_) { int drow_ = drow, dp_ = dp; asm volatile("" : "+v"(drow_), "+v"(dp_)); \
            const unsigned dst_ = (unsigned)__builtin_amdgcn_readfirstlane(lds0 + (j_ & 1) * 65536 + (isV ? 32768 : 0) + (wid & 3) * 8192); \
            _Pragma("unroll") for (int e_ = 0; e_ < 8; ++e_) { const int row_ = drow_ + 4 * e_; const int c_ = isV ? (dp_ ^ ((row_ & 7) << 1)) : (dp_ ^ (row_ & 15)); \
                glds16(src_ + (size_t)row_ * D + c_ * 8, dst_ + e_ * 1024); } } } while (0)
#define NATT_TILE_SYNC() do { asm volatile("s_waitcnt vmcnt(0) lgkmcnt(0)\n\ts_barrier" ::: "memory"); __builtin_amdgcn_sched_barrier(0); } while (0)
        NATT_ISSUE(0);
#pragma unroll 1
        for (int j = 0; j < 2; ++j) {
            NATT_TILE_SYNC();
            NATT_ISSUE(j + 1);
            const unsigned Kb = lds0 + (j & 1) * 65536, Vb = Kb + 32768;
#pragma unroll 1
            for (int pr = 0; pr < 4; ++pr) step2<false>(Kb, Vb, 32 * pr, 32 * pr, qA, qB, oA, oB, lA, lB, fr, fq, dcvA, dcvB, Tb, shift);
        }
#pragma unroll 1
        for (int j = 2; j < ntile; ++j) {
            NATT_TILE_SYNC();
            if (j + 1 < ntile) NATT_ISSUE(j + 1);
            const unsigned Kb = lds0 + (j & 1) * 65536, Vb = Kb + 32768;
#pragma unroll 1
            for (int hr = 0; hr < 2; ++hr) {
                const int kr = rsu + 2 * (j - 2) + hr;
                if (kr >= rsq && kr < rsq + 8) step2<true>(Kb, Vb, 64 * hr + cwA, 64 * hr + cwB, qA, qB, oA, oB, lA, lB, fr, fq, dcvA, dcvB, Tb + (kr - qrow + 7) * 31, shift);
            }
        }
#undef NATT_ISSUE
        asm volatile("s_waitcnt lgkmcnt(0)\n\ts_barrier" ::: "memory"); __builtin_amdgcn_sched_barrier(0);
        lA += __shfl_xor(lA, 16); lA += __shfl_xor(lA, 32); lB += __shfl_xor(lB, 16); lB += __shfl_xor(lB, 32);
        const float invA = 1.0f / lA, invB = 1.0f / lB;
        const bf16_t* zp = T.SZA + qtok * D + h * HD + 4 * fq;
#pragma unroll
        for (int db = 0; db < 8; ++db) {
            const u32x2 zA = *(const u32x2*)(zp + 16 * db), zB = *(const u32x2*)(zp + (size_t)16 * D + 16 * db);
            u32x2 w; w[0] = pg8::cvt_pk_bf16(oA[db][0] * invA * bflo(zA[0]), oA[db][1] * invA * bfhi(zA[0])); w[1] = pg8::cvt_pk_bf16(oA[db][2] * invA * bflo(zA[1]), oA[db][3] * invA * bfhi(zA[1]));
            *(u32x2*)(op + 16 * db + 4 * fq) = w;
            w[0] = pg8::cvt_pk_bf16(oB[db][0] * invB * bflo(zB[0]), oB[db][1] * invB * bfhi(zB[0])); w[1] = pg8::cvt_pk_bf16(oB[db][2] * invB * bflo(zB[1]), oB[db][3] * invB * bfhi(zB[1]));
            *(u32x2*)(op + (size_t)16 * D + 16 * db + 4 * fq) = w;
        }
    }
}
}

struct MArgs { const float* in[13]; float* out; unsigned char* ws; int ph_lo, ph_hi, li, pad; };
struct Frame {
    LAS unsigned char* lds; volatile LAS unsigned* MISC; unsigned* ctl; int tid, lane, wave, vcu, G;
};
__device__ __forceinline__ unsigned pk2(float lo, float hi) { return f2bf(lo) | (f2bf(hi) << 16); }

__device__ __forceinline__ void p0_transpose_item(const float* W, int N, bf16_t* WT, int ldo, int koff, int k0, int n0, int lane) {
    f32x4 v[16];
    const float* src = W + (size_t)k0 * N + n0 + 4 * lane;
#pragma unroll
    for (int kk = 0; kk < 16; ++kk) v[kk] = __builtin_nontemporal_load((const f32x4*)(src + (size_t)kk * N));
#pragma unroll
    for (int j = 0; j < 4; ++j) {
        u32x4 a, b;
        a[0] = pk2(v[0][j], v[1][j]); a[1] = pk2(v[2][j], v[3][j]); a[2] = pk2(v[4][j], v[5][j]); a[3] = pk2(v[6][j], v[7][j]);
        b[0] = pk2(v[8][j], v[9][j]); b[1] = pk2(v[10][j], v[11][j]); b[2] = pk2(v[12][j], v[13][j]); b[3] = pk2(v[14][j], v[15][j]);
        bf16_t* dst = WT + (size_t)(n0 + 4 * lane + j) * ldo + koff + k0;
        *(u32x4*)dst = a; *(u32x4*)(dst + 8) = b;
    }
}
struct CopyItem { const float* W; bf16_t* WT; int N, ldo, koff, k0, n0; };
__device__ __forceinline__ void p0_copy_load(const CopyItem& c, int wave, int lane, f32x4 (&v)[8][2]) {
    const float* src = c.W + (size_t)(c.k0 + 8 * wave) * c.N + c.n0 + 4 * lane;
#pragma unroll
    for (int r = 0; r < 8; ++r) { v[r][0] = __builtin_nontemporal_load((const f32x4*)(src + (size_t)r * c.N)); v[r][1] = __builtin_nontemporal_load((const f32x4*)(src + (size_t)r * c.N + 256)); }
}
__device__ __forceinline__ void p0_copy_finish(const CopyItem& c, LAS unsigned char* T, int wave, int lane, const f32x4 (&v)[8][2]) {
#pragma unroll
    for (int i = 0; i < 2; ++i)
#pragma unroll
        for (int j = 0; j < 4; ++j) {
            u32x4 a; a[0] = pk2(v[0][i][j], v[1][i][j]); a[1] = pk2(v[2][i][j], v[3][i][j]); a[2] = pk2(v[4][i][j], v[5][i][j]); a[3] = pk2(v[6][i][j], v[7][i][j]);
            *(LAS u32x4*)(T + (256 * i + 4 * lane + j) * 144 + wave * 16) = a;
        }
    __syncthreads();
#pragma unroll
    for (int e = 0; e < 8; ++e) {
        const int n = wave * 64 + 8 * e + (lane >> 3), p = lane & 7;
        const u32x4 w = *(const LAS u32x4*)(T + n * 144 + p * 16);
        *(u32x4*)(c.WT + (size_t)(c.n0 + n) * c.ldo + c.koff + c.k0 + 8 * p) = w;
    }
    __syncthreads();
}
__device__ __forceinline__ void p0_mod_item(const float* c, const float* cctx, const float* wmod, const float* bmod, float* mod, LAS unsigned char* lds, int item, int wave, int lane) {
    LAS float* scr = (LAS float*)(lds + wave * 16384);
    LAS f32x4* red = (LAS f32x4*)(lds + 131072 + 1024);
    const int j0 = item * 16, fq = lane >> 4, fr = lane & 15, k0 = wave * 256;
    const float* wp = wmod + (size_t)(k0 + fq) * (3 * D) + j0 + fr;
    float w[64];
#pragma unroll
    for (int i = 0; i < 64; ++i) w[i] = __builtin_nontemporal_load(wp + (size_t)(4 * i) * (3 * D));
#pragma unroll 4
    for (int i = 0; i < 64; ++i) { const int idx = i * 64 + lane, b = idx >> 8, kk = idx & 255; float v = 0.f; if (b < 9) { const float z = (b < 8) ? c[b * D + k0 + kk] : cctx[k0 + kk]; v = z / (1.0f + __expf(-z)); } scr[idx] = v; }
    LDS_WAIT(); asm volatile("" ::: "memory");
    f32x4 acc0 = (f32x4){0.f, 0.f, 0.f, 0.f}, acc1 = (f32x4){0.f, 0.f, 0.f, 0.f};
#pragma unroll
    for (int i = 0; i < 64; i += 2) {
        acc0 = __builtin_amdgcn_mfma_f32_16x16x4f32(scr[fr * 256 + 4 * i + fq], w[i], acc0, 0, 0, 0);
        acc1 = __builtin_amdgcn_mfma_f32_16x16x4f32(scr[fr * 256 + 4 * i + 4 + fq], w[i + 1], acc1, 0, 0, 0);
    }
    red[wave * 64 + lane] = acc0 + acc1;
    __syncthreads();
    if (wave == 0) {
        f32x4 t = red[lane];
#pragma unroll
        for (int ww = 1; ww < 8; ++ww) t += red[ww * 64 + lane];
#pragma unroll
        for (int r = 0; r < 4; ++r) { const int b = 4 * fq + r; if (b < 9) mod[b * 3 * D + j0 + fr] = t[r] + bmod[j0 + fr]; }
    }
    __syncthreads();
}
__device__ __forceinline__ void p0_table_item(float2* rope, bf16_t* CS, bf16_t* DFTA, const float* qg, const float* kg, const float* rpbp, float* shiftp, int item, int lane) {
    if (item == 0) {
        for (int i = 0; i < 32; ++i) { const int gid = i * 64 + lane, pos = gid >> 5, j = gid & 31;
            const float invf = exp2f(-(float)j * 0.41524101186092029f); const float ang = (float)pos * invf; float sn, cs; sincosf(ang, &sn, &cs);
            rope[gid] = make_float2(cs, sn); }
        float mq = fmaxf(fabsf(qg[lane]), fabsf(qg[lane + 64])), mk = fmaxf(fabsf(kg[lane]), fabsf(kg[lane + 64])), mb = 0.f;
        for (int i = lane; i < NH * 465; i += 64) mb = fmaxf(mb, rpbp[i]);
        mq = wave_max(mq); mk = wave_max(mk); mb = wave_max(mb);
        if (lane == 0) shiftp[0] = (11.313708498984761f * mq * mk + mb) * 1.4426950408889634f;
    } else if (item <= 32) {
        const int base = (item - 1) * 4096;
#pragma unroll
        for (int i = 0; i < 8; ++i) { const int e0 = base + (i * 64 + lane) * 8; unsigned w[4];
#pragma unroll
            for (int q = 0; q < 4; ++q) { float v[2];
#pragma unroll
                for (int z = 0; z < 2; ++z) { const int e = e0 + 2 * q + z, part = e >> 16, cp = (e >> 8) & 255, cc = e & 255, mm = (cp * cc) & 255;
                    const float rev = (float)mm * (1.0f / 256.0f); v[z] = (part == 0 ? __builtin_amdgcn_cosf(rev) : -__builtin_amdgcn_sinf(rev)) * 0.0625f; }
                w[q] = pk2(v[0], v[1]); }
            *(u32x4*)(CS + e0) = (u32x4){w[0], w[1], w[2], w[3]}; }
    } else {
        const int k1 = item - 33;
#pragma unroll
        for (int i = 0; i < 4; ++i) { const int kk0 = (i * 64 + lane) * 8; unsigned w[4];
#pragma unroll
            for (int q = 0; q < 4; ++q) { float v[2];
#pragma unroll
                for (int z = 0; z < 2; ++z) { const int kk = kk0 + 2 * q + z, part = kk >> 10, n = kk & 1023, mm = (k1 * n) & 2047;
                    const float rev = (float)mm * (1.0f / 2048.0f); v[z] = (part == 0 ? __builtin_amdgcn_cosf(rev) : __builtin_amdgcn_sinf(rev)) * 0.022097086912079608f; }
                w[q] = pk2(v[0], v[1]); }
            *(u32x4*)(DFTA + (size_t)k1 * 2048 + kk0) = (u32x4){w[0], w[1], w[2], w[3]}; }
    }
}
__device__ __forceinline__ void p0_wuf_row(const float* win, bf16_t* Wuf, int k, int lane) {
    const float* src = win + (size_t)k * INW + lane * 16;
    const f32x4 a = *(const f32x4*)(src), b = *(const f32x4*)(src + 4), c = *(const f32x4*)(src + 8), d = *(const f32x4*)(src + 12);
    u32x4 w0, w1; w0[0] = pk2(a[0], a[1]); w0[1] = pk2(a[2], a[3]); w0[2] = pk2(b[0], b[1]); w0[3] = pk2(b[2], b[3]);
    w1[0] = pk2(c[0], c[1]); w1[1] = pk2(c[2], c[3]); w1[2] = pk2(d[0], d[1]); w1[3] = pk2(d[2], d[3]);
    bf16_t* dst = Wuf + (size_t)k * FW + lane * 16;
    *(u32x4*)dst = w0; *(u32x4*)(dst + 8) = w1;
}
__device__ __forceinline__ void p1_hnorm_row(const float* src, const float* shift, const float* scale, bf16_t* dst, int lane) {
    f32x4 v[8]; float ss = 0.f;
#pragma unroll
    for (int j = 0; j < 8; ++j) { v[j] = *(const f32x4*)(src + (j * 64 + lane) * 4); ss += (v[j][0] * v[j][0] + v[j][1] * v[j][1]) + (v[j][2] * v[j][2] + v[j][3] * v[j][3]); }
    ss = wave_sum(ss);
    const float rstd = 1.0f / sqrtf(ss * (1.0f / D) + 1e-6f);
#pragma unroll
    for (int j = 0; j < 8; ++j) {
        const int k = (j * 64 + lane) * 4;
        const f32x4 sc = *(const f32x4*)(scale + k), sh = *(const f32x4*)(shift + k);
        u32x2 o;
        o[0] = pk2(v[j][0] * rstd * (1.f + sc[0]) + sh[0], v[j][1] * rstd * (1.f + sc[1]) + sh[1]);
        o[1] = pk2(v[j][2] * rstd * (1.f + sc[2]) + sh[2], v[j][3] * rstd * (1.f + sc[3]) + sh[3]);
        *(u32x2*)(dst + k) = o;
    }
}
__device__ __forceinline__ void p1_pair_load(const float* xb, int n, int lane, f32x4 (&a)[8], f32x4 (&b)[8]) {
    const int n2 = (n == 0) ? 1024 : 2048 - n;
    const float* s0 = xb + (size_t)n * D; const float* s1 = xb + (size_t)n2 * D;
#pragma unroll
    for (int j = 0; j < 8; ++j) { a[j] = __builtin_nontemporal_load((const f32x4*)(s0 + (j * 64 + lane) * 4)); b[j] = __builtin_nontemporal_load((const f32x4*)(s1 + (j * 64 + lane) * 4)); }
}
__device__ __forceinline__ void p1_pair_finish(const f32x4 (&a)[8], const f32x4 (&b)[8], const float* shift, const float* scale, bf16_t* Hb, bf16_t* HEb, int n, int lane) {
    const int n2 = (n == 0) ? 1024 : 2048 - n;
    float sa = 0.f, sb = 0.f;
#pragma unroll
    for (int j = 0; j < 8; ++j) { sa += (a[j][0] * a[j][0] + a[j][1] * a[j][1]) + (a[j][2] * a[j][2] + a[j][3] * a[j][3]); sb += (b[j][0] * b[j][0] + b[j][1] * b[j][1]) + (b[j][2] * b[j][2] + b[j][3] * b[j][3]); }
    sa = wave_sum(sa); sb = wave_sum(sb);
    const float ra = 1.0f / sqrtf(sa * (1.0f / D) + 1e-6f), rb = 1.0f / sqrtf(sb * (1.0f / D) + 1e-6f);
#pragma unroll
    for (int j = 0; j < 8; ++j) {
        const int k = (j * 64 + lane) * 4;
        const f32x4 sc = *(const f32x4*)(scale + k), sh = *(const f32x4*)(shift + k);
        const f32x4 ha = a[j] * ra * (sc + 1.f) + sh, hb = b[j] * rb * (sc + 1.f) + sh;
        u32x2 o; o[0] = pk2(ha[0], ha[1]); o[1] = pk2(ha[2], ha[3]); *(u32x2*)(Hb + (size_t)n * D + k) = o;
        o[0] = pk2(hb[0], hb[1]); o[1] = pk2(hb[2], hb[3]); *(u32x2*)(Hb + (size_t)n2 * D + k) = o;
        f32x4 he, ho;
        if (n == 0) { he = ha; ho = (f32x4){0.f, 0.f, 0.f, 0.f}; } else { he = ha + hb; ho = ha - hb; }
        o[0] = pk2(he[0], he[1]); o[1] = pk2(he[2], he[3]); *(u32x2*)(HEb + (size_t)n * D + k) = o;
        o[0] = pk2(ho[0], ho[1]); o[1] = pk2(ho[2], ho[3]); *(u32x2*)(HEb + (size_t)(1024 + n) * D + k) = o;
    }
}
__device__ __forceinline__ void p3_pn_item(const bf16_t* H, const bf16_t* WPQ, float* PN, int item, int lane) {
    const int ch0 = item * 2;
    u32x4 w[2][4];
#pragma unroll
    for (int c = 0; c < 2; ++c)
#pragma unroll
        for (int q = 0; q < 4; ++q) w[c][q] = *(const u32x4*)(WPQ + (size_t)(ch0 + c) * D + (q * 64 + lane) * 8);
#pragma unroll 1
    for (int b = 0; b < NB; ++b) {
        const bf16_t* hr = H + ((size_t)b * S + 1024) * D;
        float a0 = 0.f, a1 = 0.f;
#pragma unroll
        for (int q = 0; q < 4; ++q) { const u32x4 hv = *(const u32x4*)(hr + (q * 64 + lane) * 8);
#pragma unroll
            for (int e = 0; e < 4; ++e) { a0 += bflo(hv[e]) * bflo(w[0][q][e]) + bfhi(hv[e]) * bfhi(w[0][q][e]); a1 += bflo(hv[e]) * bflo(w[1][q][e]) + bfhi(hv[e]) * bfhi(w[1][q][e]); } }
        a0 = wave_sum(a0); a1 = wave_sum(a1);
        if (lane < 2) PN[b * 1024 + ch0 + lane] = lane ? a1 : a0;
    }
}

__global__ void __launch_bounds__(NWAVES * 64, 2) mega_fwd(MArgs args) {
    extern __shared__ __attribute__((aligned(16))) unsigned char lds_raw[];
    Frame F;
    F.lds = (LAS unsigned char*)lds_raw;
    F.MISC = (volatile LAS unsigned*)(F.lds + MISC_OFF);
    F.tid = threadIdx.x; F.lane = F.tid & 63; F.wave = __builtin_amdgcn_readfirstlane(F.tid >> 6);
    F.G = gridDim.x; { const int bx = blockIdx.x; F.vcu = (F.G % 8 == 0) ? (bx % 8) * (F.G / 8) + bx / 8 : bx; }
    unsigned char* ws = args.ws; unsigned char* dob = (unsigned char*)args.out;
    F.ctl = (unsigned*)(ws + WS_CTL);
    const float* x = args.in[0]; const float* c = args.in[1]; const float* ctx = args.in[2]; const float* cctx = args.in[3];
    const float* wmod = args.in[4]; const float* bmod = args.in[5]; const float* win = args.in[6];
    const float* qg = args.in[7]; const float* kg = args.in[8]; const float* rpb = args.in[9];
    float* shiftp = (float*)(ws + WS_ROPE + 65536);
    const float* wf = args.in[10]; const float* wa = args.in[11]; const float* wo = args.in[12];
    bf16_t* Wfa_t = (bf16_t*)(ws + WS_WFA); bf16_t* Wo_t = (bf16_t*)(ws + WS_WO); bf16_t* DFTA = (bf16_t*)(ws + WS_DFTA); bf16_t* CS = (bf16_t*)(ws + WS_CS);
    bf16_t* WPQ = (bf16_t*)(ws + WS_WPQ); bf16_t* HEO = (bf16_t*)(ws + WS_HEO); bf16_t* PQT = (bf16_t*)(ws + WS_PQT); float* PN = (float*)(ws + WS_PN);
    float* mod = (float*)(ws + WS_MOD); float2* rope = (float2*)(ws + WS_ROPE);
    bf16_t* H = (bf16_t*)(dob + DO_H); bf16_t* Win_t = (bf16_t*)(dob + DO_WIN); bf16_t* Wuf = (bf16_t*)(dob + DO_WUF);
    for (int u = F.tid; u < (LDS_BYTES - LDSCTL_OFF) / 4; u += NWAVES * 64) ((LAS unsigned*)(F.lds + LDSCTL_OFF))[u] = 0u;
    __syncthreads();
    XcdBarrier bar = xcd_barrier_post(F.ctl + CW_BAR + args.li * XCD_BAR_WORDS, F.MISC + 8);
    const int lo = args.ph_lo, hi = args.ph_hi;
#define IN(k) (lo <= (k) && (k) < hi)
#define BOTH(k) (IN(k) && IN((k) + 1))

    if (IN(0)) {
        for (int it = F.vcu; it < 384; it += F.G) p0_mod_item(c, cctx, wmod, bmod, mod, F.lds, it, F.wave, F.lane);
        for (int it = F.wave * F.G + F.vcu; it < 33 + 2048 + 2048; it += F.G * NWAVES) {
            if (it < 33 + 2048) p0_table_item(rope, CS, DFTA, qg, kg, rpb, shiftp, it, F.lane); else p0_wuf_row(win, Wuf, it - (33 + 2048), F.lane); }
        {   constexpr int I_WIN = 32 * 26, I_WO = 32 * 4, I_WA = 32 * 4, I_WF = 16 * 4, NIT = I_WIN + I_WO + I_WA + I_WF;
            auto item = [&](int wi) { CopyItem ci; int r = wi;
                if (r < I_WIN) { ci = CopyItem{win, Win_t, INW, D, 0, (r & 31) * 64, 1024 + (r >> 5) * 512}; return ci; } r -= I_WIN;
                if (r < I_WO) { ci = CopyItem{wo, Wo_t, D, D, 0, (r & 31) * 64, (r >> 5) * 512}; return ci; } r -= I_WO;
                if (r < I_WA) { ci = CopyItem{wa, Wfa_t, D, 3072, 1024, (r & 31) * 64, (r >> 5) * 512}; return ci; } r -= I_WA;
                ci = CopyItem{wf, Wfa_t, D, 3072, 0, (r & 15) * 64, (r >> 4) * 512}; return ci; };
            f32x4 va[8][2], vb[8][2];
            int wi = F.vcu;
            if (wi < NIT) p0_copy_load(item(wi), F.wave, F.lane, va);
#pragma unroll 1
            for (; wi < NIT; wi += F.G) {
                const int wn = wi + F.G;
                if (wn < NIT) p0_copy_load(item(wn), F.wave, F.lane, vb);
                p0_copy_finish(item(wi), F.lds, F.wave, F.lane, va);
#pragma unroll
                for (int r = 0; r < 8; ++r) { va[r][0] = vb[r][0]; va[r][1] = vb[r][1]; }
            } }
        if (BOTH(0)) xcd_barrier(bar);
    }
    if (IN(1)) {
        {   pg8::Gemm g{CS, Wuf, 256, FW};
            SchedFold Sc{F.G, F.vcu};
            EpiTile E{WPQ, (long)D, 0};
            pg8::gemm_phase<EpiTile, SchedFold>(F.lds, g, Sc, E); }
        const int gw = F.vcu * NWAVES + F.wave, NGW = F.G * NWAVES;
        {   f32x4 ra[8], rb[8], na[8], nb[8];
            int it = gw;
            if (it < NB * 1024) p1_pair_load(x + (size_t)(it >> 10) * S * D, it & 1023, F.lane, ra, rb);
#pragma unroll 1
            for (; it < NB * 1024; it += NGW) {
                const int itn = it + NGW, b = it >> 10, n = it & 1023;
                if (itn < NB * 1024) p1_pair_load(x + (size_t)(itn >> 10) * S * D, itn & 1023, F.lane, na, nb);
                p1_pair_finish(ra, rb, mod + (size_t)b * 3 * D, mod + (size_t)b * 3 * D + D, H + (size_t)b * S * D, HEO + (size_t)b * S * D, n, F.lane);
#pragma unroll
                for (int j = 0; j < 8; ++j) { ra[j] = na[j]; rb[j] = nb[j]; }
            } }
        for (int r2 = gw; r2 < NB * L; r2 += NGW) p1_hnorm_row(ctx + (size_t)r2 * D, mod + (size_t)8 * 3 * D, mod + (size_t)8 * 3 * D + D, H + (size_t)(NB * S + r2) * D, F.lane);
        if (BOTH(1)) xcd_barrier(bar);
    }
    if (IN(2)) {
        for (int it = F.wave * F.G + F.vcu; it < 512; it += F.G * NWAVES) p3_pn_item(H, WPQ, PN, it, F.lane);
        {
            pg8::Gemm g{WPQ, HEO, D, D};
            SchedUft Sc{F.G, F.vcu};
            EpiTile E{PQT, (long)D, 1};
            pg8::gemm_phase<EpiTile, SchedUft>(F.lds, g, Sc, E);
            xcd_barrier(bar);
        }
        pg8::Gemm g{H, Win_t, D, D};
        SchedInproj Sc{F.G, (int)blockIdx.x};
        EpiInproj E{ws, qg, kg, rope};
        pg8::gemm_phase<EpiInproj, SchedInproj, true>(F.lds, g, Sc, E);
        if (BOTH(2)) xcd_barrier(bar);
    }
    if (IN(3)) {
        natt::Tensors AT{(const bf16_t*)(ws + WS_Q), (bf16_t*)(ws + WS_Q), (const bf16_t*)(ws + WS_K), (const bf16_t*)(ws + WS_V), (const bf16_t*)(ws + WS_KC), (const bf16_t*)(ws + WS_VC), (const bf16_t*)(ws + WS_SZA), rpb, shiftp};
        natt::attn_phase(F.lds, AT, F.vcu);
        pg8::Gemm g{DFTA, PQT, D, D};
        SchedPos Sc{F.G, F.vcu};
        EpiPos E{(const bf16_t*)(ws + WS_ZFC), (bf16_t*)(dob + DO_MF), PN};
        pg8::gemm_phase<EpiPos, SchedPos>(F.lds, g, Sc, E);
        if (BOTH(3)) xcd_barrier(bar);
    }
    if (IN(4)) {
        pg8::Gemm g{(const bf16_t*)(dob + DO_MF), Wfa_t, D, 3072};
        SchedY Sc{F.G, (int)blockIdx.x, (long)((ws + WS_Q) - (dob + DO_MF))};
        EpiY E{(bf16_t*)(ws + WS_SGF), (const bf16_t*)(ws + WS_SGA)};
        pg8::gemm_phase<EpiY, SchedY>(F.lds, g, Sc, E);
        if (BOTH(4)) xcd_barrier(bar);
    }
    if (IN(5)) {
        pg8::Gemm g{(const bf16_t*)(ws + WS_SGF), Wo_t, D, D};
        SchedRows Sc{F.G, (int)blockIdx.x};
        EpiOut E{x, mod, args.out};
        pg8::gemm_phase<EpiOut, SchedRows>(F.lds, g, Sc, E);
    }
#undef IN
#undef BOTH
}

extern "C" void kernel_launch(void* const* d_in, const int* in_sizes, int n_in, void* d_out, int out_size, void* d_ws, size_t ws_size, hipStream_t stream) {
    unsigned char* ws = (unsigned char*)d_ws;
    if (ws_size < WS_END || n_in != 13) return;
    static int grid = 0;
    if (grid == 0) {
        int dev = 0, cus = 0, per_cu = 0;
        if (hipGetDevice(&dev) != hipSuccess || hipDeviceGetAttribute(&cus, hipDeviceAttributeMultiprocessorCount, dev) != hipSuccess) { grid = -1; return; }
        if (hipFuncSetAttribute((const void*)mega_fwd, hipFuncAttributeMaxDynamicSharedMemorySize, LDS_BYTES) != hipSuccess) { grid = -1; return; }
        if (hipOccupancyMaxActiveBlocksPerMultiprocessor(&per_cu, (const void*)mega_fwd, NWAVES * 64, LDS_BYTES) != hipSuccess || per_cu < 1) { fprintf(stderr, "occupancy query: %d\n", per_cu); grid = -1; return; }
        (void)hipGetLastError();
        grid = cus;
    }
    if (grid != 256) return;
    (void)hipMemsetAsync(ws + WS_CTL, 0, 1 * MiB, stream);
    MArgs a; memset(&a, 0, sizeof(a));
    for (int i = 0; i < 13; ++i) a.in[i] = (const float*)d_in[i];
    a.out = (float*)d_out; a.ws = ws;
    a.ph_lo = 0; a.ph_hi = 6; a.li = 0;
    hipLaunchKernelGGL(mega_fwd, dim3(grid), dim3(NWAVES * 64), LDS_BYTES, stream, a);
}
```
